# Optimizing an MI355X kernel written in HIP

```python
import jax, jax.numpy as jnp
from jax import lax
import numpy as np

D_MODEL = 1024
BATCH = 16
SEQ = 256
DEPTH = 2
DEC_BATCH = 2
DEC_SEQ = 2048
PAST_LEN = 512

GRID_W = 64
EXPAND = 2
D_INNER = EXPAND * D_MODEL
D_A = D_INNER // 2
DK_A = 128
H_A = D_A // DK_A
DV_A = D_A // H_A
D_B = D_INNER // 2
HS_B = 64
H_B = D_B // HS_B
R_DECAY = 64
R_ICL = 64
D_C = D_INNER
H_C = 4
DH_C = D_C // H_C
CHUNK_A = 32
CHUNK_C = 64
N_EVEN = (DEPTH + 1) // 2
N_ODD = DEPTH // 2
SHIFT_W_B = 3 * D_B + 2 * R_DECAY + 2 * R_ICL
IN_EVEN = 5 * D_A + SHIFT_W_B + D_B
IN_ODD = 5 * D_C + 4 * H_C
EPS = 1e-6
GN_EPS_B = 64e-5
F32 = jnp.float32

kernel_name = "bidir_hgrn2_rwkv7_mlstm_ctx_prefix_step"


def _split(x, sizes):
    return jnp.split(x, np.cumsum(sizes)[:-1].tolist(), axis=-1)


def _rms_norm(x, g):
    xf = x.astype(F32)
    y = xf * lax.rsqrt(jnp.mean(xf * xf, axis=-1, keepdims=True) + EPS)
    return (y * g.astype(F32)).astype(x.dtype)


def _head_rms(y, g):
    b, t = y.shape[:2]
    y = y * lax.rsqrt(jnp.mean(y * y, axis=-1, keepdims=True) + EPS)
    return y.reshape(b, t, -1) * g.astype(F32)


def _head_group_norm(y, g, bias):
    b, t = y.shape[:2]
    yc = y - jnp.mean(y, axis=-1, keepdims=True)
    yn = yc * lax.rsqrt(jnp.mean(yc * yc, axis=-1, keepdims=True) + GN_EPS_B)
    return yn.reshape(b, t, -1) * g.astype(F32) + bias.astype(F32)


def _ada(cond, w, b):
    m = jax.nn.silu(cond) @ w + b
    shift, scale, gate = jnp.split(m, 3, axis=-1)
    return shift[:, None], scale[:, None], gate[:, None]


def _centred_shift(p, mu):
    prev = jnp.pad(p[:, :-1], ((0, 0), (1, 0), (0, 0)))
    nxt = jnp.pad(p[:, 1:], ((0, 0), (0, 1), (0, 0)))
    return p + mu[0] * (prev - p) + mu[1] * (nxt - p)


def _flip(a):
    return jnp.flip(a, axis=1)


def _to_chunks(a, L):
    b, t = a.shape[:2]
    a = a.reshape((b, t // L, L) + a.shape[2:])
    return jnp.moveaxis(jnp.moveaxis(a, 1, 0), 2, 3)


def _from_chunks(a):
    a = jnp.moveaxis(jnp.moveaxis(a, 3, 2), 0, 1)
    return a.reshape((a.shape[0], a.shape[1] * a.shape[2]) + a.shape[3:])


def _hgrn2_chunked(q, k, v, log_f, s0):
    L = CHUNK_A
    causal = jnp.tril(jnp.ones((L, L), dtype=bool))[:, :, None]

    def step(S, blk):
        qc, kc, vc, gc = blk
        b = jnp.cumsum(gc, axis=2)
        o = jnp.einsum("bhtd,bhde->bhte", qc * jnp.exp(b), S)
        rel = jnp.where(causal, b[:, :, :, None, :] - b[:, :, None, :, :], -jnp.inf)
        att = jnp.einsum("bhtd,bhsd,bhtsd->bhts", qc, kc, jnp.exp(rel))
        o = o + jnp.einsum("bhts,bhse->bhte", att, vc)
        b_end = b[:, :, -1:, :]
        S = jnp.exp(b_end[:, :, 0, :, None]) * S + jnp.einsum("bhsd,bhse->bhde", kc * jnp.exp(b_end - b), vc)
        return S, o

    S, o = lax.scan(step, s0, tuple(_to_chunks(a, L) for a in (q, k, v, log_f)))
    return _from_chunks(o), S


def _rwkv7_scan(r, log_w, k, v, kk, a, s0):
    def step(S, inp):
        rt, lwt, kt, vt, kkt, at = inp
        sa = jnp.einsum("bhvk,bhk->bhv", S, kkt)
        S = (S * jnp.exp(lwt)[:, :, None, :] - sa[..., None] * (kkt * at)[:, :, None, :]
             + vt[..., None] * kt[:, :, None, :])
        return S, jnp.einsum("bhvk,bhk->bhv", S, rt)

    S, y = lax.scan(step, s0, tuple(jnp.moveaxis(t, 1, 0) for t in (r, log_w, k, v, kk, a)))
    return jnp.moveaxis(y, 0, 1), S


def _mlstm_chunked(q, k, v, log_i, log_f, C0, n0, m0):
    L = CHUNK_C
    causal = jnp.tril(jnp.ones((L, L), dtype=bool))

    def step(carry, blk):
        C, n, m = carry
        qc, kc, vc, ic, fc = blk
        b = jnp.cumsum(fc, axis=-1)
        log_d = jnp.where(causal, b[..., :, None] - b[..., None, :] + ic[..., None, :], -jnp.inf)
        log_prev = b + m[..., None]
        m_t = jnp.maximum(log_prev, jnp.max(log_d, axis=-1))
        w_prev = jnp.exp(log_prev - m_t)
        s = jnp.einsum("bhtd,bhsd->bhts", qc, kc) * jnp.exp(log_d - m_t[..., None])
        num = w_prev[..., None] * jnp.einsum("bhtd,bhde->bhte", qc, C) + jnp.einsum("bhts,bhse->bhte", s, vc)
        den = w_prev * jnp.einsum("bhtd,bhd->bht", qc, n) + jnp.sum(s, axis=-1)
        h = num / jnp.maximum(jnp.abs(den), jnp.exp(-m_t))[..., None]
        log_s = b[..., -1:] - b + ic
        m_new = jnp.maximum(b[..., -1] + m, jnp.max(log_s, axis=-1))
        w_s = jnp.exp(log_s - m_new[..., None])
        w_old = jnp.exp(b[..., -1] + m - m_new)
        C = w_old[..., None, None] * C + jnp.einsum("bhs,bhsd,bhse->bhde", w_s, kc, vc)
        n = w_old[..., None] * n + jnp.einsum("bhs,bhsd->bhd", w_s, kc)
        return (C, n, m_new), h

    (C, n, m), h = lax.scan(step, (C0, n0, m0), tuple(_to_chunks(a, L) for a in (q, k, v, log_i, log_f)))
    return _from_chunks(h), C, n, m


def _short_conv(x, w, b, rows):
    bsz, t, ch = x.shape
    w = w.astype(x.dtype)
    if rows is None:
        y = lax.conv_general_dilated(x, w[1][:, None, :], (1,), "SAME",
                                     dimension_numbers=("NWC", "WIO", "NWC"), feature_group_count=ch)
    else:
        y = lax.conv_general_dilated(x.reshape(bsz, rows, GRID_W, ch), w[:, :, None, :], (1, 1), "SAME",
                                     dimension_numbers=("NHWC", "HWIO", "NHWC"),
                                     feature_group_count=ch).reshape(bsz, t, ch)
    return y + b.astype(x.dtype)


def _hgrn_rwkv_mixer(h, w_in, w_out, lb, hg_g, mu, w0, w2, a0, a2, k_k, k_a, r_k, gn_g, gn_b, s_hgrn, s_rwkv):
    bsz, t, _ = h.shape
    q_a, i_a, ff_a, fb_a, z_a, sh_in, z_b = _split(h @ w_in, [D_A] * 5 + [SHIFT_W_B, D_B])
    heads = lambda a, nh: a.astype(F32).reshape(bsz, t, nh, -1)
    lb = lb.astype(F32)
    q = heads(q_a, H_A)
    v_a = heads(i_a, H_A)

    def hgrn_gate(f_pre):
        f = lb + (1.0 - lb) * jax.nn.sigmoid(f_pre.astype(F32))
        return heads(jnp.log(f), H_A), heads(1.0 - f, H_A)

    lf_f, k_f = hgrn_gate(ff_a)
    lf_b, k_b = hgrn_gate(fb_a)
    s_hgrn = s_hgrn.astype(F32)
    o_f, sa_f = _hgrn2_chunked(q, k_f, v_a, lf_f, s_hgrn[:, 0])
    o_b, sa_b = _hgrn2_chunked(_flip(q), _flip(k_b), _flip(v_a), _flip(lf_b), s_hgrn[:, 1])
    out_a = _head_rms(o_f + _flip(o_b), hg_g) * jax.nn.silu(z_a.astype(F32))
    sh = _centred_shift(sh_in.astype(F32), mu.astype(F32))
    r, k, v, wl_f, wl_b, al_f, al_b = _split(sh, [D_B] * 3 + [R_DECAY] * 2 + [R_ICL] * 2)
    kk = heads(k * k_k, H_B)
    kk = kk / jnp.maximum(jnp.sqrt(jnp.sum(kk * kk, axis=-1, keepdims=True)), 1e-12)
    r_h = heads(r, H_B)
    v_h = heads(v, H_B)
    s_rwkv = s_rwkv.astype(F32)

    def rwkv_dir(wl, al, d, rev):
        u = w0[d] + jnp.tanh(wl) @ w2[d]
        log_w = heads(-jnp.exp(-jax.nn.softplus(-u) - 0.5), H_B)
        a = jax.nn.sigmoid(a0[d] + al @ a2[d])
        kd = k * (1.0 + (a - 1.0) * k_a)
        a, kd = heads(a, H_B), heads(kd, H_B)
        bonus = jnp.sum(r_h * kd * r_k, axis=-1, keepdims=True) * v_h
        seq = (r_h, log_w, kd, v_h, kk, a)
        if rev:
            seq = tuple(_flip(x) for x in seq)
        y, s = _rwkv7_scan(*seq, s_rwkv[:, d])
        return (_flip(y) if rev else y), bonus, s

    y_f, bo_f, sr_f = rwkv_dir(wl_f, al_f, 0, False)
    y_b, bo_b, sr_b = rwkv_dir(wl_b, al_b, 1, True)
    out_b = (_head_group_norm(y_f + y_b, gn_g, gn_b) + (bo_f + bo_b).reshape(bsz, t, -1)) * jax.nn.silu(z_b.astype(F32))
    out = jnp.concatenate([out_a, out_b], axis=-1).astype(h.dtype) @ w_out
    return out, jnp.stack([sa_f, sa_b], axis=1), jnp.stack([sr_f, sr_b], axis=1)


def _mlstm_mixer(h, w_in, w_out, conv_w, conv_b, gate_b, norm_g, s_c, s_n, s_m, rows):
    bsz, t, _ = h.shape
    qk, v, o, z, gates = _split(h @ w_in, [2 * D_C, D_C, D_C, D_C, 4 * H_C])
    qk = jax.nn.silu(_short_conv(qk, conv_w, conv_b, rows)).astype(F32)
    heads = lambda a: a.astype(F32).reshape(bsz, t, H_C, DH_C)
    q = heads(qk[..., :D_C])
    k = heads(qk[..., D_C:]) * (DH_C ** -0.5)
    v = heads(v)
    g = gates.astype(F32).reshape(bsz, t, 4, H_C) + gate_b.astype(F32)
    s_c, s_n, s_m = s_c.astype(F32), s_n.astype(F32), s_m.astype(F32)

    def run(d, rev):
        seq = (q, k, v, g[:, :, d], jax.nn.log_sigmoid(g[:, :, 2 + d]))
        if rev:
            seq = tuple(_flip(a) for a in seq)
        hd, C, n, m = _mlstm_chunked(*seq, s_c[:, d], s_n[:, d], s_m[:, d])
        return (_flip(hd) if rev else hd), C, n, m

    h_f, c_f, n_f, m_f = run(0, False)
    h_b, c_b, n_b, m_b = run(1, True)
    y = jax.nn.sigmoid(heads(o)) * (h_f + h_b)
    y = _head_rms(y, norm_g) * jax.nn.silu(z.astype(F32))
    return (y.astype(h.dtype) @ w_out, jnp.stack([c_f, c_b], axis=1),
            jnp.stack([n_f, n_b], axis=1), jnp.stack([m_f, m_b], axis=1))


def setup_inputs(seed: int = 0) -> dict:
    key = jax.random.key(seed)
    ks = iter(jax.random.split(key, 48))
    nrm = lambda shape, s: jax.random.normal(next(ks), shape, F32) * s
    inp = {}
    inp["x_prompt"] = nrm((BATCH, SEQ, D_MODEL), 1.0)
    inp["x_sample"] = nrm((DEC_BATCH, DEC_SEQ, D_MODEL), 1.0)
    inp["c"] = nrm((DEC_BATCH, D_MODEL), 1.0)
    inp["state_hgrn"] = nrm((DEC_BATCH, N_EVEN, 2, H_A, DK_A, DV_A), 0.3)
    inp["state_rwkv"] = nrm((DEC_BATCH, N_EVEN, 2, H_B, HS_B, HS_B), 0.1)
    inp["state_mlstm_C"] = nrm((DEC_BATCH, N_ODD, 2, H_C, DH_C, DH_C), 0.05)
    inp["state_mlstm_n"] = nrm((DEC_BATCH, N_ODD, 2, H_C, DH_C), 0.1)
    inp["state_mlstm_m"] = nrm((DEC_BATCH, N_ODD, 2, H_C), 0.5)
    inp["c_ctx"] = nrm((D_MODEL,), 1.0)
    inp["w_mod"] = nrm((DEPTH, D_MODEL, 3 * D_MODEL), D_MODEL ** -0.5)
    inp["b_mod"] = nrm((DEPTH, 3 * D_MODEL), 0.02)
    inp["norm_g"] = 1.0 + nrm((DEPTH, D_MODEL), 0.02)
    inp["final_norm_g"] = 1.0 + nrm((D_MODEL,), 0.02)
    inp["w_in_even"] = nrm((N_EVEN, D_MODEL, IN_EVEN), D_MODEL ** -0.5)
    inp["w_out_even"] = nrm((N_EVEN, D_INNER, D_MODEL), D_INNER ** -0.5)
    inp["hgrn_lb_logits"] = nrm((N_EVEN + 1, D_A), 0.5)
    inp["hgrn_norm_g"] = 1.0 + nrm((N_EVEN, D_A), 0.02)
    inp["rwkv_shift_mu"] = jax.random.uniform(next(ks), (N_EVEN, 2, SHIFT_W_B), F32, 0.0, 0.5)
    inp["rwkv_w0"] = nrm((N_EVEN, 2, D_B), 0.5)
    inp["rwkv_w2"] = nrm((N_EVEN, 2, R_DECAY, D_B), 0.5 * R_DECAY ** -0.5)
    inp["rwkv_a0"] = nrm((N_EVEN, 2, D_B), 0.1)
    inp["rwkv_a2"] = nrm((N_EVEN, 2, R_ICL, D_B), 0.5 * R_ICL ** -0.5)
    inp["rwkv_k_k"] = 0.85 + nrm((N_EVEN, D_B), 0.05)
    inp["rwkv_k_a"] = 1.0 + nrm((N_EVEN, D_B), 0.05)
    inp["rwkv_r_k"] = nrm((N_EVEN, H_B, HS_B), 0.1)
    inp["rwkv_gn_g"] = 1.0 + nrm((N_EVEN, D_B), 0.02)
    inp["rwkv_gn_b"] = nrm((N_EVEN, D_B), 0.02)
    inp["w_in_odd"] = nrm((N_ODD, D_MODEL, IN_ODD), D_MODEL ** -0.5)
    inp["w_out_odd"] = nrm((N_ODD, D_C, D_MODEL), D_C ** -0.5)
    inp["mlstm_conv_w"] = nrm((N_ODD, 3, 3, 2 * D_C), 1.0 / 3.0)
    inp["mlstm_conv_b"] = nrm((N_ODD, 2 * D_C), 0.02)
    inp["mlstm_gate_b"] = nrm((N_ODD, 4, H_C), 0.1) + jnp.array([0.0, 0.0, 3.0, 3.0], F32)[None, :, None]
    inp["mlstm_norm_g"] = 1.0 + nrm((N_ODD, D_C), 0.02)
    return inp


def reference(x_prompt, x_sample, c, state_hgrn, state_rwkv, state_mlstm_C, state_mlstm_n, state_mlstm_m,
              c_ctx, w_mod, b_mod, norm_g, final_norm_g, w_in_even, w_out_even, hgrn_lb_logits, hgrn_norm_g,
              rwkv_shift_mu, rwkv_w0, rwkv_w2, rwkv_a0, rwkv_a2, rwkv_k_k, rwkv_k_a, rwkv_r_k, rwkv_gn_g,
              rwkv_gn_b, w_in_odd, w_out_odd, mlstm_conv_w, mlstm_conv_b, mlstm_gate_b, mlstm_norm_g):
    rows = x_sample.shape[1] // GRID_W
    n_p = x_prompt.shape[0]
    lb_all = jnp.cumsum(jax.nn.softmax(hgrn_lb_logits.astype(F32), axis=0), axis=0)
    xp, xs = x_prompt, x_sample
    new_hgrn, new_rwkv, new_c, new_n, new_m = [], [], [], [], []
    for layer in range(DEPTH):
        j = layer // 2
        sh_p, sc_p, g_p = _ada(c_ctx[None], w_mod[layer], b_mod[layer])
        sh_s, sc_s, g_s = _ada(c, w_mod[layer], b_mod[layer])
        h_p = _rms_norm(xp, norm_g[layer]) * (1.0 + sc_p) + sh_p
        h_s = _rms_norm(xs, norm_g[layer]) * (1.0 + sc_s) + sh_s
        if layer % 2 == 0:
            p = (w_in_even[j], w_out_even[j], lb_all[j], hgrn_norm_g[j], rwkv_shift_mu[j], rwkv_w0[j], rwkv_w2[j],
                 rwkv_a0[j], rwkv_a2[j], rwkv_k_k[j], rwkv_k_a[j], rwkv_r_k[j], rwkv_gn_g[j], rwkv_gn_b[j])
            o_p, s_h, s_r = _hgrn_rwkv_mixer(h_p, *p, jnp.zeros((n_p, 2, H_A, DK_A, DV_A), F32),
                                             jnp.zeros((n_p, 2, H_B, HS_B, HS_B), F32))
            o_s, _, _ = _hgrn_rwkv_mixer(h_s, *p, state_hgrn[:, j], state_rwkv[:, j])
            new_hgrn.append(s_h)
            new_rwkv.append(s_r)
        else:
            p = (w_in_odd[j], w_out_odd[j], mlstm_conv_w[j], mlstm_conv_b[j], mlstm_gate_b[j], mlstm_norm_g[j])
            o_p, s_c, s_n, s_m = _mlstm_mixer(h_p, *p, jnp.zeros((n_p, 2, H_C, DH_C, DH_C), F32),
                                              jnp.zeros((n_p, 2, H_C, DH_C), F32),
                                              jnp.zeros((n_p, 2, H_C), F32), None)
            o_s, _, _, _ = _mlstm_mixer(h_s, *p, state_mlstm_C[:, j], state_mlstm_n[:, j], state_mlstm_m[:, j], rows)
            new_c.append(s_c)
            new_n.append(s_n)
            new_m.append(s_m)
        xp = xp + g_p * o_p
        xs = xs + g_s * o_s
    y_prompt = _rms_norm(xp, final_norm_g)
    y_sample = _rms_norm(xs, final_norm_g)
    dt = x_prompt.dtype
    new_hgrn = jnp.stack(new_hgrn, axis=1).astype(dt)
    new_rwkv = jnp.stack(new_rwkv, axis=1).astype(dt)
    new_mlstm_C = jnp.stack(new_c, axis=1).astype(dt)
    new_mlstm_n = jnp.stack(new_n, axis=1).astype(dt)
    new_mlstm_m = jnp.stack(new_m, axis=1).astype(dt)
    return (y_prompt, y_sample, new_hgrn, new_rwkv, new_mlstm_C, new_mlstm_n, new_mlstm_m)
```

```cpp
#include <hip/hip_runtime.h>
#include <cstdio>
#include <cstdint>

#define LAS __attribute__((address_space(3)))
#define GAS __attribute__((address_space(1)))
typedef unsigned short bf16_t;
typedef short bf16x8 __attribute__((ext_vector_type(8)));
typedef float f32x4 __attribute__((ext_vector_type(4)));
typedef float f32x2 __attribute__((ext_vector_type(2)));
typedef unsigned u32x4 __attribute__((ext_vector_type(4)));
typedef unsigned u32x2 __attribute__((ext_vector_type(2)));

namespace pg8 {
#define PG8_LAS __attribute__((address_space(3)))
constexpr int BM = 256, BK = 64, HALF = 128, HTB = HALF * BK * 2, STAGE_BYTES = 8 * HTB, NXCD = 8, WGM = 8;

__host__ __device__ __forceinline__ int lds_byte(int r, int c) { const int st = (r >> 4) * 2 + (c >> 5), rr = r & 15, cc = c & 31, ob = rr * 64 + cc * 2; return st * 1024 + (ob ^ (((ob >> 9) & 1) << 5)); }
__host__ __device__ __forceinline__ void stage_rc(int b, int& R, int& C) { const int st = b / 1024, sb = b % 1024, swz = sb ^ (((sb >> 9) & 1) << 5); R = (st >> 1) * 16 + swz / 64; C = (st & 1) * 32 + (swz % 64) / 2; }
__host__ __device__ __forceinline__ int perm32(int rho) { const int n = rho >> 4, i = rho & 15; return 8 * (i >> 2) + 4 * n + (i & 3); }

struct Unit { int pm, pn, ks; };
struct Gemm { const bf16_t* A; const bf16_t* Bt; int M, N, K, ld; };

struct StaticOrder {
    int nM, nN, nwg, G, c;
    __host__ __device__ void init(int M, int N, int G_, int c_) { nM = M / BM; nN = N / BM; nwg = nM * nN; G = G_; c = c_; }
    __host__ __device__ bool next(int i, Unit& u) const {
        const long L = (long)i * G + c; if (L >= nwg) return false;
        int wgid = (int)L; { const int q = nwg / NXCD, r = nwg % NXCD, xcd = wgid % NXCD, off = wgid / NXCD; wgid = (xcd < r ? xcd * (q + 1) : r * (q + 1) + (xcd - r) * q) + off; }
        const int nig = WGM * nN, gid = wgid / nig, fm = gid * WGM, gsz = (nM - fm) < WGM ? (nM - fm) : WGM;
        u.pm = fm + ((wgid % nig) % gsz); u.pn = (wgid % nig) / gsz; u.ks = 0; return true;
    }
    __device__ __forceinline__ void a_ready(const Unit&) const {}
    __device__ __forceinline__ void done(const Unit&) const {}
};
struct LowRankOrder { StaticOrder S;
    __host__ __device__ bool next(int i, Unit& u) const { if (!S.next(i, u)) return false; u.ks = u.pn >> 3; return true; }
    __device__ __forceinline__ void a_ready(const Unit&) const {}
    __device__ __forceinline__ void done(const Unit&) const {}
};
struct SplitKOrder {
    int G, c;
    __host__ __device__ bool next(int i, Unit& u) const {
        const long L = (long)i * G + c; if (L >= 256) return false;
        u.pm = (int)(L >> 3); u.pn = (int)((L >> 1) & 3); u.ks = (int)(L & 1); return true;
    }
    __device__ __forceinline__ void a_ready(const Unit&) const {}
    __device__ __forceinline__ void done(const Unit&) const {}
};

__device__ __forceinline__ unsigned cvt_pk_bf16(float lo, float hi) { unsigned r; asm volatile("v_cvt_pk_bf16_f32 %0, %1, %2" : "=v"(r) : "v"(lo), "v"(hi)); return r; }

struct EpiBf16 {
    static constexpr bool PERM = true, AFTER_DRAIN = false;
    bf16_t* O; int ldc;
    __device__ __forceinline__ void operator()(const f32x4 (&acc)[2][2][4][2], const Unit& u, int wr, int wc, int fr, int fq) const {
        const int row0 = u.pm * BM + wr * 64 + fr; const int col0 = u.pn * BM + wc * 32 + 8 * fq;
#pragma unroll
        for (int ai = 0; ai < 2; ++ai)
#pragma unroll
            for (int m = 0; m < 4; ++m) { bf16_t* rowp = O + (size_t)(row0 + ai * HALF + m * 16) * ldc + col0;
#pragma unroll
                for (int bj = 0; bj < 2; ++bj) { const f32x4 v0 = acc[ai][bj][m][0], v1 = acc[ai][bj][m][1];
                    u32x4 w; w.x = cvt_pk_bf16(v0[0], v0[1]); w.y = cvt_pk_bf16(v0[2], v0[3]); w.z = cvt_pk_bf16(v1[0], v1[1]); w.w = cvt_pk_bf16(v1[2], v1[3]);
                    *(u32x4*)(rowp + bj * HALF) = w; } }
    }
};
struct EpiBf16Part {
    static constexpr bool PERM = true, AFTER_DRAIN = false;
    bf16_t* O; int ldc; size_t part_stride;
    __device__ __forceinline__ void operator()(const f32x4 (&acc)[2][2][4][2], const Unit& u, int wr, int wc, int fr, int fq) const {
        const int row0 = u.pm * BM + wr * 64 + fr; const int col0 = u.pn * BM + wc * 32 + 8 * fq;
        bf16_t* base = O + (size_t)u.ks * part_stride;
#pragma unroll
        for (int ai = 0; ai < 2; ++ai)
#pragma unroll
            for (int m = 0; m < 4; ++m) { bf16_t* rowp = base + (size_t)(row0 + ai * HALF + m * 16) * ldc + col0;
#pragma unroll
                for (int bj = 0; bj < 2; ++bj) { const f32x4 v0 = acc[ai][bj][m][0], v1 = acc[ai][bj][m][1];
                    u32x4 w; w.x = cvt_pk_bf16(v0[0], v0[1]); w.y = cvt_pk_bf16(v0[2], v0[3]); w.z = cvt_pk_bf16(v1[0], v1[1]); w.w = cvt_pk_bf16(v1[2], v1[3]);
                    *(u32x4*)(rowp + bj * HALF) = w; } }
    }
};
struct EpiF32Part {
    static constexpr bool PERM = false, AFTER_DRAIN = false;
    float* P; int ldc; size_t part_stride;
    __device__ __forceinline__ void operator()(const f32x4 (&acc)[2][2][4][2], const Unit& u, int wr, int wc, int fr, int fq) const {
        const int row0 = u.pm * BM + wr * 64 + fr; const int col0 = u.pn * BM + wc * 32 + 4 * fq;
        float* base = P + (size_t)u.ks * part_stride;
#pragma unroll
        for (int ai = 0; ai < 2; ++ai)
#pragma unroll
            for (int m = 0; m < 4; ++m) { float* rowp = base + (size_t)(row0 + ai * HALF + m * 16) * ldc + col0;
#pragma unroll
                for (int bj = 0; bj < 2; ++bj)
#pragma unroll
                    for (int n = 0; n < 2; ++n) *(f32x4*)(rowp + bj * HALF + n * 16) = acc[ai][bj][m][n]; }
    }
};

template <class Epi, class Sched, bool ALIGN_EPI = false, bool SP2 = false>
__device__ __forceinline__ void gemm_phase(PG8_LAS unsigned char* lds, const Gemm g, const Sched& S, const Epi& E) {
    const int tid = threadIdx.x, wid = __builtin_amdgcn_readfirstlane(tid >> 6), lane = tid & 63, wr = wid >> 2, wc = wid & 3, fr = lane & 15, fq = lane >> 4;
    const int K = g.K, nt = K / BK, LD = g.ld;
    unsigned voffA[2], voffB[2];
#pragma unroll
    for (int i = 0; i < 2; ++i) { int R, C; stage_rc(tid * 16 + i * 8192, R, C); const int Rb = Epi::PERM ? ((R & ~31) + perm32(R & 31)) : R;
        voffA[i] = (unsigned)(R * LD + C) * 2u; voffB[i] = (unsigned)(Rb * LD + C) * 2u; }
    const size_t kstep = (size_t)(BK * 2);
    const size_t hstep = (size_t)HALF * LD * 2;
    const size_t tstep = 2 * hstep;
    const size_t sstep = (size_t)K * 2;
    const unsigned ldsw = (unsigned)wid * 1024u;
    const int aoff = lds_byte(wr * 64 + fr, fq * 8), boff = lds_byte(wc * 32 + fr, fq * 8);
#define PG8_SA(b, h) (((b) * 2 + (h)) * HTB)
#define PG8_SB(b, h) ((4 + (b) * 2 + (h)) * HTB)
#define PG8_STAGE(bufoff, gbase, voff) do { _Pragma("unroll") for (int _i = 0; _i < 2; ++_i) \
        __builtin_amdgcn_global_load_lds((const unsigned*)((const char*)(gbase) + (voff)[_i]), (PG8_LAS unsigned*)(lds + (bufoff) + ldsw + _i * 8192), 16, 0, 0); } while (0)
#define PG8_LDA(dst, b, h) do { _Pragma("unroll") for (int m = 0; m < 4; ++m) _Pragma("unroll") for (int k = 0; k < 2; ++k) dst[m][k] = *(const PG8_LAS bf16x8*)(lds + PG8_SA(b, h) + aoff + m * 2048 + k * 1024); } while (0)
#define PG8_LDB(dst, b, h) do { _Pragma("unroll") for (int n = 0; n < 2; ++n) _Pragma("unroll") for (int k = 0; k < 2; ++k) dst[n][k] = *(const PG8_LAS bf16x8*)(lds + PG8_SB(b, h) + boff + n * 2048 + k * 1024); } while (0)
#define PG8_MMA(ai, bj, At, Bt) do { __builtin_amdgcn_s_setprio(1); _Pragma("unroll") for (int m = 0; m < 4; ++m) _Pragma("unroll") for (int n = 0; n < 2; ++n) _Pragma("unroll") for (int k = 0; k < 2; ++k) \
        acc[ai][bj][m][n] = __builtin_amdgcn_mfma_f32_16x16x32_bf16(Bt[n][k], At[m][k], acc[ai][bj][m][n], 0, 0, 0); __builtin_amdgcn_s_setprio(0); } while (0)
#define PG8_WAIT_V(n) asm volatile("s_waitcnt vmcnt(" #n ")" ::: "memory")
#define PG8_WAIT_L(n) asm volatile("s_waitcnt lgkmcnt(" #n ")" ::: "memory")
#define PG8_BAR __builtin_amdgcn_s_barrier()
#define PG8_SCHED __builtin_amdgcn_sched_barrier(0)
    Unit cur, nxt; int ui = 0;
    if (!S.next(0, cur)) return;
    f32x4 acc[2][2][4][2];
#pragma unroll
    for (int a = 0; a < 2; ++a)
#pragma unroll
        for (int b = 0; b < 2; ++b)
#pragma unroll
            for (int m = 0; m < 4; ++m)
#pragma unroll
                for (int n = 0; n < 2; ++n) acc[a][b][m][n] = (f32x4){0.f, 0.f, 0.f, 0.f};
    bf16x8 At[4][2], B0[2][2], B1[2][2];
    const char* cA = (const char*)g.A + (size_t)cur.pm * tstep + (size_t)cur.ks * sstep; const char* cB = (const char*)g.Bt + (size_t)cur.pn * tstep + (size_t)cur.ks * sstep;
    S.a_ready(cur);
    if constexpr (SP2) {
        PG8_STAGE(PG8_SB(0, 0), cB, voffB); PG8_STAGE(PG8_SB(0, 1), cB + hstep, voffB); PG8_STAGE(PG8_SA(0, 0), cA, voffA); PG8_STAGE(PG8_SA(0, 1), cA + hstep, voffA);
        if (wr == 1) PG8_BAR;
        PG8_WAIT_V(2); PG8_BAR;
        PG8_STAGE(PG8_SB(1, 0), cB + kstep, voffB); PG8_STAGE(PG8_SA(1, 0), cA + kstep, voffA); PG8_STAGE(PG8_SB(1, 1), cB + hstep + kstep, voffB);
        PG8_WAIT_V(6); PG8_BAR;
    } else {
        PG8_STAGE(PG8_SB(0, 0), cB, voffB); PG8_STAGE(PG8_SA(0, 0), cA, voffA); PG8_STAGE(PG8_SB(0, 1), cB + hstep, voffB); PG8_STAGE(PG8_SA(0, 1), cA + hstep, voffA);
        if (wr == 1) PG8_BAR;
        PG8_WAIT_V(4); PG8_BAR;
        PG8_STAGE(PG8_SB(1, 0), cB + kstep, voffB); PG8_STAGE(PG8_SA(1, 0), cA + kstep, voffA); PG8_STAGE(PG8_SB(1, 1), cB + hstep + kstep, voffB);
        PG8_WAIT_V(6); PG8_BAR;
    }
    for (;;) {
        const bool has_next = S.next(ui + 1, nxt);
        const char* nA = has_next ? (const char*)g.A + (size_t)nxt.pm * tstep + (size_t)nxt.ks * sstep : cA; const char* nB = has_next ? (const char*)g.Bt + (size_t)nxt.pn * tstep + (size_t)nxt.ks * sstep : cB;
        for (int t = 0; t < nt; t += 2) {
            const bool last = (t == nt - 2);
            const char* a1 = cA + (size_t)(t + 1) * kstep;
            const char* a2 = last ? nA : cA + (size_t)(t + 2) * kstep; const char* b2 = last ? nB : cB + (size_t)(t + 2) * kstep;
            const char* a3 = a2 + kstep; const char* b3 = b2 + kstep;
            if (last && has_next) S.a_ready(nxt);
            if constexpr (SP2) {
            PG8_LDB(B0, 0, 0); PG8_LDB(B1, 0, 1); PG8_SCHED; PG8_LDA(At, 0, 0); PG8_STAGE(PG8_SA(1, 1), a1 + hstep, voffA);
            PG8_WAIT_V(8); PG8_WAIT_L(0); PG8_BAR; PG8_MMA(0, 0, At, B0); PG8_MMA(0, 1, At, B1); PG8_BAR; PG8_SCHED;
            PG8_LDA(At, 0, 1); PG8_STAGE(PG8_SB(0, 0), b2, voffB); PG8_STAGE(PG8_SB(0, 1), b2 + hstep, voffB); PG8_STAGE(PG8_SA(0, 0), a2, voffA);
            PG8_WAIT_V(8); PG8_WAIT_L(0); PG8_BAR; PG8_MMA(1, 0, At, B0); PG8_MMA(1, 1, At, B1); PG8_BAR; PG8_SCHED;
            PG8_LDB(B0, 1, 0); PG8_LDB(B1, 1, 1); PG8_SCHED; PG8_LDA(At, 1, 0); PG8_STAGE(PG8_SA(0, 1), a2 + hstep, voffA);
            PG8_WAIT_V(8); PG8_WAIT_L(0); PG8_BAR; PG8_MMA(0, 0, At, B0); PG8_MMA(0, 1, At, B1); PG8_BAR; PG8_SCHED;
            PG8_LDA(At, 1, 1); PG8_STAGE(PG8_SB(1, 0), b3, voffB); PG8_STAGE(PG8_SB(1, 1), b3 + hstep, voffB); PG8_STAGE(PG8_SA(1, 0), a3, voffA);
            PG8_WAIT_V(8); PG8_WAIT_L(0); PG8_BAR; PG8_MMA(1, 0, At, B0); PG8_MMA(1, 1, At, B1); PG8_BAR; PG8_SCHED;
            } else {
            PG8_LDB(B0, 0, 0); PG8_SCHED; PG8_LDA(At, 0, 0); PG8_STAGE(PG8_SA(1, 1), a1 + hstep, voffA);
            PG8_WAIT_L(8); PG8_BAR; PG8_WAIT_L(0); PG8_MMA(0, 0, At, B0); PG8_BAR; PG8_SCHED;
            PG8_LDB(B1, 0, 1); PG8_STAGE(PG8_SB(0, 0), b2, voffB);
            PG8_BAR; PG8_WAIT_L(0); PG8_MMA(0, 1, At, B1); PG8_BAR;
            PG8_LDA(At, 0, 1); PG8_STAGE(PG8_SA(0, 0), a2, voffA);
            PG8_BAR; PG8_WAIT_L(0); PG8_MMA(1, 0, At, B0); PG8_BAR; PG8_SCHED;
            PG8_STAGE(PG8_SB(0, 1), b2 + hstep, voffB);
            PG8_WAIT_V(6); PG8_BAR; PG8_MMA(1, 1, At, B1); PG8_BAR;
            PG8_LDB(B0, 1, 0); PG8_SCHED; PG8_LDA(At, 1, 0); PG8_STAGE(PG8_SA(0, 1), a2 + hstep, voffA);
            PG8_WAIT_L(8); PG8_BAR; PG8_WAIT_L(0); PG8_MMA(0, 0, At, B0); PG8_BAR; PG8_SCHED;
            PG8_LDB(B1, 1, 1); PG8_STAGE(PG8_SB(1, 0), b3, voffB);
            PG8_BAR; PG8_WAIT_L(0); PG8_MMA(0, 1, At, B1); PG8_BAR;
            PG8_LDA(At, 1, 1); PG8_STAGE(PG8_SA(1, 0), a3, voffA);
            PG8_BAR; PG8_WAIT_L(0); PG8_MMA(1, 0, At, B0); PG8_BAR; PG8_SCHED;
            PG8_STAGE(PG8_SB(1, 1), b3 + hstep, voffB);
            PG8_WAIT_V(6); PG8_BAR; PG8_MMA(1, 1, At, B1); PG8_BAR;
            }
        }
        if constexpr (ALIGN_EPI) { if (wr == 0) PG8_BAR; }
        if constexpr (!Epi::AFTER_DRAIN) { E(acc, cur, wr, wc, fr, fq); S.done(cur); }
        if (!has_next) break;
#pragma unroll
        for (int a = 0; a < 2; ++a)
#pragma unroll
            for (int b = 0; b < 2; ++b)
#pragma unroll
                for (int m = 0; m < 4; ++m)
#pragma unroll
                    for (int n = 0; n < 2; ++n) acc[a][b][m][n] = (f32x4){0.f, 0.f, 0.f, 0.f};
        cur = nxt; cA = nA; cB = nB; ++ui;
        if constexpr (ALIGN_EPI) { if (wr == 1) PG8_BAR; }
    }
    PG8_WAIT_V(0);
    if constexpr (!ALIGN_EPI) { if (wr == 0) PG8_BAR; }
    PG8_BAR;
#undef PG8_SA
#undef PG8_SB
#undef PG8_STAGE
#undef PG8_LDA
#undef PG8_LDB
#undef PG8_MMA
#undef PG8_WAIT_V
#undef PG8_WAIT_L
#undef PG8_BAR
#undef PG8_SCHED
}
}

constexpr int NT = 512, NWAVES = 8;
constexpr int LDS_BYTES = 159744;
constexpr int MISC_OFF = 155648;
constexpr int NTOK = 8192, DM = 1024;
constexpr int IN_EVEN = 9472, IN_ODD = 10256, IN_ODD_MAIN = 10240;
constexpr float EPS = 1e-6f, GN_EPS = 64e-5f;
constexpr size_t OUT_Y = 0, OUT_HGRN = 8388608, OUT_RWKV = 12582912, OUT_C = 14680064, OUT_N = 48234496, OUT_M = 48300032;
constexpr size_t MiB = 1u << 20;
constexpr size_t WS_CTL = 0, CTL_ZERO_BYTES = 64 * 1024;
constexpr size_t WS_MOD = 1 * MiB;
constexpr size_t WS_GW = 1 * MiB + 512 * 1024;
constexpr size_t WS_GATES = 1 * MiB + 768 * 1024;
constexpr size_t WS_WINE = 4 * MiB;
constexpr size_t WS_WOUTE = 24 * MiB;
constexpr size_t WS_WINO = 28 * MiB;
constexpr size_t WS_WOUTO = 48 * MiB;
constexpr size_t WS_XN = 52 * MiB;
constexpr size_t WS_X1 = 68 * MiB;
constexpr size_t WS_PROJ = 100 * MiB;
constexpr size_t WS_OF = 260 * MiB, WS_OB = 292 * MiB;
constexpr size_t WS_QKC = 260 * MiB;
constexpr size_t WS_YF = 324 * MiB, WS_YB = 356 * MiB;
constexpr size_t WS_HF = 324 * MiB, WS_HB = 388 * MiB;
constexpr size_t WS_U4 = 260 * MiB;
constexpr size_t WS_RS = 324 * MiB, WS_KS = 340 * MiB, WS_KKS = 356 * MiB;
constexpr size_t WS_RWREC = 388 * MiB;
constexpr size_t WS_Y = 564 * MiB;
constexpr size_t WS_PART = 596 * MiB;
constexpr size_t WS_BS = 660 * MiB;
constexpr size_t WS_GT = 662 * MiB;
constexpr size_t WS_DEN = 662 * MiB + 512 * 1024;
constexpr size_t WS_V = 664 * MiB;
constexpr size_t WS_LR = 680 * MiB;
constexpr size_t WS_W2B = 684 * MiB;
constexpr size_t WS_HQA0 = 52 * MiB, WS_HKT0 = 68 * MiB, WS_HQA1 = 84 * MiB, WS_HKT1 = 616 * MiB;
constexpr size_t WS_HSC = 632 * MiB;
constexpr size_t WS_MP = 686 * MiB;
constexpr size_t WS_MLREC = 596 * MiB;
constexpr size_t WS_END = 687 * MiB;
constexpr int CW_Q0 = 64, CW_Q2 = 192, CW_Q1 = 1024, CW_BAR = 4096;

struct Args { const float* in[33]; float* out; unsigned char* ws; int ph_lo, ph_hi; };

__device__ __forceinline__ float bf2f(unsigned short u) { return __uint_as_float((unsigned)u << 16); }
typedef __bf16 bf16x2_t __attribute__((ext_vector_type(2)));
__device__ __forceinline__ unsigned pk2(float lo, float hi) { const f32x2 v = {lo, hi}; const bf16x2_t b = __builtin_convertvector(v, bf16x2_t); return __builtin_bit_cast(unsigned, b); }
__device__ __forceinline__ unsigned f2bf(float f) { return (unsigned)__builtin_bit_cast(unsigned short, (__bf16)f); }
__device__ __forceinline__ float sigm(float x) { return 1.f / (1.f + __expf(-x)); }
__device__ __forceinline__ float silu(float x) { return x / (1.f + __expf(-x)); }
__device__ __forceinline__ void tok_info(int m, int& t, int& T, int& cr) {
    if (m < 4096) { t = m & 255; T = 256; cr = 0; } else { const int mm = m - 4096; t = mm & 2047; T = 2048; cr = 1 + (mm >> 11); }
}
__device__ __forceinline__ const float* x_row(const Args& a, int m) { return m < 4096 ? a.in[0] + (size_t)m * DM : a.in[1] + (size_t)(m - 4096) * DM; }
template <int CTRL> __device__ __forceinline__ float dpp_mov(float v) { return __uint_as_float((unsigned)__builtin_amdgcn_update_dpp(0, (int)__float_as_uint(v), CTRL, 0xF, 0xF, false)); }
__device__ __forceinline__ float row16_sum(float v) {
    v += dpp_mov<0xB1>(v);
    v += dpp_mov<0x4E>(v);
    v += dpp_mov<0x141>(v);
    v += dpp_mov<0x140>(v);
    return v;
}
__device__ __forceinline__ float bflo(unsigned u) { return __uint_as_float(u << 16); }
__device__ __forceinline__ float bfhi(unsigned u) { return __uint_as_float(u & 0xffff0000u); }
__device__ __forceinline__ float quad_sum(float v) { v += dpp_mov<0xB1>(v); v += dpp_mov<0x4E>(v); return v; }
__device__ __forceinline__ float oct_sum(float v) { v = quad_sum(v); v += dpp_mov<0x141>(v); return v; }
__device__ __forceinline__ float wave_sum(float v) {
    v = row16_sum(v);
    const int vi = (int)__float_as_uint(v);
    const float s0 = __uint_as_float((unsigned)__builtin_amdgcn_readlane(vi, 0)), s1 = __uint_as_float((unsigned)__builtin_amdgcn_readlane(vi, 16));
    const float s2 = __uint_as_float((unsigned)__builtin_amdgcn_readlane(vi, 32)), s3 = __uint_as_float((unsigned)__builtin_amdgcn_readlane(vi, 48));
    return (s0 + s1) + (s2 + s3);
}

__device__ __forceinline__ void p0_transpose_item(const float* W, int ldw, int K, int nblk, bf16_t* WT, LAS float* scr, int item, int lane) {
    const int kb = item / nblk, nb = item % nblk, k0 = 64 * kb, n0 = 32 * nb;
    f32x4 v[8];
#pragma unroll
    for (int i = 0; i < 8; ++i) v[i] = *(const f32x4*)(W + (size_t)(k0 + 8 * i + (lane >> 3)) * ldw + n0 + 4 * (lane & 7));
    __builtin_amdgcn_sched_barrier(0);
#pragma unroll
    for (int i = 0; i < 8; ++i) { LAS float* d = scr + (8 * i + (lane >> 3)) * 33 + 4 * (lane & 7); d[0] = v[i].x; d[1] = v[i].y; d[2] = v[i].z; d[3] = v[i].w; }
    asm volatile("s_waitcnt lgkmcnt(0)" ::: "memory");
    const int c = lane & 7;
#pragma unroll
    for (int j = 0; j < 4; ++j) { const int n = (lane >> 3) + 8 * j; const LAS float* s = scr + (8 * c) * 33 + n;
        u32x4 o; o.x = pk2(s[0 * 33], s[1 * 33]); o.y = pk2(s[2 * 33], s[3 * 33]); o.z = pk2(s[4 * 33], s[5 * 33]); o.w = pk2(s[6 * 33], s[7 * 33]);
        *(u32x4*)(WT + (size_t)(n0 + n) * K + k0 + 8 * c) = o; }
    asm volatile("s_waitcnt lgkmcnt(0)" ::: "memory");
}

__device__ __forceinline__ void phase_prologue(const Args& a, LAS unsigned char* lds, int tid, int lane, int wave, int G) {
    unsigned char* ws = a.ws;
    if ((int)blockIdx.x < 96) {
        const int item = blockIdx.x, layer = item / 48, g = item % 48, col = g * 64 + lane;
        const float* wm = a.in[9] + (size_t)layer * 1024 * 3072;
        const float* cctx = a.in[8]; const float* cc = a.in[2];
        float a0 = 0.f, a1 = 0.f, a2 = 0.f;
        const int k0 = wave * 128;
#pragma unroll 8
        for (int k = k0; k < k0 + 128; ++k) {
            const float wv = wm[(size_t)k * 3072 + col];
            a0 += silu(cctx[k]) * wv; a1 += silu(cc[k]) * wv; a2 += silu(cc[1024 + k]) * wv;
        }
        LAS float* red = (LAS float*)lds;
        red[(wave * 3 + 0) * 64 + lane] = a0; red[(wave * 3 + 1) * 64 + lane] = a1; red[(wave * 3 + 2) * 64 + lane] = a2;
        __syncthreads();
        if (tid < 192) { const int r = tid >> 6, l = tid & 63; float s = 0.f;
#pragma unroll
            for (int w = 0; w < 8; ++w) s += red[(w * 3 + r) * 64 + l];
            ((float*)(ws + WS_MOD))[(layer * 3 + r) * 3072 + g * 64 + l] = s + a.in[10][layer * 3072 + g * 64 + l]; }
        __syncthreads();
    }
    for (int idx = blockIdx.x * NT + tid; idx < 16384; idx += G * NT) { const int k = idx >> 4, j = idx & 15; ((float*)(ws + WS_GW))[j * 1024 + k] = a.in[27][(size_t)k * IN_ODD + IN_ODD_MAIN + j]; }
    for (int idx = blockIdx.x * NT + tid; idx < 4096 * 256; idx += G * NT) { const int n = idx >> 8, k = idx & 255, qn = n >> 10, c = n & 1023, qk = k >> 6, j = k & 63;
        float wv = 0.f; if (qn == qk) wv = (qn < 2 ? a.in[19] : a.in[21])[(size_t)((qn & 1) * 64 + j) * 1024 + c];
        ((bf16_t*)(ws + WS_W2B))[idx] = (bf16_t)f2bf(wv); }
    LAS float* scr = (LAS float*)(lds + wave * 16384);
    const int gw = blockIdx.x * NWAVES + wave, NGW = G * NWAVES;
    constexpr int I_E = 16 * 296, I_OE = 32 * 32, NITEMS = I_E + I_OE;
    for (int it = gw; it < NITEMS; it += NGW) {
        int r = it;
        if (r < I_E) { p0_transpose_item(a.in[13], IN_EVEN, 1024, 296, (bf16_t*)(ws + WS_WINE), scr, r, lane); continue; } r -= I_E;
        p0_transpose_item(a.in[14], 1024, 2048, 32, (bf16_t*)(ws + WS_WOUTE), scr, r, lane);
    }
}

__device__ __forceinline__ void modnorm_store(const f32x4 (&v)[4], const float* ng, const float* mod, bf16_t* orow, int lane, f32x4 (&h)[4]) {
    float s = 0.f;
#pragma unroll
    for (int j = 0; j < 4; ++j) s += (v[j].x * v[j].x + v[j].y * v[j].y) + (v[j].z * v[j].z + v[j].w * v[j].w);
    const float rstd = rsqrtf(wave_sum(s) * (1.f / 1024.f) + EPS);
#pragma unroll
    for (int j = 0; j < 4; ++j) { const int col = 4 * lane + 256 * j;
        const f32x4 g4 = *(const f32x4*)(ng + col), sh = *(const f32x4*)(mod + col), sc = *(const f32x4*)(mod + 1024 + col);
        h[j] = v[j] * rstd * g4 * (sc + 1.f) + sh;
        u32x2 o; o.x = pk2(h[j].x, h[j].y); o.y = pk2(h[j].z, h[j].w);
        *(u32x2*)(orow + col) = o; }
}

__device__ __forceinline__ void phase_modnorm0(const Args& a, int lane, int wave, int G) {
    const int gw = blockIdx.x * NWAVES + wave, NGW = G * NWAVES;
    const float* MOD = (const float*)(a.ws + WS_MOD);
    bf16_t* XN = (bf16_t*)(a.ws + WS_XN);
    for (int m = gw; m < NTOK; m += NGW) {
        int t, T, cr; tok_info(m, t, T, cr);
        const f32x4* xr = (const f32x4*)x_row(a, m) + lane;
        f32x4 v[4], h[4];
#pragma unroll
        for (int j = 0; j < 4; ++j) v[j] = xr[64 * j];
        modnorm_store(v, a.in[11], MOD + (0 * 3 + cr) * 3072, XN + (size_t)m * DM, lane, h);
    }
}

__device__ __forceinline__ float shiftv(const bf16_t* P, const float* mu, int m, int t, int T, int cc) {
    const bf16_t* p = P + (size_t)m * IN_EVEN + 5120 + cc;
    const float cur = bf2f(p[0]);
    const float prev = t > 0 ? bf2f(p[-IN_EVEN]) : 0.f;
    const float nxt = t < T - 1 ? bf2f(p[IN_EVEN]) : 0.f;
    return cur + mu[cc] * (prev - cur) + mu[3328 + cc] * (nxt - cur);
}
__device__ __forceinline__ void phase_rwkv_lr(const Args& a, int tid, int G) {
    const bf16_t* P = (const bf16_t*)(a.ws + WS_PROJ); bf16_t* LR = (bf16_t*)(a.ws + WS_LR); const float* mu = a.in[17];
    for (int idx = blockIdx.x * NT + tid; idx < NTOK * 256; idx += G * NT) { const int m = idx >> 8, jj = idx & 255;
        int t, T, cr; tok_info(m, t, T, cr);
        float val = shiftv(P, mu, m, t, T, 3072 + jj);
        if (jj < 128) val = 1.f - 2.f * __builtin_amdgcn_rcpf(1.f + __expf(2.f * val));
        LR[idx] = (bf16_t)f2bf(val); }
    bf16_t* RS = (bf16_t*)(a.ws + WS_RS); bf16_t* KS = (bf16_t*)(a.ws + WS_KS); bf16_t* KKS = (bf16_t*)(a.ws + WS_KKS); bf16_t* oV = (bf16_t*)(a.ws + WS_V);
    const int lane = tid & 63, gw = blockIdx.x * NWAVES + (tid >> 6), NGW = G * NWAVES;
    const int hc = (gw & 15) * 64 + lane;
    float m0c[3], m1c[3];
#pragma unroll
    for (int arr = 0; arr < 3; ++arr) { m0c[arr] = mu[arr * 1024 + hc]; m1c[arr] = mu[3328 + arr * 1024 + hc]; }
    const float kkw = a.in[22][hc];
    for (int item = gw; item < NTOK * 16; item += 2 * NGW) {
        unsigned raw[2][3][3]; float pm[2], nm[2]; int mm[2];
#pragma unroll
        for (int u = 0; u < 2; ++u) { const int it2 = item + u * NGW; const int m = it2 < NTOK * 16 ? (it2 >> 4) : (item >> 4); mm[u] = m;
            int t, T, cr; tok_info(m, t, T, cr);
            const int mp = t > 0 ? m - 1 : m, mn = t < T - 1 ? m + 1 : m; pm[u] = t > 0 ? 1.f : 0.f; nm[u] = t < T - 1 ? 1.f : 0.f;
#pragma unroll
            for (int arr = 0; arr < 3; ++arr) { const int col = 5120 + arr * 1024 + hc;
                raw[u][arr][0] = P[(size_t)mp * IN_EVEN + col]; raw[u][arr][1] = P[(size_t)m * IN_EVEN + col]; raw[u][arr][2] = P[(size_t)mn * IN_EVEN + col]; } }
        __builtin_amdgcn_sched_barrier(0);
#pragma unroll
        for (int u = 0; u < 2; ++u) { float x[3];
#pragma unroll
            for (int arr = 0; arr < 3; ++arr) { const float prev = bflo(raw[u][arr][0]) * pm[u], cur = bflo(raw[u][arr][1]), nxt = bflo(raw[u][arr][2]) * nm[u];
                x[arr] = cur + m0c[arr] * (prev - cur) + m1c[arr] * (nxt - cur); }
            const float kkr = x[1] * kkw; const float nrm = wave_sum(kkr * kkr);
            if (item + u * NGW < NTOK * 16) { const size_t o = (size_t)mm[u] * 1024 + hc;
                RS[o] = (bf16_t)f2bf(x[0]); KS[o] = (bf16_t)f2bf(x[1]); KKS[o] = (bf16_t)f2bf(kkr / fmaxf(sqrtf(nrm), 1e-12f)); oV[o] = (bf16_t)f2bf(x[2]); } }
    }
}

typedef short s16x4g __attribute__((ext_vector_type(4)));
template <int PITCH>
__device__ __forceinline__ bf16x8 tr_frag_p(const LAS unsigned char* img, int rowb, int col0, int r16) {
    const LAS unsigned char* p = img + (rowb + (r16 >> 2)) * PITCH + (col0 + 4 * (r16 & 3)) * 2;
    const s16x4g t0 = __builtin_amdgcn_ds_read_tr16_b64_v4i16((LAS s16x4g*)p), t1 = __builtin_amdgcn_ds_read_tr16_b64_v4i16((LAS s16x4g*)(p + 4 * PITCH));
    return (bf16x8){t0[0], t0[1], t0[2], t0[3], t1[0], t1[1], t1[2], t1[3]};
}
constexpr int RW_RECSZ = 29184, RW_WL = 18432;
__device__ __forceinline__ void rwkv_chunk_job(const Args& a, LAS unsigned char* wl, int lane, int gtb, int h) {
    const bf16_t* U4 = (const bf16_t*)(a.ws + WS_U4);
    const bf16_t* RS = (const bf16_t*)(a.ws + WS_RS); const bf16_t* KS = (const bf16_t*)(a.ws + WS_KS); const bf16_t* KKS = (const bf16_t*)(a.ws + WS_KKS); const bf16_t* Vs = (const bf16_t*)(a.ws + WS_V);
    float* oBS = (float*)(a.ws + WS_BS);
    const int m0 = gtb * 32;
    const int hc = h * 64 + lane, q = lane >> 4, r16 = lane & 15;
    LAS unsigned char* X0 = wl; LAS unsigned char* X1 = wl + 4608; LAS unsigned char* X2 = wl + 9216; LAS unsigned char* X3 = wl + 13824;
    const float ka = a.in[23][hc], rk = a.in[24][hc];
    { u32x4 vp[4];
#pragma unroll
      for (int i = 0; i < 4; ++i) { const int p = lane + 64 * i; vp[i] = *(const u32x4*)(Vs + (size_t)(m0 + (p >> 3)) * 1024 + h * 64 + (p & 7) * 8); }
#pragma unroll
      for (int i = 0; i < 4; ++i) { const int p = lane + 64 * i; *(LAS u32x4*)(X0 + (p >> 3) * 144 + (p & 7) * 16) = vp[i]; }
#pragma unroll
      for (int vt = 0; vt < 4; ++vt) { const bf16x8 ff = tr_frag_p<144>(X0, 8 * q, 16 * vt, r16), fr = tr_frag_p<144>(X0, 24 - 8 * q, 16 * vt, r16);
          *(bf16x8*)(a.ws + WS_RWREC + (size_t)((gtb * 16 + h) * 2 + 0) * RW_RECSZ + (24 + vt) * 1024 + lane * 16) = ff;
          *(bf16x8*)(a.ws + WS_RWREC + (size_t)((gtb * 16 + h) * 2 + 1) * RW_RECSZ + (24 + vt) * 1024 + lane * 16) = (bf16x8){fr[7], fr[6], fr[5], fr[4], fr[3], fr[2], fr[1], fr[0]}; } }
#pragma unroll
    for (int dir = 0; dir < 2; ++dir) {
        unsigned char* rec = a.ws + WS_RWREC + (size_t)((gtb * 16 + h) * 2 + dir) * RW_RECSZ;
        const float w0c = a.in[18][dir * 1024 + hc], a0c = a.in[20][dir * 1024 + hc];
        float cum = 0.f;
        unsigned nlw[8], nav[8], nr[8], nk[8], nkk[8];
#define RW_JLOAD(jo_) do { _Pragma("unroll") for (int ji = 0; ji < 8; ++ji) { const int j = 8 * (jo_) + ji; const int t = dir ? 31 - j : j; \
            const bf16_t* up = U4 + (size_t)(m0 + t) * 4096 + dir * 1024 + hc; const size_t o = (size_t)(m0 + t) * 1024 + hc; \
            nlw[ji] = up[0]; nav[ji] = up[2048]; nr[ji] = RS[o]; nk[ji] = KS[o]; nkk[ji] = KKS[o]; } } while (0)
        RW_JLOAD(0);
#pragma unroll 1
        for (int jo = 0; jo < 4; ++jo) {
            float lw8[8], av8[8], r8[8], k8[8], kk8[8], bs8[8];
#pragma unroll
            for (int ji = 0; ji < 8; ++ji) { lw8[ji] = __uint_as_float(nlw[ji] << 16); av8[ji] = __uint_as_float(nav[ji] << 16); r8[ji] = __uint_as_float(nr[ji] << 16); k8[ji] = __uint_as_float(nk[ji] << 16); kk8[ji] = __uint_as_float(nkk[ji] << 16); }
            if (jo < 3) RW_JLOAD(jo + 1);
            __builtin_amdgcn_sched_barrier(0);
#pragma unroll
            for (int ji = 0; ji < 8; ++ji) { const int j = 8 * jo + ji;
                const float lw = -0.60653066f * sigm(w0c + lw8[ji]), av = sigm(a0c + av8[ji]);
                const float cprev = cum; cum += lw;
                const float kka = kk8[ji] * av, kd = k8[ji] * (1.f + (av - 1.f) * ka);
                bs8[ji] = r8[ji] * kd * rk;
                const float ei = __expf(-cum);
                *(LAS unsigned short*)(X0 + j * 144 + lane * 2) = (unsigned short)f2bf(__expf(cprev) * kk8[ji]);
                *(LAS unsigned short*)(X3 + j * 144 + lane * 2) = (unsigned short)f2bf(__expf(cum) * r8[ji]);
                *(LAS unsigned short*)(X1 + j * 144 + lane * 2) = (unsigned short)f2bf(-kka * ei);
                *(LAS unsigned short*)(X2 + j * 144 + lane * 2) = (unsigned short)f2bf(kd * ei); }
#pragma unroll
            for (int ji = 0; ji < 8; ++ji) { const int j = 8 * jo + ji; const int t = dir ? 31 - j : j; const float bs = wave_sum(bs8[ji]);
                if (lane == 0) oBS[(size_t)dir * NTOK * 16 + (size_t)(m0 + t) * 16 + h] = bs; }
        }
#undef RW_JLOAD
        const float wend = __expf(cum);
        *(float*)(rec + 28672 + lane * 4) = wend;
#define RWF(X, rt, ks) (*(const LAS bf16x8*)((X) + (16 * (rt) + r16) * 144 + (32 * (ks) + 8 * q) * 2))
        f32x4 A1[3], A2T[3], B1[3], B2[3];
#pragma unroll
        for (int tl = 0; tl < 3; ++tl) { const int jt = tl > 0 ? 1 : 0, it = tl == 2 ? 1 : 0;
            f32x4 c1 = (f32x4){0.f, 0.f, 0.f, 0.f}, c2 = c1, c3 = c1, c4 = c1;
#pragma unroll
            for (int ks = 0; ks < 2; ++ks) { const bf16x8 kbj = RWF(X0, jt, ks), rbj = RWF(X3, jt, ks), aci = RWF(X1, it, ks), bci = RWF(X2, it, ks);
                c1 = __builtin_amdgcn_mfma_f32_16x16x32_bf16(kbj, aci, c1, 0, 0, 0);
                c2 = __builtin_amdgcn_mfma_f32_16x16x32_bf16(bci, kbj, c2, 0, 0, 0);
                c3 = __builtin_amdgcn_mfma_f32_16x16x32_bf16(rbj, aci, c3, 0, 0, 0);
                c4 = __builtin_amdgcn_mfma_f32_16x16x32_bf16(rbj, bci, c4, 0, 0, 0); }
#pragma unroll
            for (int rr = 0; rr < 4; ++rr) { const int jrow = 16 * jt + 4 * q + rr, icol = 16 * it + r16;
                c1[rr] = (icol < jrow) ? c1[rr] : 0.f; c3[rr] = (icol <= jrow) ? c3[rr] : 0.f; c4[rr] = (icol <= jrow) ? c4[rr] : 0.f;
                const int irow = 16 * it + 4 * q + rr, jcol = 16 * jt + r16;
                c2[rr] = (irow < jcol) ? c2[rr] : 0.f; }
            A1[tl] = c1; A2T[tl] = c2; B1[tl] = c3; B2[tl] = c4; }
#pragma unroll
        for (int jt = 0; jt < 2; ++jt)
#pragma unroll
            for (int ks = 0; ks < 2; ++ks) { *(bf16x8*)(rec + (jt * 2 + ks) * 1024 + lane * 16) = RWF(X0, jt, ks); *(bf16x8*)(rec + (4 + jt * 2 + ks) * 1024 + lane * 16) = RWF(X3, jt, ks); }
#pragma unroll
        for (int kt = 0; kt < 4; ++kt) { const float we = __shfl(wend, 16 * kt + r16);
            const u32x4 ra = __builtin_bit_cast(u32x4, tr_frag_p<144>(X1, 8 * q, 16 * kt, r16)), rb = __builtin_bit_cast(u32x4, tr_frag_p<144>(X2, 8 * q, 16 * kt, r16));
            u32x4 wa, wb;
#pragma unroll
            for (int x = 0; x < 4; ++x) { wa[x] = pk2(bflo(ra[x]) * we, bfhi(ra[x]) * we); wb[x] = pk2(bflo(rb[x]) * we, bfhi(rb[x]) * we); }
            *(u32x4*)(rec + (16 + kt) * 1024 + lane * 16) = wa;
            *(u32x4*)(rec + (20 + kt) * 1024 + lane * 16) = wb; }
#undef RWF
        LAS float* AS = (LAS float*)X0;
#pragma unroll
        for (int tl = 0; tl < 3; ++tl) { const int jt = tl > 0 ? 1 : 0, it = tl == 2 ? 1 : 0;
#pragma unroll
            for (int rr = 0; rr < 4; ++rr) AS[(16 * jt + 4 * q + rr) * 33 + 16 * it + r16] = A1[tl][rr]; }
#pragma unroll
        for (int rr = 0; rr < 4; ++rr) AS[(4 * q + rr) * 33 + 16 + r16] = 0.f;
        { const int col = lane & 31; float Tr[32];
#pragma unroll
          for (int j = 0; j < 32; ++j) { const float rowv = AS[j * 33 + col]; float acc = (col == j) ? 1.f : 0.f;
#pragma unroll
              for (int i = 0; i < j; ++i) acc += __uint_as_float((unsigned)__builtin_amdgcn_readlane((int)__float_as_uint(rowv), i)) * Tr[i];
              Tr[j] = acc;
              if (lane < 32) *(LAS unsigned short*)(X1 + j * 80 + col * 2) = (unsigned short)f2bf(acc); } }
#pragma unroll
        for (int tl = 0; tl < 3; ++tl) { const int it = tl == 2 ? 1 : 0, jt = tl > 0 ? 1 : 0;
#pragma unroll
            for (int rr = 0; rr < 4; ++rr) *(LAS unsigned short*)(X2 + (16 * it + 4 * q + rr) * 80 + (16 * jt + r16) * 2) = (unsigned short)f2bf(A2T[tl][rr]); }
#pragma unroll
        for (int rr = 0; rr < 4; ++rr) *(LAS unsigned short*)(X2 + (16 + 4 * q + rr) * 80 + r16 * 2) = (unsigned short)0;
        { bf16x8 tf[2], af[2];
#pragma unroll
          for (int x = 0; x < 2; ++x) { tf[x] = *(const LAS bf16x8*)(X1 + (16 * x + r16) * 80 + 8 * q * 2); af[x] = *(const LAS bf16x8*)(X2 + (16 * x + r16) * 80 + 8 * q * 2);
              *(bf16x8*)(rec + (8 + x) * 1024 + lane * 16) = tf[x]; }
#pragma unroll
          for (int jt = 0; jt < 2; ++jt)
#pragma unroll
              for (int it = 0; it < 2; ++it) { f32x4 c = (f32x4){0.f, 0.f, 0.f, 0.f}; c = __builtin_amdgcn_mfma_f32_16x16x32_bf16(tf[jt], af[it], c, 0, 0, 0);
#pragma unroll
                  for (int rr = 0; rr < 4; ++rr) *(LAS unsigned short*)(X3 + (16 * jt + 4 * q + rr) * 80 + (16 * it + r16) * 2) = (unsigned short)f2bf(c[rr]); } }
#pragma unroll
        for (int x = 0; x < 2; ++x) *(bf16x8*)(rec + (10 + x) * 1024 + lane * 16) = *(const LAS bf16x8*)(X3 + (16 * x + r16) * 80 + 8 * q * 2);
#pragma unroll
        for (int which = 0; which < 2; ++which) {
#pragma unroll
            for (int tl = 0; tl < 3; ++tl) { const int jt = tl > 0 ? 1 : 0, it = tl == 2 ? 1 : 0;
#pragma unroll
                for (int rr = 0; rr < 4; ++rr) *(LAS unsigned short*)(X3 + (16 * jt + 4 * q + rr) * 80 + (16 * it + r16) * 2) = (unsigned short)f2bf(which ? B2[tl][rr] : B1[tl][rr]); }
#pragma unroll
            for (int rr = 0; rr < 4; ++rr) *(LAS unsigned short*)(X3 + (4 * q + rr) * 80 + (16 + r16) * 2) = (unsigned short)0;
#pragma unroll
            for (int x = 0; x < 2; ++x) *(bf16x8*)(rec + (12 + 2 * which + x) * 1024 + lane * 16) = *(const LAS bf16x8*)(X3 + (16 * x + r16) * 80 + 8 * q * 2);
        }
    }
}
__device__ __forceinline__ void phase_rwkv_chunks(const Args& a, LAS unsigned char* lds, int lane, int wave, int G) {
    const int gw = blockIdx.x * NWAVES + wave, NGW = G * NWAVES;
    for (int job = gw; job < 256 * 16; job += NGW) rwkv_chunk_job(a, lds + wave * RW_WL, lane, job >> 4, job & 15);
}

constexpr int HP_QA = 0, HP_KT = 8704, HP_TOT = 17408;
__device__ __forceinline__ void hgrn_pre_load(const Args& a, int tid, int gtb, int h, int dir, unsigned (&pq)[8], unsigned (&pf)[8]) {
    const bf16_t* P = (const bf16_t*)(a.ws + WS_PROJ);
    const int m0 = gtb * 32, ch = tid & 127, tq = tid >> 7; const int fcol = (dir ? 3072 : 2048) + h * 128 + ch;
#pragma unroll
    for (int i = 0; i < 8; ++i) { const int ii = 8 * tq + i; const int t = dir ? 31 - ii : ii; const bf16_t* row = P + (size_t)(m0 + t) * IN_EVEN; pq[i] = row[h * 128 + ch]; pf[i] = row[fcol]; }
}
__device__ __forceinline__ void hgrn_pre_job(const Args& a, LAS unsigned char* lds, int tid, int gtb, int h, int dir, const unsigned (&pq)[8], const unsigned (&pf)[8]) {
    bf16_t* QA = (bf16_t*)(a.ws + (dir ? WS_HQA1 : WS_HQA0)); bf16_t* KT = (bf16_t*)(a.ws + (dir ? WS_HKT1 : WS_HKT0));
    float* SC = (float*)(a.ws + WS_HSC) + (size_t)(dir * 256 + gtb) * 3072;
    const int m0 = gtb * 32, ch = tid & 127, tq = tid >> 7;
    LAS unsigned char* Qi = lds + HP_QA; LAS unsigned char* Ki = lds + HP_KT; LAS float* tot = (LAS float*)(lds + HP_TOT);
    const float l0 = a.in[15][h * 128 + ch], l1 = a.in[15][1024 + h * 128 + ch];
    const float lb = 1.f / (1.f + __expf(l1 - l0));
    float bl[8], kv[8]; float run = 0.f;
#pragma unroll
    for (int i = 0; i < 8; ++i) { const float f = lb + (1.f - lb) * sigm(bflo(pf[i])); run += __logf(f); bl[i] = run; kv[i] = 1.f - f; }
    tot[tq * 128 + ch] = run;
    __syncthreads();
    { const float t0 = tot[ch], t1 = tot[128 + ch], t2 = tot[256 + ch], t3 = tot[384 + ch];
      const float off = tq == 0 ? 0.f : (tq == 1 ? t0 : (tq == 2 ? t0 + t1 : t0 + t1 + t2));
      const float bmid = t0 + t1, bend = (t0 + t1) + (t2 + t3);
#pragma unroll
      for (int i = 0; i < 8; ++i) { const float b = off + bl[i]; const int s = 8 * tq + i;
          const float ek = __expf(bmid - b), ea = __builtin_amdgcn_rcpf(ek);
          *(LAS unsigned short*)(Qi + s * 272 + ch * 2) = (unsigned short)f2bf(bflo(pq[i]) * ea);
          *(LAS unsigned short*)(Ki + s * 272 + ch * 2) = (unsigned short)f2bf(kv[i] * ek); }
      if (tq == 0) { SC[h * 128 + ch] = __expf(bmid); SC[1024 + h * 128 + ch] = __expf(bend); SC[2048 + h * 128 + ch] = __expf(bend - bmid); } }
    __syncthreads();
    { const int s = tid >> 4, dc = tid & 15; const size_t o = (size_t)(m0 + s) * 1024 + h * 128 + dc * 8;
      *(u32x4*)(QA + o) = *(const LAS u32x4*)(Qi + s * 272 + dc * 16); *(u32x4*)(KT + o) = *(const LAS u32x4*)(Ki + s * 272 + dc * 16); }
    __syncthreads();
}
__device__ __forceinline__ void hgrn_pre_bundle(const Args& a, LAS unsigned char* lds, int tid, int job0) {
    unsigned qA[8], fA[8], qB[8], fB[8];
#define HP_DEC(j) ((j) >> 4), (((j) >> 1) & 7), ((j) & 1)
    hgrn_pre_load(a, tid, HP_DEC(job0), qA, fA);
#pragma unroll 1
    for (int i = 0; i < 16; i += 2) {
        hgrn_pre_load(a, tid, HP_DEC(job0 + i + 1), qB, fB);
        hgrn_pre_job(a, lds, tid, HP_DEC(job0 + i), qA, fA);
        if (i + 2 < 16) hgrn_pre_load(a, tid, HP_DEC(job0 + i + 2), qA, fA);
        hgrn_pre_job(a, lds, tid, HP_DEC(job0 + i + 1), qB, fB);
    }
#undef HP_DEC
}

constexpr int HG_IMG = 0  , HG_ST = 52224, HG_PM = 87040;
typedef short s16x4h __attribute__((ext_vector_type(4)));
__device__ __forceinline__ bf16x8 tr_frag(const LAS unsigned char* img, int row0, int col0, int q, int r16) {
    const LAS unsigned char* p = img + (row0 + 8 * q + (r16 >> 2)) * 272 + (col0 + 4 * (r16 & 3)) * 2;
    const s16x4h t0 = __builtin_amdgcn_ds_read_tr16_b64_v4i16((LAS s16x4h*)p), t1 = __builtin_amdgcn_ds_read_tr16_b64_v4i16((LAS s16x4h*)(p + 4 * 272));
    return (bf16x8){t0[0], t0[1], t0[2], t0[3], t1[0], t1[1], t1[2], t1[3]};
}
__device__ __forceinline__ void hgrn_task(const Args& a, LAS unsigned char* lds, int tid, int seq, int is_sample, int dir, int h) {
    const bf16_t* P = (const bf16_t*)(a.ws + WS_PROJ);
    const bf16_t* QA = (const bf16_t*)(a.ws + (dir ? WS_HQA1 : WS_HQA0)); const bf16_t* KT = (const bf16_t*)(a.ws + (dir ? WS_HKT1 : WS_HKT0));
    const float* SCb = (const float*)(a.ws + WS_HSC) + (size_t)dir * 256 * 3072;
    bf16_t* O = (bf16_t*)(a.ws + (dir ? WS_OB : WS_OF));
    const int T = is_sample ? 2048 : 256, base = is_sample ? 4096 + seq * 2048 : seq * 256, nch = T / 32, gtb0 = base / 32;
    const int lane = tid & 63, w = __builtin_amdgcn_readfirstlane(tid >> 6), q = lane >> 4, r16 = lane & 15;
    LAS unsigned char* St = lds + HG_ST; LAS unsigned char* Pm = lds + HG_PM;
    f32x4 Sacc[8];
    if (is_sample) { const float* s0 = a.in[3] + ((size_t)((seq * 2 + dir) * 8 + h) * 128) * 128;
#pragma unroll
        for (int j = 0; j < 8; ++j)
#pragma unroll
            for (int r = 0; r < 4; ++r) Sacc[j][r] = s0[(size_t)(16 * w + 4 * q + r) * 128 + 16 * j + r16];
    } else {
#pragma unroll
        for (int j = 0; j < 8; ++j) Sacc[j] = (f32x4){0.f, 0.f, 0.f, 0.f};
    }
#define HG_GTB(c) (gtb0 + (dir ? nch - 1 - (c) : (c)))
#define HG_SCAL(dst, c, which) do { const float* sp = SCb + (size_t)HG_GTB(c) * 3072 + (which) * 1024 + h * 128 + 16 * w + 4 * q; const f32x4 v4 = *(const f32x4*)sp; dst[0] = v4.x; dst[1] = v4.y; dst[2] = v4.z; dst[3] = v4.w; } while (0)
#define HG_STORE_ST(scl) do { _Pragma("unroll") for (int j = 0; j < 8; ++j) { u32x2 pk; pk.x = pk2(Sacc[j][0] * scl[0], Sacc[j][1] * scl[1]); pk.y = pk2(Sacc[j][2] * scl[2], Sacc[j][3] * scl[3]); \
        *(LAS u32x2*)(St + (16 * j + r16) * 272 + (16 * w + 4 * q) * 2) = pk; } } while (0)
    const int ps = tid >> 4, pdc = tid & 15;
#define HG_LOADIMG(rq, rk, rv, c) do { const int gb = HG_GTB(c); const size_t o = (size_t)(gb * 32 + ps) * 1024 + h * 128 + pdc * 8; rq = *(const u32x4*)(QA + o); rk = *(const u32x4*)(KT + o); \
        rv = *(const u32x4*)(P + (size_t)(gb * 32 + (dir ? 31 - ps : ps)) * IN_EVEN + 1024 + h * 128 + pdc * 8); } while (0)
#define HG_WRITE(rq, rk, rv, buf) do { LAS unsigned char* ib = lds + HG_IMG + (buf) * 26112 + ps * 272 + pdc * 16; *(LAS u32x4*)ib = rq; *(LAS u32x4*)(ib + 8704) = rk; *(LAS u32x4*)(ib + 17408) = rv; } while (0)
#define HG_BUNDLE(X, c) do { if ((c) < nch) { HG_SCAL(ebe##X, c, 1); HG_SCAL(ecc##X, c, 2); if ((c) + 1 < nch) { HG_SCAL(ebm##X, (c) + 1, 0); HG_LOADIMG(rq##X, rk##X, rv##X, (c) + 1); } } } while (0)
    u32x4 rqA, rkA, rvA, rqB, rkB, rvB; float ebeA[4], eccA[4], ebmA[4], ebeB[4], eccB[4], ebmB[4];
    rqA = rkA = rvA = rqB = rkB = rvB = (u32x4){0u, 0u, 0u, 0u};
#pragma unroll
    for (int r = 0; r < 4; ++r) { ebeA[r] = eccA[r] = ebmA[r] = ebeB[r] = eccB[r] = ebmB[r] = 0.f; }
    { float e0[4]; HG_SCAL(e0, 0, 0); u32x4 q0, k0, v0; HG_LOADIMG(q0, k0, v0, 0); HG_STORE_ST(e0); HG_WRITE(q0, k0, v0, 0); }
    HG_BUNDLE(A, 0); HG_BUNDLE(B, 1);
#define HG_CHUNK(X, c) do { \
        const LAS unsigned char* Qi = lds + HG_IMG + ((c) & 1) * 26112; const LAS unsigned char* Ki = Qi + 8704; const LAS unsigned char* Vi = Qi + 17408; \
        __syncthreads();                                             \
        if (w < 3) { const int tt = w > 0 ? 1 : 0, ss = w == 2 ? 1 : 0; \
            f32x4 s4 = (f32x4){0.f, 0.f, 0.f, 0.f}; \
            _Pragma("unroll") for (int ks = 0; ks < 4; ++ks) { const bf16x8 af = *(const LAS bf16x8*)(Qi + (16 * tt + r16) * 272 + (32 * ks + 8 * q) * 2); const bf16x8 bf = *(const LAS bf16x8*)(Ki + (16 * ss + r16) * 272 + (32 * ks + 8 * q) * 2); \
                s4 = __builtin_amdgcn_mfma_f32_16x16x32_bf16(af, bf, s4, 0, 0, 0); } \
            _Pragma("unroll") for (int r = 0; r < 4; ++r) { const int trow = 16 * tt + 4 * q + r, scol = 16 * ss + r16; \
                *(LAS unsigned short*)(Pm + trow * 80 + scol * 2) = (unsigned short)((scol <= trow) ? f2bf(s4[r]) : 0u); } \
        } else if (w == 3) { \
            _Pragma("unroll") for (int r = 0; r < 4; ++r) *(LAS unsigned short*)(Pm + (4 * q + r) * 80 + (16 + r16) * 2) = (unsigned short)0; \
        } \
        f32x4 oacc[2]; \
        _Pragma("unroll") for (int tt = 0; tt < 2; ++tt) { oacc[tt] = (f32x4){0.f, 0.f, 0.f, 0.f}; \
            _Pragma("unroll") for (int ks = 0; ks < 4; ++ks) { const bf16x8 af = *(const LAS bf16x8*)(Qi + (16 * tt + r16) * 272 + (32 * ks + 8 * q) * 2); const bf16x8 bf = *(const LAS bf16x8*)(St + (16 * w + r16) * 272 + (32 * ks + 8 * q) * 2); \
                oacc[tt] = __builtin_amdgcn_mfma_f32_16x16x32_bf16(af, bf, oacc[tt], 0, 0, 0); } } \
        bf16x8 vf[8]; \
        _Pragma("unroll") for (int j = 0; j < 8; ++j) vf[j] = tr_frag(Vi, 0, 16 * j, q, r16); \
        const bf16x8 kta = tr_frag(Ki, 0, 16 * w, q, r16); \
        __syncthreads();                                             \
        { const bf16x8 vown = tr_frag(Vi, 0, 16 * w, q, r16);        \
          _Pragma("unroll") for (int tt = 0; tt < 2; ++tt) { const bf16x8 pf_ = *(const LAS bf16x8*)(Pm + (16 * tt + r16) * 80 + q * 16); \
              oacc[tt] = __builtin_amdgcn_mfma_f32_16x16x32_bf16(pf_, vown, oacc[tt], 0, 0, 0); \
              _Pragma("unroll") for (int r = 0; r < 4; ++r) { const int ii = (c) * 32 + 16 * tt + 4 * q + r; const int t = dir ? (T - 1 - ii) : ii; \
                  O[(size_t)(base + t) * 1024 + h * 128 + 16 * w + r16] = (bf16_t)f2bf(oacc[tt][r]); } } } \
        _Pragma("unroll") for (int j = 0; j < 8; ++j) { f32x4 t4 = (f32x4){0.f, 0.f, 0.f, 0.f}; t4 = __builtin_amdgcn_mfma_f32_16x16x32_bf16(kta, vf[j], t4, 0, 0, 0); \
            _Pragma("unroll") for (int r = 0; r < 4; ++r) Sacc[j][r] = ebe##X[r] * Sacc[j][r] + ecc##X[r] * t4[r]; } \
        if ((c) + 1 < nch) { HG_STORE_ST(ebm##X); HG_WRITE(rq##X, rk##X, rv##X, ((c) + 1) & 1); } \
        HG_BUNDLE(X, (c) + 2); \
    } while (0)
    for (int c = 0; c < nch; c += 2) { HG_CHUNK(A, c); HG_CHUNK(B, c + 1); }
#undef HG_CHUNK
#undef HG_BUNDLE
#undef HG_LOADIMG
#undef HG_WRITE
#undef HG_SCAL
#undef HG_GTB
#undef HG_STORE_ST
    if (!is_sample) { float* so = a.out + OUT_HGRN + ((size_t)((seq * 2 + dir) * 8 + h) * 128) * 128;
#pragma unroll
        for (int j = 0; j < 8; ++j)
#pragma unroll
            for (int r = 0; r < 4; ++r) so[(size_t)(16 * w + 4 * q + r) * 128 + 16 * j + r16] = Sacc[j][r]; }
    __syncthreads();
}

__device__ __forceinline__ void rwkv_scan_wave(const Args& a, LAS unsigned char* wl, int lane, int rid, int is_sample, int vt) {
    const int h = rid & 15, dir = (rid >> 4) & 1, seq = rid >> 5;
    const int T = is_sample ? 2048 : 256, base = is_sample ? 4096 + seq * 2048 : seq * 256;
    const int nblk = T / 32, gtb0 = base / 32;
    const int q = lane >> 4, r16 = lane & 15;
    LAS unsigned char* SA = wl; LAS unsigned char* UA = wl + 2304;
    bf16_t* Y = (bf16_t*)(a.ws + (dir ? WS_YB : WS_YF));
    f32x4 S[4];
    if (is_sample) { const float* sp = a.in[4] + (size_t)((seq * 2 + dir) * 16 + h) * 4096;
#pragma unroll
        for (int kt = 0; kt < 4; ++kt)
#pragma unroll
            for (int r = 0; r < 4; ++r) S[kt][r] = sp[(size_t)(16 * vt + 4 * q + r) * 64 + 16 * kt + r16];
    } else {
#pragma unroll
        for (int kt = 0; kt < 4; ++kt) S[kt] = (f32x4){0.f, 0.f, 0.f, 0.f};
    }
#define RW_REC(c) (a.ws + WS_RWREC + (size_t)(((gtb0 + (dir ? nblk - 1 - (c) : (c))) * 16 + h) * 2 + dir) * RW_RECSZ)
#define RW_FR(rec, f) (*(const bf16x8*)((rec) + (f) * 1024 + lane * 16))
    bf16x8 Kf[4], Rf[4], Tf[2], TAf[2], B1f[2], B2f[2], Af[4], Bf[4], VA; float we[4];
    { const unsigned char* rec = RW_REC(0);
#pragma unroll
      for (int x = 0; x < 4; ++x) { Kf[x] = RW_FR(rec, x); Rf[x] = RW_FR(rec, 4 + x); Af[x] = RW_FR(rec, 16 + x); Bf[x] = RW_FR(rec, 20 + x); we[x] = *(const float*)(rec + 28672 + (16 * x + r16) * 4); }
#pragma unroll
      for (int x = 0; x < 2; ++x) { Tf[x] = RW_FR(rec, 8 + x); TAf[x] = RW_FR(rec, 10 + x); B1f[x] = RW_FR(rec, 12 + x); B2f[x] = RW_FR(rec, 14 + x); }
      VA = RW_FR(rec, 24 + vt); }
    for (int c = 0; c < nblk; ++c) {
        const unsigned char* nrec = RW_REC(c + 1 < nblk ? c + 1 : c);
        const bf16x8 VAn = RW_FR(nrec, 24 + vt);
#pragma unroll
        for (int kt = 0; kt < 4; ++kt)
#pragma unroll
            for (int r = 0; r < 4; ++r) *(LAS unsigned short*)(SA + (4 * q + r) * 144 + (16 * kt + r16) * 2) = (unsigned short)f2bf(S[kt][r]);
        const bf16x8 sa0 = *(const LAS bf16x8*)(SA + r16 * 144 + (8 * q) * 2), sa1 = *(const LAS bf16x8*)(SA + r16 * 144 + (32 + 8 * q) * 2);
        f32x4 ut[2], yt[2];
#pragma unroll
        for (int jt = 0; jt < 2; ++jt) { ut[jt] = (f32x4){0.f, 0.f, 0.f, 0.f}; yt[jt] = ut[jt];
            ut[jt] = __builtin_amdgcn_mfma_f32_16x16x32_bf16(sa0, Kf[jt * 2], ut[jt], 0, 0, 0); ut[jt] = __builtin_amdgcn_mfma_f32_16x16x32_bf16(sa1, Kf[jt * 2 + 1], ut[jt], 0, 0, 0);
            yt[jt] = __builtin_amdgcn_mfma_f32_16x16x32_bf16(sa0, Rf[jt * 2], yt[jt], 0, 0, 0); yt[jt] = __builtin_amdgcn_mfma_f32_16x16x32_bf16(sa1, Rf[jt * 2 + 1], yt[jt], 0, 0, 0); }
#pragma unroll
        for (int x = 0; x < 4; ++x) { Kf[x] = RW_FR(nrec, x); Rf[x] = RW_FR(nrec, 4 + x); }
#pragma unroll
        for (int jt = 0; jt < 2; ++jt)
#pragma unroll
            for (int r = 0; r < 4; ++r) *(LAS unsigned short*)(UA + (4 * q + r) * 80 + (16 * jt + r16) * 2) = (unsigned short)f2bf(ut[jt][r]);
        const bf16x8 ua0 = *(const LAS bf16x8*)(UA + r16 * 80 + 8 * q * 2);
        f32x4 u2[2];
#pragma unroll
        for (int jt = 0; jt < 2; ++jt) { u2[jt] = (f32x4){0.f, 0.f, 0.f, 0.f};
            u2[jt] = __builtin_amdgcn_mfma_f32_16x16x32_bf16(ua0, Tf[jt], u2[jt], 0, 0, 0); u2[jt] = __builtin_amdgcn_mfma_f32_16x16x32_bf16(VA, TAf[jt], u2[jt], 0, 0, 0); }
#pragma unroll
        for (int x = 0; x < 2; ++x) { Tf[x] = RW_FR(nrec, 8 + x); TAf[x] = RW_FR(nrec, 10 + x); }
#pragma unroll
        for (int jt = 0; jt < 2; ++jt)
#pragma unroll
            for (int r = 0; r < 4; ++r) *(LAS unsigned short*)(UA + (4 * q + r) * 80 + (16 * jt + r16) * 2) = (unsigned short)f2bf(u2[jt][r]);
        const bf16x8 ua1 = *(const LAS bf16x8*)(UA + r16 * 80 + 8 * q * 2);
#pragma unroll
        for (int jt = 0; jt < 2; ++jt) { yt[jt] = __builtin_amdgcn_mfma_f32_16x16x32_bf16(ua1, B1f[jt], yt[jt], 0, 0, 0); yt[jt] = __builtin_amdgcn_mfma_f32_16x16x32_bf16(VA, B2f[jt], yt[jt], 0, 0, 0); }
#pragma unroll
        for (int x = 0; x < 2; ++x) { B1f[x] = RW_FR(nrec, 12 + x); B2f[x] = RW_FR(nrec, 14 + x); }
        { const int tb = dir ? nblk - 1 - c : c;
#pragma unroll
          for (int jt = 0; jt < 2; ++jt) { const int j = 16 * jt + r16; const int tl = dir ? 31 - j : j;
              *(u32x2*)(Y + (size_t)(base + tb * 32 + tl) * 1024 + h * 64 + 16 * vt + 4 * q) = (u32x2){pk2(yt[jt][0], yt[jt][1]), pk2(yt[jt][2], yt[jt][3])}; } }
#pragma unroll
        for (int kt = 0; kt < 4; ++kt) { S[kt] *= we[kt];
            S[kt] = __builtin_amdgcn_mfma_f32_16x16x32_bf16(ua1, Af[kt], S[kt], 0, 0, 0); S[kt] = __builtin_amdgcn_mfma_f32_16x16x32_bf16(VA, Bf[kt], S[kt], 0, 0, 0); }
#pragma unroll
        for (int x = 0; x < 4; ++x) { Af[x] = RW_FR(nrec, 16 + x); Bf[x] = RW_FR(nrec, 20 + x); we[x] = *(const float*)(nrec + 28672 + (16 * x + r16) * 4); }
        VA = VAn;
    }
#undef RW_REC
#undef RW_FR
    if (!is_sample) { float* so = a.out + OUT_RWKV + (size_t)((seq * 2 + dir) * 16 + h) * 4096;
#pragma unroll
        for (int kt = 0; kt < 4; ++kt)
#pragma unroll
            for (int r = 0; r < 4; ++r) so[(size_t)(16 * vt + 4 * q + r) * 64 + 16 * kt + r16] = S[kt][r]; }
}

__device__ __forceinline__ int queue_pop(unsigned* head, volatile LAS unsigned* slot, int tid) {
    __syncthreads();
    if (tid == 0) slot[0] = __hip_atomic_fetch_add(head, 1u, __ATOMIC_RELAXED, __HIP_MEMORY_SCOPE_AGENT);
    __syncthreads();
    return (int)slot[0];
}

__device__ __forceinline__ void phase_scans_even(const Args& a, LAS unsigned char* lds, int tid, int qoff) {
    unsigned* head = (unsigned*)(a.ws + WS_CTL) + CW_Q0 + qoff;
    volatile LAS unsigned* slot = (volatile LAS unsigned*)(lds + MISC_OFF);
    const int lane = tid & 63, wave = __builtin_amdgcn_readfirstlane(tid >> 6);
    for (;;) {
        int task = queue_pop(head, slot, tid);
        if (task >= 1376) break;
        if (task >= 96 && task < 864) { LAS float* scr = (LAS float*)(lds + wave * 16384); const int r = (task - 96) * 8 + wave;
            if (r < 5120) p0_transpose_item(a.in[27], IN_ODD, 1024, 320, (bf16_t*)(a.ws + WS_WINO), scr, r, lane);
            else p0_transpose_item(a.in[28], 1024, 2048, 32, (bf16_t*)(a.ws + WS_WOUTO), scr, r - 5120, lane);
            continue; }
        if (task >= 864) task -= 768;
        const bool is_h = task < 32 || (task >= 96 && task < 352);
        if (is_h) { const int is_sample = task < 32; const int k = is_sample ? task : task - 96; hgrn_task(a, lds, tid, k >> 4, is_sample, (k >> 3) & 1, k & 7); }
        else if (task < 96) { if (wave < 4) rwkv_scan_wave(a, lds + wave * 4096, lane, task - 32, 1, wave); }
        else rwkv_scan_wave(a, lds + wave * 4096, lane, 2 * (task - 352) + (wave >> 2), 0, wave & 3);
    }
}

__device__ __forceinline__ void phase_combine_even(const Args& a, int lane, int wave, int G) {
    const int gw = blockIdx.x * NWAVES + wave, NGW = G * NWAVES;
    const bf16_t* OF = (const bf16_t*)(a.ws + WS_OF); const bf16_t* OB = (const bf16_t*)(a.ws + WS_OB);
    const bf16_t* YF = (const bf16_t*)(a.ws + WS_YF); const bf16_t* YB = (const bf16_t*)(a.ws + WS_YB);
    const bf16_t* P = (const bf16_t*)(a.ws + WS_PROJ); const bf16_t* V = (const bf16_t*)(a.ws + WS_V); const float* BS = (const float*)(a.ws + WS_BS);
    bf16_t* Yo = (bf16_t*)(a.ws + WS_Y);
    const int c0 = 16 * lane, hh = lane >> 2;
    f32x4 hg4[4], gg4[4], gb4[4];
#pragma unroll
    for (int q = 0; q < 4; ++q) { hg4[q] = *(const f32x4*)(a.in[16] + c0 + 4 * q); gg4[q] = *(const f32x4*)(a.in[25] + c0 + 4 * q); gb4[q] = *(const f32x4*)(a.in[26] + c0 + 4 * q); }
    for (int m = gw; m < NTOK; m += NGW) {
        f32x4 of[4], ob[4], yf[4], yb[4]; u32x4 za[2], zb[2], vv[2], rof[2], rob[2], ryf[2], ryb[2];
#pragma unroll
        for (int x = 0; x < 2; ++x) { rof[x] = *(const u32x4*)(OF + (size_t)m * 1024 + c0 + 8 * x); rob[x] = *(const u32x4*)(OB + (size_t)m * 1024 + c0 + 8 * x);
            ryf[x] = *(const u32x4*)(YF + (size_t)m * 1024 + c0 + 8 * x); ryb[x] = *(const u32x4*)(YB + (size_t)m * 1024 + c0 + 8 * x); }
#pragma unroll
        for (int x = 0; x < 2; ++x) { za[x] = *(const u32x4*)(P + (size_t)m * IN_EVEN + 4096 + c0 + 8 * x); zb[x] = *(const u32x4*)(P + (size_t)m * IN_EVEN + 8448 + c0 + 8 * x); vv[x] = *(const u32x4*)(V + (size_t)m * 1024 + c0 + 8 * x); }
#pragma unroll
        for (int q = 0; q < 4; ++q) { const int x = q >> 1, j = (q & 1) * 2;
            of[q] = (f32x4){bflo(rof[x][j]), bfhi(rof[x][j]), bflo(rof[x][j + 1]), bfhi(rof[x][j + 1])}; ob[q] = (f32x4){bflo(rob[x][j]), bfhi(rob[x][j]), bflo(rob[x][j + 1]), bfhi(rob[x][j + 1])};
            yf[q] = (f32x4){bflo(ryf[x][j]), bfhi(ryf[x][j]), bflo(ryf[x][j + 1]), bfhi(ryf[x][j + 1])}; yb[q] = (f32x4){bflo(ryb[x][j]), bfhi(ryb[x][j]), bflo(ryb[x][j + 1]), bfhi(ryb[x][j + 1])}; }
        const float bon = BS[(size_t)m * 16 + hh] + BS[(size_t)NTOK * 16 + (size_t)m * 16 + hh];
        float ss = 0.f;
#pragma unroll
        for (int q = 0; q < 4; ++q) { of[q] = of[q] + ob[q]; ss += (of[q].x * of[q].x + of[q].y * of[q].y) + (of[q].z * of[q].z + of[q].w * of[q].w); }
        const float rs = rsqrtf(oct_sum(ss) * (1.f / 128.f) + EPS);
        { unsigned w[8];
#pragma unroll
          for (int q = 0; q < 4; ++q) { const unsigned z01 = za[q >> 1][(q & 1) * 2], z23 = za[q >> 1][(q & 1) * 2 + 1]; const f32x4 o = of[q] * rs * hg4[q];
              w[2 * q] = pk2(o.x * silu(bflo(z01)), o.y * silu(bfhi(z01))); w[2 * q + 1] = pk2(o.z * silu(bflo(z23)), o.w * silu(bfhi(z23))); }
          u32x4* dst = (u32x4*)(Yo + (size_t)m * 2048 + c0);
          dst[0] = (u32x4){w[0], w[1], w[2], w[3]}; dst[1] = (u32x4){w[4], w[5], w[6], w[7]}; }
        float sm = 0.f;
#pragma unroll
        for (int q = 0; q < 4; ++q) { yf[q] = yf[q] + yb[q]; sm += (yf[q].x + yf[q].y) + (yf[q].z + yf[q].w); }
        const float mean = quad_sum(sm) * (1.f / 64.f); float sq = 0.f;
#pragma unroll
        for (int q = 0; q < 4; ++q) { yf[q] = yf[q] - mean; sq += (yf[q].x * yf[q].x + yf[q].y * yf[q].y) + (yf[q].z * yf[q].z + yf[q].w * yf[q].w); }
        const float rg = rsqrtf(quad_sum(sq) * (1.f / 64.f) + GN_EPS);
        { unsigned w[8];
#pragma unroll
          for (int q = 0; q < 4; ++q) { const unsigned z01 = zb[q >> 1][(q & 1) * 2], z23 = zb[q >> 1][(q & 1) * 2 + 1], v01 = vv[q >> 1][(q & 1) * 2], v23 = vv[q >> 1][(q & 1) * 2 + 1];
              const f32x4 g = yf[q] * rg * gg4[q] + gb4[q];
              w[2 * q] = pk2((g.x + bon * bflo(v01)) * silu(bflo(z01)), (g.y + bon * bfhi(v01)) * silu(bfhi(z01)));
              w[2 * q + 1] = pk2((g.z + bon * bflo(v23)) * silu(bflo(z23)), (g.w + bon * bfhi(v23)) * silu(bfhi(z23))); }
          u32x4* dst = (u32x4*)(Yo + (size_t)m * 2048 + 1024 + c0);
          dst[0] = (u32x4){w[0], w[1], w[2], w[3]}; dst[1] = (u32x4){w[4], w[5], w[6], w[7]}; }
    }
}

__device__ __forceinline__ void phase_res_modnorm1(const Args& a, int lane, int wave, int G) {
    const int gw = blockIdx.x * NWAVES + wave, NGW = G * NWAVES;
    const float* MOD = (const float*)(a.ws + WS_MOD); const bf16_t* PART = (const bf16_t*)(a.ws + WS_PART); const float* GW = (const float*)(a.ws + WS_GW);
    float* X1 = (float*)(a.ws + WS_X1); bf16_t* XN = (bf16_t*)(a.ws + WS_XN); float* GT = (float*)(a.ws + WS_GT);
    for (int m = gw; m < NTOK; m += NGW) {
        int t, T, cr; tok_info(m, t, T, cr);
        const f32x4* xr = (const f32x4*)x_row(a, m) + lane;
        const u32x2* p0 = (const u32x2*)(PART + (size_t)m * 1024) + lane; const u32x2* p1 = (const u32x2*)(PART + (size_t)NTOK * 1024 + (size_t)m * 1024) + lane;
        const f32x4* gt = (const f32x4*)(MOD + (0 * 3 + cr) * 3072 + 2048) + lane;
        f32x4 v[4], h[4];
#pragma unroll
        for (int j = 0; j < 4; ++j) { { const u32x2 a0 = p0[64 * j], a1 = p1[64 * j]; const f32x4 ps = (f32x4){bflo(a0.x) + bflo(a1.x), bfhi(a0.x) + bfhi(a1.x), bflo(a0.y) + bflo(a1.y), bfhi(a0.y) + bfhi(a1.y)}; v[j] = xr[64 * j] + gt[64 * j] * ps; } ((f32x4*)(X1 + (size_t)m * 1024))[lane + 64 * j] = v[j]; }
        modnorm_store(v, a.in[11] + 1024, MOD + (1 * 3 + cr) * 3072, XN + (size_t)m * DM, lane, h);
        float myg = 0.f;
#pragma unroll
        for (int jg = 0; jg < 16; ++jg) { float d = 0.f;
#pragma unroll
            for (int j = 0; j < 4; ++j) { const f32x4 w4 = *(const f32x4*)(GW + jg * 1024 + 4 * lane + 256 * j); d += (h[j].x * w4.x + h[j].y * w4.y) + (h[j].z * w4.z + h[j].w * w4.w); }
            d = wave_sum(d);
            if (lane == jg) myg = d; }
        if (lane < 16) GT[(size_t)m * 16 + lane] = myg + a.in[31][lane];
    }
}

__device__ __forceinline__ void conv_fma8(float (&acc)[8], const u32x4 x, const f32x4 w0, const f32x4 w1) {
    acc[0] += bflo(x.x) * w0.x; acc[1] += bfhi(x.x) * w0.y; acc[2] += bflo(x.y) * w0.z; acc[3] += bfhi(x.y) * w0.w;
    acc[4] += bflo(x.z) * w1.x; acc[5] += bfhi(x.z) * w1.y; acc[6] += bflo(x.w) * w1.z; acc[7] += bfhi(x.w) * w1.w;
}
__device__ __forceinline__ u32x4 conv_out8(const float (&acc)[8], float sc) {
    u32x4 o; o.x = pk2(silu(acc[0]) * sc, silu(acc[1]) * sc); o.y = pk2(silu(acc[2]) * sc, silu(acc[3]) * sc); o.z = pk2(silu(acc[4]) * sc, silu(acc[5]) * sc); o.w = pk2(silu(acc[6]) * sc, silu(acc[7]) * sc); return o;
}
__device__ __forceinline__ void phase_conv(const Args& a, int tid, int G) {
    const bf16_t* P = (const bf16_t*)(a.ws + WS_PROJ); bf16_t* QKC = (bf16_t*)(a.ws + WS_QKC);
    const float* cw = a.in[29]; const float* cb = a.in[30];
    const int c0 = tid * 8;
    const float sc = c0 >= 2048 ? 0.044194173824159216f : 1.f;
    const f32x4 b0 = *(const f32x4*)(cb + c0), b1 = *(const f32x4*)(cb + c0 + 4);
    const u32x4 zero4 = (u32x4){0u, 0u, 0u, 0u};
    for (int gtb = blockIdx.x; gtb < 256; gtb += G) {
        const int m0 = gtb * 32;
        if (m0 < 4096) {
            f32x4 w0[3], w1[3];
#pragma unroll
            for (int j = 0; j < 3; ++j) { w0[j] = *(const f32x4*)(cw + (size_t)(3 + j) * 4096 + c0); w1[j] = *(const f32x4*)(cw + (size_t)(3 + j) * 4096 + c0 + 4); }
            const int t0 = m0 & 255;
#pragma unroll 1
            for (int s8 = 0; s8 < 4; ++s8) { u32x4 x[10];
#pragma unroll
                for (int i = 0; i < 10; ++i) { const int t = t0 + 8 * s8 + i - 1; x[i] = (t >= 0 && t < 256) ? *(const u32x4*)(P + (size_t)(m0 + 8 * s8 + i - 1) * IN_ODD_MAIN + c0) : zero4; }
                __builtin_amdgcn_sched_barrier(0);
#pragma unroll
                for (int i = 0; i < 8; ++i) { float acc[8] = {b0.x, b0.y, b0.z, b0.w, b1.x, b1.y, b1.z, b1.w};
#pragma unroll
                    for (int j = 0; j < 3; ++j) conv_fma8(acc, x[i + j], w0[j], w1[j]);
                    *(u32x4*)(QKC + (size_t)(m0 + 8 * s8 + i) * 4096 + c0) = conv_out8(acc, sc); } }
        } else {
            f32x4 w0[9], w1[9];
#pragma unroll
            for (int j = 0; j < 9; ++j) { w0[j] = *(const f32x4*)(cw + (size_t)j * 4096 + c0); w1[j] = *(const f32x4*)(cw + (size_t)j * 4096 + c0 + 4); }
            const int tl = (m0 - 4096) & 2047, r = tl >> 6, cw0 = tl & 63;
#pragma unroll 1
            for (int s4 = 0; s4 < 8; ++s4) { u32x4 x[3][6];
#pragma unroll
                for (int i3 = 0; i3 < 3; ++i3)
#pragma unroll
                    for (int i = 0; i < 6; ++i) { const int rr = r + i3 - 1, cc = cw0 + 4 * s4 + i - 1;
                        x[i3][i] = (rr >= 0 && rr < 32 && cc >= 0 && cc < 64) ? *(const u32x4*)(P + (size_t)(m0 + (i3 - 1) * 64 + 4 * s4 + i - 1) * IN_ODD_MAIN + c0) : zero4; }
                __builtin_amdgcn_sched_barrier(0);
#pragma unroll
                for (int i = 0; i < 4; ++i) { float acc[8] = {b0.x, b0.y, b0.z, b0.w, b1.x, b1.y, b1.z, b1.w};
#pragma unroll
                    for (int i3 = 0; i3 < 3; ++i3)
#pragma unroll
                        for (int j = 0; j < 3; ++j) conv_fma8(acc, x[i3][i + j], w0[i3 * 3 + j], w1[i3 * 3 + j]);
                    *(u32x4*)(QKC + (size_t)(m0 + 4 * s4 + i) * 4096 + c0) = conv_out8(acc, sc); } }
        }
    }
}

constexpr int ML_RECSZ = 2560;
__device__ __forceinline__ float logsig(float x) { return fminf(x, 0.f) - log1pf(__expf(-fabsf(x))); }
__device__ __forceinline__ void mlstm_gate_scan(const Args& a, int lane, int rid) {
    const float* GT = (const float*)(a.ws + WS_GT); float* MP = (float*)(a.ws + WS_MP);
    const int is_sample = rid < 16, k = is_sample ? rid : rid - 16, h = k & 3, dir = (k >> 2) & 1, seq = k >> 3;
    const int T = is_sample ? 2048 : 256, base = is_sample ? 4096 + seq * 2048 : seq * 256, nch = T / 32;
    float B = 0.f, Gm = -3.0e38f;
    if (lane < nch) { float gi[32], gf[32];
#pragma unroll
        for (int i = 0; i < 32; ++i) { const int ii = lane * 32 + i; const int t = dir ? (T - 1 - ii) : ii; gi[i] = GT[(size_t)(base + t) * 16 + dir * 4 + h]; gf[i] = GT[(size_t)(base + t) * 16 + (2 + dir) * 4 + h]; }
#pragma unroll
        for (int i = 0; i < 32; ++i) { B += logsig(gf[i]); Gm = fmaxf(Gm, gi[i] - B); } }
    float m = is_sample ? a.in[7][(seq * 2 + dir) * 4 + h] : 0.f;
    for (int c = 0; c < nch; ++c) { const float Bc = __shfl(B, c), Gc = __shfl(Gm, c);
        if (lane == 0) MP[rid * 64 + c] = m;
        m = Bc + fmaxf(m, Gc); }
    if (!is_sample && lane == 0) a.out[OUT_M + (seq * 2 + dir) * 4 + h] = m;
}
__device__ __forceinline__ void mlstm_sp_job(const Args& a, LAS unsigned char* wl, int lane, int gtb, int h) {
    const bf16_t* QKC = (const bf16_t*)(a.ws + WS_QKC); const float* GT = (const float*)(a.ws + WS_GT); const float* MP = (const float*)(a.ws + WS_MP);
    const int m0 = gtb * 32, is_sample = m0 >= 4096;
    const int seq = is_sample ? (m0 - 4096) >> 11 : m0 >> 8, T = is_sample ? 2048 : 256, base = is_sample ? 4096 + seq * 2048 : seq * 256;
    const int tb = (m0 - base) >> 5, nblk = T / 32, q = lane >> 4, r16 = lane & 15;
    LAS unsigned char* PL = wl; LAS float* sc = (LAS float*)(wl + 2560);
    f32x4 S[2][2];
#pragma unroll
    for (int x = 0; x < 2; ++x)
#pragma unroll
        for (int y = 0; y < 2; ++y) S[x][y] = (f32x4){0.f, 0.f, 0.f, 0.f};
#pragma unroll 1
    for (int kg = 0; kg < 4; ++kg) { bf16x8 qf[2][4], kf[2][4];
#pragma unroll
        for (int x = 0; x < 2; ++x)
#pragma unroll
            for (int k4 = 0; k4 < 4; ++k4) { const bf16_t* row = QKC + (size_t)(m0 + 16 * x + r16) * 4096 + h * 512 + 32 * (4 * kg + k4) + 8 * q;
                qf[x][k4] = *(const bf16x8*)row; kf[x][k4] = *(const bf16x8*)(row + 2048); }
        __builtin_amdgcn_sched_barrier(0);
#pragma unroll
        for (int k4 = 0; k4 < 4; ++k4)
#pragma unroll
            for (int x = 0; x < 2; ++x)
#pragma unroll
                for (int y = 0; y < 2; ++y) S[x][y] = __builtin_amdgcn_mfma_f32_16x16x32_bf16(qf[x][k4], kf[y][k4], S[x][y], 0, 0, 0); }
#pragma unroll
    for (int dir = 0; dir < 2; ++dir) {
        const int rid = is_sample ? (seq * 2 + dir) * 4 + h : 16 + (seq * 2 + dir) * 4 + h, c = dir ? nblk - 1 - tb : tb;
        const float m_prev = MP[rid * 64 + c];
        unsigned char* rec = a.ws + WS_MLREC + (size_t)(rid * 64 + c) * ML_RECSZ;
        { const int i = lane & 31, t = dir ? 31 - i : i;
          const float li = GT[(size_t)(m0 + t) * 16 + dir * 4 + h], lf = logsig(GT[(size_t)(m0 + t) * 16 + (2 + dir) * 4 + h]);
          float b = lf;
#pragma unroll
          for (int o = 1; o < 32; o <<= 1) { const float x = __shfl_up(b, o, 32); if (i >= o) b += x; }
          const float g = li - b; float G = g;
#pragma unroll
          for (int o = 1; o < 32; o <<= 1) { const float x = __shfl_up(G, o, 32); if (i >= o) G = fmaxf(G, x); }
          const float M = fmaxf(m_prev, G), Mend = __shfl(M, 31);
          if (lane < 32) { sc[i] = g; sc[32 + i] = M;
              *(float*)(rec + 2048 + i * 4) = __expf(m_prev - M); *(float*)(rec + 2176 + i * 4) = __expf(g - Mend); *(float*)(rec + 2304 + i * 4) = __expf(-(b + M));
              if (lane == 0) *(float*)(rec + 2432) = __expf(m_prev - Mend); } }
#pragma unroll
        for (int x = 0; x < 2; ++x)
#pragma unroll
            for (int y = 0; y < 2; ++y)
#pragma unroll
                for (int r = 0; r < 4; ++r) { const int t = 16 * x + 4 * q + r, s = 16 * y + r16; const int i = dir ? 31 - t : t, j = dir ? 31 - s : s;
                    const float v = (j <= i) ? S[x][y][r] * __expf(sc[j] - sc[32 + i]) : 0.f;
                    *(LAS unsigned short*)(PL + i * 80 + j * 2) = (unsigned short)f2bf(v); }
#pragma unroll
        for (int x = 0; x < 2; ++x) *(bf16x8*)(rec + x * 1024 + lane * 16) = *(const LAS bf16x8*)(PL + (16 * x + r16) * 80 + 8 * q * 2);
    }
}
__device__ __forceinline__ void phase_mlstm_pre(const Args& a, LAS unsigned char* lds, int lane, int wave, int G) {
    const int gw = blockIdx.x * NWAVES + wave, NGW = G * NWAVES;
    for (int job = gw; job < 256 * 4; job += NGW) mlstm_sp_job(a, lds + wave * 3072, lane, job >> 2, job & 3);
}

constexpr int ML_PITCH = 1040;
#ifndef ML_TR
#define ML_TR 1
#endif
typedef short s16x4 __attribute__((ext_vector_type(4)));
constexpr int M2_QS = 0, M2_KS = 33280, M2_PS = 66560, M2_VT = 132096;
template <bool DEN>
__device__ __forceinline__ void mlstm_scan_task(const Args& a, LAS unsigned char* lds, int tid, int seq, int is_sample, int dir, int h, int sl) {
    constexpr int ne = DEN ? 1 : 4;
    const bf16_t* QKC = (const bf16_t*)(a.ws + WS_QKC); const bf16_t* P = (const bf16_t*)(a.ws + WS_PROJ);
    bf16_t* H = (bf16_t*)(a.ws + (dir ? WS_HB : WS_HF)); float* DN = (float*)(a.ws + WS_DEN) + (size_t)dir * NTOK * 4;
    const int T = is_sample ? 2048 : 256, base = is_sample ? 4096 + seq * 2048 : seq * 256, nch = T / 32;
    const int rid = is_sample ? (seq * 2 + dir) * 4 + h : 16 + (seq * 2 + dir) * 4 + h;
    const unsigned char* rec0 = a.ws + WS_MLREC + (size_t)rid * 64 * ML_RECSZ;
    asm volatile("" : "+v"(tid));
    const int lane = tid & 63, w = __builtin_amdgcn_readfirstlane(tid >> 6), tt = w & 1, et = w >> 1, q = lane >> 4, r16 = lane & 15;
    LAS unsigned char* Qs = lds + M2_QS; LAS unsigned char* Ks = lds + M2_KS; LAS unsigned char* PS = lds + M2_PS; LAS unsigned char* VT = lds + M2_VT;
    const size_t sb = (size_t)((seq * 2 + dir) * 4 + h);
    f32x4 Cacc[4][4];
    if (is_sample && !DEN) { const float* src = a.in[5] + (sb * 512) * 512 + sl * 64;
        for (int i = tid; i < 512 * 16; i += NT) { const int d = i >> 4, c4 = i & 15; *(LAS f32x4*)(lds + d * 272 + c4 * 16) = *(const f32x4*)(src + (size_t)d * 512 + 4 * c4); }
        __syncthreads(); }
#pragma unroll
    for (int dt = 0; dt < 4; ++dt)
#pragma unroll
        for (int e = 0; e < 4; ++e)
#pragma unroll
            for (int r = 0; r < 4; ++r) { float v = 0.f;
                if (is_sample) { if (DEN) { if (e == 0) v = (r16 == 0) ? a.in[6][sb * 512 + 64 * w + 16 * dt + 4 * q + r] : 0.f; }
                                 else v = *(const LAS float*)(lds + (64 * w + 16 * dt + 4 * q + r) * 272 + (16 * e + r16) * 4); }
                Cacc[dt][e][r] = v; }
    __syncthreads();
    if (DEN) { for (int i = tid; i < 5120; i += NT) ((LAS unsigned*)VT)[i] = 0u;
        __syncthreads();
        if (tid < 80) *(LAS unsigned short*)(VT + (tid >= 40 ? 10240 : 0) + (tid % 40) * 2) = (unsigned short)0x3F80; }
    u32x4 pq[4], pk_[4]; u32x4 pv = (u32x4){0u, 0u, 0u, 0u}; float pws = 0.f;
#define M2_LOAD(c) do { const unsigned char* rc = rec0 + (size_t)(c) * ML_RECSZ; \
        _Pragma("unroll") for (int i = 0; i < 4; ++i) { const int idx = tid + 512 * i; const int j = idx >> 6, c16 = idx & 63; const int ii = (c) * 32 + j; const int t = dir ? (T - 1 - ii) : ii; \
        const bf16_t* row = QKC + (size_t)(base + t) * 4096 + h * 512 + c16 * 8; pq[i] = *(const u32x4*)row; pk_[i] = *(const u32x4*)(row + 2048); } \
        if (!DEN && tid < 256) { const int j = tid & 31, c16 = tid >> 5; const int ii = (c) * 32 + j; const int t = dir ? (T - 1 - ii) : ii; \
            pv = *(const u32x4*)(P + (size_t)(base + t) * IN_ODD_MAIN + 4096 + h * 512 + sl * 64 + c16 * 8); pws = *(const float*)(rc + 2176 + j * 4); } \
        if (DEN && tid < 32) pws = *(const float*)(rc + 2176 + tid * 4); } while (0)
#define M2_STORE(buf) do { LAS unsigned char* vb = VT + (buf) * 10240; \
        _Pragma("unroll") for (int i = 0; i < 4; ++i) { const int idx = tid + 512 * i; const int j = idx >> 6, c16 = idx & 63; \
            *(LAS u32x4*)(Qs + j * ML_PITCH + c16 * 16) = pq[i]; *(LAS u32x4*)(Ks + j * ML_PITCH + c16 * 16) = pk_[i]; } \
        if (!DEN && tid < 256) { const int j = tid & 31, c16 = tid >> 5; const unsigned vv[4] = {pv.x, pv.y, pv.z, pv.w}; \
            _Pragma("unroll") for (int i = 0; i < 4; ++i) { const int e0 = c16 * 8 + 2 * i; \
                *(LAS unsigned short*)(vb + e0 * 80 + j * 2) = (unsigned short)(vv[i] & 0xffffu); *(LAS unsigned short*)(vb + (e0 + 1) * 80 + j * 2) = (unsigned short)(vv[i] >> 16); \
                *(LAS unsigned short*)(vb + 5120 + e0 * 80 + j * 2) = (unsigned short)f2bf(bflo(vv[i]) * pws); *(LAS unsigned short*)(vb + 5120 + (e0 + 1) * 80 + j * 2) = (unsigned short)f2bf(bfhi(vv[i]) * pws); } } \
        if (DEN && tid < 32) *(LAS unsigned short*)(vb + 5120 + tid * 2) = (unsigned short)f2bf(pws); } while (0)
    LAS float* wold_s = (LAS float*)(lds + 152576);
    if (tid < nch) wold_s[tid] = *(const float*)(rec0 + (size_t)tid * ML_RECSZ + 2432);
    M2_LOAD(0);
    M2_STORE(0);
    __syncthreads();
    for (int c = 0; c < nch; ++c) {
        const unsigned char* rc = rec0 + (size_t)c * ML_RECSZ;
        const int buf = c & 1;
        bf16x8 pfrag = (bf16x8){0, 0, 0, 0, 0, 0, 0, 0}; float wp[4] = {0.f, 0.f, 0.f, 0.f}, cl[4] = {0.f, 0.f, 0.f, 0.f};
        if (et < ne) { pfrag = *(const bf16x8*)(rc + tt * 1024 + lane * 16);
#pragma unroll
            for (int r = 0; r < 4; ++r) { wp[r] = *(const float*)(rc + 2048 + (16 * tt + 4 * q + r) * 4); if constexpr (DEN) cl[r] = *(const float*)(rc + 2304 + (16 * tt + 4 * q + r) * 4); } }
        const float w_old = wold_s[c];
        if (c + 1 < nch) M2_LOAD(c + 1);
#pragma unroll
        for (int x = 0; x < 2; ++x) { f32x4 part[4];
#pragma unroll
          for (int e = 0; e < 4; ++e) part[e] = (f32x4){0.f, 0.f, 0.f, 0.f};
#pragma unroll
          for (int s = 0; s < 2; ++s) {
              const LAS unsigned char* qp = Qs + (16 * x + r16) * ML_PITCH + (64 * w + 32 * s + 4 * q) * 2;
              const u32x2 lo = *(const LAS u32x2*)qp, hi = *(const LAS u32x2*)(qp + 32);
              const u32x4 af = (u32x4){lo.x, lo.y, hi.x, hi.y};
#pragma unroll
              for (int e = 0; e < 4; ++e) if (e < ne) { u32x4 bfr; bfr.x = pk2(Cacc[2 * s][e][0], Cacc[2 * s][e][1]); bfr.y = pk2(Cacc[2 * s][e][2], Cacc[2 * s][e][3]);
                  bfr.z = pk2(Cacc[2 * s + 1][e][0], Cacc[2 * s + 1][e][1]); bfr.w = pk2(Cacc[2 * s + 1][e][2], Cacc[2 * s + 1][e][3]);
                  part[e] = __builtin_amdgcn_mfma_f32_16x16x32_bf16(__builtin_bit_cast(bf16x8, af), __builtin_bit_cast(bf16x8, bfr), part[e], 0, 0, 0); } }
#pragma unroll
          for (int e = 0; e < 4; ++e) if (e < ne) *(LAS u32x2*)(PS + ((w * 2 + x) * 4 + e) * 512 + lane * 8) = (u32x2){pk2(part[e][0], part[e][1]), pk2(part[e][2], part[e][3])};
          __builtin_amdgcn_sched_barrier(0); }
#pragma unroll
        for (int dt = 0; dt < 4; ++dt)
#pragma unroll
            for (int e = 0; e < 4; ++e) Cacc[dt][e] *= w_old;
        { bf16x8 bfr[4];
#pragma unroll
          for (int e = 0; e < 4; ++e) if (e < ne) bfr[e] = *(const LAS bf16x8*)(VT + buf * 10240 + 5120 + (16 * e + r16) * 80 + q * 16);
#pragma unroll
          for (int dt = 0; dt < 4; ++dt) {
#if ML_TR
              const LAS unsigned char* kp = Ks + (8 * q + (r16 >> 2)) * ML_PITCH + (64 * w + 16 * dt + 4 * (r16 & 3)) * 2;
              const s16x4 t0 = __builtin_amdgcn_ds_read_tr16_b64_v4i16((LAS s16x4*)kp), t1 = __builtin_amdgcn_ds_read_tr16_b64_v4i16((LAS s16x4*)(kp + 4 * ML_PITCH));
              const bf16x8 afv = (bf16x8){t0[0], t0[1], t0[2], t0[3], t1[0], t1[1], t1[2], t1[3]};
              const u32x4 af = __builtin_bit_cast(u32x4, afv);
#else
              unsigned kx[8];
#pragma unroll
              for (int j = 0; j < 8; ++j) kx[j] = *(const LAS unsigned short*)(Ks + (8 * q + j) * ML_PITCH + (64 * w + 16 * dt + r16) * 2);
              const u32x4 af = (u32x4){kx[0] | (kx[1] << 16), kx[2] | (kx[3] << 16), kx[4] | (kx[5] << 16), kx[6] | (kx[7] << 16)};
#endif
#pragma unroll
              for (int e = 0; e < 4; ++e) if (e < ne) Cacc[dt][e] = __builtin_amdgcn_mfma_f32_16x16x32_bf16(__builtin_bit_cast(bf16x8, af), bfr[e], Cacc[dt][e], 0, 0, 0);
              __builtin_amdgcn_sched_barrier(0); } }
        __syncthreads();
        if (et < ne) { f32x4 n4 = (f32x4){0.f, 0.f, 0.f, 0.f};
#pragma unroll
            for (int ww = 0; ww < 8; ++ww) { const u32x2 pp = *(const LAS u32x2*)(PS + ((ww * 2 + tt) * 4 + et) * 512 + lane * 8); n4 += (f32x4){bflo(pp.x), bfhi(pp.x), bflo(pp.y), bfhi(pp.y)}; }
#pragma unroll
            for (int r = 0; r < 4; ++r) n4[r] *= wp[r];
            const bf16x8 vf = *(const LAS bf16x8*)(VT + buf * 10240 + (16 * et + r16) * 80 + q * 16);
            n4 = __builtin_amdgcn_mfma_f32_16x16x32_bf16(pfrag, vf, n4, 0, 0, 0);
#pragma unroll
            for (int r = 0; r < 4; ++r) { const int ii = c * 32 + 16 * tt + 4 * q + r; const int t = dir ? (T - 1 - ii) : ii;
                if (DEN) { if (r16 == 0) DN[(size_t)(base + t) * 4 + h] = fmaxf(fabsf(n4[r]), cl[r]); }
                else H[(size_t)(base + t) * 2048 + h * 512 + sl * 64 + 16 * et + r16] = (bf16_t)f2bf(n4[r]); } }
        if (c + 1 < nch) M2_STORE(buf ^ 1);
        __syncthreads();
    }
#undef M2_LOAD
#undef M2_STORE
    if (!is_sample) {
        if (DEN) {
#pragma unroll
            for (int dt = 0; dt < 4; ++dt)
#pragma unroll
                for (int r = 0; r < 4; ++r) if (r16 == 0) a.out[OUT_N + sb * 512 + 64 * w + 16 * dt + 4 * q + r] = Cacc[dt][0][r];
        } else {
#pragma unroll
            for (int dt = 0; dt < 4; ++dt)
#pragma unroll
                for (int e = 0; e < 4; ++e)
#pragma unroll
                    for (int r = 0; r < 4; ++r) *(LAS float*)(lds + (64 * w + 16 * dt + 4 * q + r) * 272 + (16 * e + r16) * 4) = Cacc[dt][e][r];
            __syncthreads();
            float* dst = a.out + OUT_C + (sb * 512) * 512 + sl * 64;
            for (int i = tid; i < 512 * 16; i += NT) { const int d = i >> 4, c4 = i & 15; *(f32x4*)(dst + (size_t)d * 512 + 4 * c4) = *(const LAS f32x4*)(lds + d * 272 + c4 * 16); }
        }
    }
    __syncthreads();
}

__device__ __forceinline__ void phase_scans_odd(const Args& a, LAS unsigned char* lds, int tid, int qoff) {
    const int xg = blockIdx.x & 7;
    unsigned* head = (unsigned*)(a.ws + WS_CTL) + CW_Q1 + qoff + 64 * xg;
    volatile LAS unsigned* slot = (volatile LAS unsigned*)(lds + MISC_OFF);
    for (;;) {
        const int task = queue_pop(head, slot, tid);
        if (task >= 162) break;
        const int rl = task / 9, k9 = task - rl * 9;
        const int is_sample = rl < 2; const int rec = is_sample ? xg * 2 + rl : xg * 16 + (rl - 2);
        const int h = rec & 3, dir = (rec >> 2) & 1, seq = rec >> 3;
        if (k9 == 8) mlstm_scan_task<true>(a, lds, tid, seq, is_sample, dir, h, 0); else mlstm_scan_task<false>(a, lds, tid, seq, is_sample, dir, h, k9);
    }
}

__device__ __forceinline__ void phase_combine_odd(const Args& a, int lane, int wave, int G) {
    const int gw = blockIdx.x * NWAVES + wave, NGW = G * NWAVES;
    const bf16_t* HF = (const bf16_t*)(a.ws + WS_HF); const bf16_t* HB = (const bf16_t*)(a.ws + WS_HB);
    const bf16_t* P = (const bf16_t*)(a.ws + WS_PROJ); bf16_t* Yo = (bf16_t*)(a.ws + WS_Y); const float* DNp = (const float*)(a.ws + WS_DEN);
    const float* ng = a.in[32];
    const int c0 = 32 * lane;
    for (int m = gw; m < NTOK; m += NGW) {
        f32x4 hf[8], hb[8]; u32x4 ov[4], zv[4], rhf[4], rhb[4];
#pragma unroll
        for (int x = 0; x < 4; ++x) { rhf[x] = *(const u32x4*)(HF + (size_t)m * 2048 + c0 + 8 * x); rhb[x] = *(const u32x4*)(HB + (size_t)m * 2048 + c0 + 8 * x); }
#pragma unroll
        for (int x = 0; x < 4; ++x) { ov[x] = *(const u32x4*)(P + (size_t)m * IN_ODD_MAIN + 6144 + c0 + 8 * x); zv[x] = *(const u32x4*)(P + (size_t)m * IN_ODD_MAIN + 8192 + c0 + 8 * x); }
#pragma unroll
        for (int q = 0; q < 8; ++q) { const int x = q >> 1, j = (q & 1) * 2;
            hf[q] = (f32x4){bflo(rhf[x][j]), bfhi(rhf[x][j]), bflo(rhf[x][j + 1]), bfhi(rhf[x][j + 1])}; hb[q] = (f32x4){bflo(rhb[x][j]), bfhi(rhb[x][j]), bflo(rhb[x][j + 1]), bfhi(rhb[x][j + 1])}; }
        const float idf = 1.f / DNp[(size_t)m * 4 + (lane >> 4)], idb = 1.f / DNp[(size_t)NTOK * 4 + (size_t)m * 4 + (lane >> 4)];
        float ss = 0.f;
#pragma unroll
        for (int q = 0; q < 8; ++q) { const unsigned o01 = ov[q >> 1][(q & 1) * 2], o23 = ov[q >> 1][(q & 1) * 2 + 1];
            f32x4 y = hf[q] * idf + hb[q] * idb;
            y.x *= sigm(bflo(o01)); y.y *= sigm(bfhi(o01)); y.z *= sigm(bflo(o23)); y.w *= sigm(bfhi(o23));
            hf[q] = y; ss += (y.x * y.x + y.y * y.y) + (y.z * y.z + y.w * y.w); }
        const float rs = rsqrtf(row16_sum(ss) * (1.f / 512.f) + EPS);
        unsigned w[16];
#pragma unroll
        for (int q = 0; q < 8; ++q) { const unsigned z01 = zv[q >> 1][(q & 1) * 2], z23 = zv[q >> 1][(q & 1) * 2 + 1]; const f32x4 g4 = *(const f32x4*)(ng + c0 + 4 * q); const f32x4 y = hf[q] * rs * g4;
            w[2 * q] = pk2(y.x * silu(bflo(z01)), y.y * silu(bfhi(z01))); w[2 * q + 1] = pk2(y.z * silu(bflo(z23)), y.w * silu(bfhi(z23))); }
        u32x4* dst = (u32x4*)(Yo + (size_t)m * 2048 + c0);
#pragma unroll
        for (int q = 0; q < 4; ++q) dst[q] = (u32x4){w[4 * q], w[4 * q + 1], w[4 * q + 2], w[4 * q + 3]};
    }
}

__device__ __forceinline__ void phase_final(const Args& a, int lane, int wave, int G) {
    const int gw = blockIdx.x * NWAVES + wave, NGW = G * NWAVES;
    const float* MOD = (const float*)(a.ws + WS_MOD); const bf16_t* PART = (const bf16_t*)(a.ws + WS_PART); const float* X1 = (const float*)(a.ws + WS_X1);
    const float* fg = a.in[12];
    for (int m = gw; m < NTOK; m += NGW) {
        int t, T, cr; tok_info(m, t, T, cr);
        const f32x4* xr = (const f32x4*)(X1 + (size_t)m * 1024) + lane;
        const u32x2* p0 = (const u32x2*)(PART + (size_t)m * 1024) + lane; const u32x2* p1 = (const u32x2*)(PART + (size_t)NTOK * 1024 + (size_t)m * 1024) + lane;
        const f32x4* gt = (const f32x4*)(MOD + (1 * 3 + cr) * 3072 + 2048) + lane;
        f32x4 v[4]; float s = 0.f;
#pragma unroll
        for (int j = 0; j < 4; ++j) { { const u32x2 a0 = p0[64 * j], a1 = p1[64 * j]; const f32x4 ps = (f32x4){bflo(a0.x) + bflo(a1.x), bfhi(a0.x) + bfhi(a1.x), bflo(a0.y) + bflo(a1.y), bfhi(a0.y) + bfhi(a1.y)}; v[j] = xr[64 * j] + gt[64 * j] * ps; } s += (v[j].x * v[j].x + v[j].y * v[j].y) + (v[j].z * v[j].z + v[j].w * v[j].w); }
        const float rstd = rsqrtf(wave_sum(s) * (1.f / 1024.f) + EPS);
#pragma unroll
        for (int j = 0; j < 4; ++j) { const f32x4 g4 = *(const f32x4*)(fg + 4 * lane + 256 * j); ((f32x4*)(a.out + OUT_Y + (size_t)m * 1024))[lane + 64 * j] = v[j] * rstd * g4; }
    }
}


#define XB_TMO      128
#define XB_XCNT(j)  (256  + 64 * (j))
#define XB_XSUB(j)  (1280 + 64 * (j))
#define XB_XGEN(j)  (2304 + 64 * (j))
#define XB_TOP      3328
#define XB_TOPGEN   3392
#define XCD_BAR_WORDS 3456
#define XB_SPIN_CAP (1u << 18)
__device__ __forceinline__ unsigned xb_ld(unsigned* p)              { return __hip_atomic_load(p, __ATOMIC_RELAXED, __HIP_MEMORY_SCOPE_AGENT); }
__device__ __forceinline__ unsigned xb_add(unsigned* p, unsigned v) { return __hip_atomic_fetch_add(p, v, __ATOMIC_RELAXED, __HIP_MEMORY_SCOPE_AGENT); }
__device__ __forceinline__ unsigned xb_xcc_id() { return (unsigned)__builtin_amdgcn_s_getreg((3 << 11) | 20) & 0xFu; }
#define XB_SPIN(cond, bar) do { unsigned _sp = 0; while (cond) { __builtin_amdgcn_s_sleep(1); \
    if ((++_sp & 255u) == 0u) { if (xb_ld(&(bar)[XB_TMO])) break; if (_sp > XB_SPIN_CAP) { atomicAdd(&(bar)[XB_TMO], 1u); break; } } } } while (0)
struct XcdBarrier { unsigned* bar; unsigned x; volatile LAS unsigned* st; };
__device__ __forceinline__ XcdBarrier xcd_barrier_post(unsigned* bar, volatile LAS unsigned* st) {
    XcdBarrier b; b.bar = bar; b.x = xb_xcc_id(); b.st = st;
    if (threadIdx.x == 0) (void)xb_add(&bar[XB_XCNT(b.x)], 1u);
    return b;
}
__device__ __forceinline__ void xcd_barrier_complete(unsigned* bar, unsigned x, unsigned& nloc, unsigned& nx) {
    const unsigned G = gridDim.x * gridDim.y * gridDim.z;
    unsigned sum, cnt, mine, sp = 0u;
    for (;;) {
        sum = 0u; cnt = 0u; mine = 0u;
#pragma unroll
        for (unsigned j = 0; j < 16; ++j) { const unsigned c = xb_ld(&bar[XB_XCNT(j)]); sum += c; cnt += (c > 0u) ? 1u : 0u; mine = (j == x) ? c : mine; }
        if (sum == G) break;
        __builtin_amdgcn_s_sleep(1);
        if ((++sp & 255u) == 0u) { if (xb_ld(&bar[XB_TMO])) break; if (sp > XB_SPIN_CAP) { atomicAdd(&bar[XB_TMO], 1u); break; } }
    }
    nloc = mine > 0u ? mine : 1u; nx = cnt > 0u ? cnt : 1u;
}
__device__ __forceinline__ void xcd_barrier(const XcdBarrier& b) {
    asm volatile("s_waitcnt vmcnt(0)" ::: "memory");
    __syncthreads();
    if (threadIdx.x == 0) {
        unsigned* bar = b.bar;
        __builtin_amdgcn_s_waitcnt(0);
        unsigned nloc = b.st[0], nx = b.st[1];
        if (nloc == 0u) { xcd_barrier_complete(bar, b.x, nloc, nx); b.st[0] = nloc; b.st[1] = nx; }
        const unsigned old = xb_add(&bar[XB_XSUB(b.x)], 1u);
        const unsigned gen = old / nloc;
        if (old + 1u == (gen + 1u) * nloc) {
            __builtin_amdgcn_fence(__ATOMIC_RELEASE, "agent");
            asm volatile("s_waitcnt vmcnt(0)" ::: "memory");
            const unsigned og = xb_add(&bar[XB_TOP], 1u);
            const unsigned tg = og / nx;
            if (og + 1u == (tg + 1u) * nx) xb_add(&bar[XB_TOPGEN], 1u);
            else XB_SPIN(xb_ld(&bar[XB_TOPGEN]) == tg, bar);
            __builtin_amdgcn_fence(__ATOMIC_ACQUIRE, "agent");
            xb_add(&bar[XB_XGEN(b.x)], 1u);
            asm volatile("s_waitcnt vmcnt(0)" ::: "memory");
        } else {
            XB_SPIN(xb_ld(&bar[XB_XGEN(b.x)]) == gen, bar);
            __builtin_amdgcn_fence(__ATOMIC_ACQUIRE, "agent");
            asm volatile("s_waitcnt vmcnt(0)" ::: "memory");
        }
    }
    __syncthreads();
}

constexpr int N_PHASES = 17;
#ifndef PROBE_MASK
#define PROBE_MASK 0u
#endif
template <int K>
__device__ __forceinline__ void run_phase(const Args& a, LAS unsigned char* lds, int tid_, int G, int rep) {
    int tid = tid_; asm volatile("" : "+v"(tid)); const int lane = tid & 63, wave = __builtin_amdgcn_readfirstlane(tid >> 6);
    if constexpr (K == 0) phase_prologue(a, lds, tid, lane, wave, G);
    else if constexpr (K == 1) phase_modnorm0(a, lane, wave, G);
    else if constexpr (K == 2) { pg8::Gemm g{(const bf16_t*)(a.ws + WS_XN), (const bf16_t*)(a.ws + WS_WINE), NTOK, IN_EVEN, 1024, 1024}; pg8::StaticOrder S; S.init(NTOK, IN_EVEN, G, (int)blockIdx.x);
        pg8::EpiBf16 E{(bf16_t*)(a.ws + WS_PROJ), IN_EVEN};
        pg8::gemm_phase<pg8::EpiBf16, pg8::StaticOrder, true, true>(lds, g, S, E); }
    else if constexpr (K == 3) phase_rwkv_lr(a, tid, G);
    else if constexpr (K == 4) { pg8::Gemm g{(const bf16_t*)(a.ws + WS_LR), (const bf16_t*)(a.ws + WS_W2B), NTOK, 4096, 128, 256}; pg8::LowRankOrder S; S.S.init(NTOK, 4096, G, (int)blockIdx.x);
        pg8::EpiBf16 E{(bf16_t*)(a.ws + WS_U4), 4096};
        pg8::gemm_phase<pg8::EpiBf16, pg8::LowRankOrder, true, true>(lds, g, S, E); }
    else if constexpr (K == 5) {
        unsigned* head = (unsigned*)(a.ws + WS_CTL) + CW_Q2 + rep * 2048; volatile LAS unsigned* slot = (volatile LAS unsigned*)(lds + MISC_OFF);
        for (;;) { const int task = queue_pop(head, slot, tid); if (task >= 768) break;
            const int grp = task / 3, sub = task - grp * 3;
            if (sub < 2) { const int job = (grp * 2 + sub) * 8 + wave; rwkv_chunk_job(a, lds + wave * RW_WL, lane, job >> 4, job & 15); }
            else hgrn_pre_bundle(a, lds, tid, grp * 16); } }
    else if constexpr (K == 6) phase_scans_even(a, lds, tid, rep * 2048);
    else if constexpr (K == 7) phase_combine_even(a, lane, wave, G);
    else if constexpr (K == 8) { pg8::Gemm g{(const bf16_t*)(a.ws + WS_Y), (const bf16_t*)(a.ws + WS_WOUTE), NTOK, 1024, 1024, 2048}; pg8::SplitKOrder S{G, (int)blockIdx.x};
        pg8::EpiBf16Part E{(bf16_t*)(a.ws + WS_PART), 1024, (size_t)NTOK * 1024};
        pg8::gemm_phase<pg8::EpiBf16Part, pg8::SplitKOrder, false, true>(lds, g, S, E); }
    else if constexpr (K == 9) phase_res_modnorm1(a, lane, wave, G);
    else if constexpr (K == 10) { pg8::Gemm g{(const bf16_t*)(a.ws + WS_XN), (const bf16_t*)(a.ws + WS_WINO), NTOK, IN_ODD_MAIN, 1024, 1024}; pg8::StaticOrder S; S.init(NTOK, IN_ODD_MAIN, G, (int)blockIdx.x);
        pg8::EpiBf16 E{(bf16_t*)(a.ws + WS_PROJ), IN_ODD_MAIN};
        pg8::gemm_phase<pg8::EpiBf16, pg8::StaticOrder, true, true>(lds, g, S, E); }
    else if constexpr (K == 11) { { const int gw = blockIdx.x * NWAVES + wave; if (gw < 144) mlstm_gate_scan(a, lane, gw); } phase_conv(a, tid, G); }
    else if constexpr (K == 12) phase_mlstm_pre(a, lds, lane, wave, G);
    else if constexpr (K == 13) phase_scans_odd(a, lds, tid, rep * 2048);
    else if constexpr (K == 14) phase_combine_odd(a, lane, wave, G);
    else if constexpr (K == 15) { pg8::Gemm g{(const bf16_t*)(a.ws + WS_Y), (const bf16_t*)(a.ws + WS_WOUTO), NTOK, 1024, 1024, 2048}; pg8::SplitKOrder S{G, (int)blockIdx.x};
        pg8::EpiBf16Part E{(bf16_t*)(a.ws + WS_PART), 1024, (size_t)NTOK * 1024};
        pg8::gemm_phase<pg8::EpiBf16Part, pg8::SplitKOrder, false, true>(lds, g, S, E); }
    else if constexpr (K == 16) phase_final(a, lane, wave, G);
}
__global__ void __launch_bounds__(NT, 2) fwd_kernel(Args a) {
    extern __shared__ __attribute__((aligned(16))) unsigned char lds_raw[];
    LAS unsigned char* lds = (LAS unsigned char*)lds_raw;
    const int tid = threadIdx.x, G = gridDim.x;
    const int lo = a.ph_lo, hi = a.ph_hi;
    if (tid < 16) ((volatile LAS unsigned*)(lds + MISC_OFF))[tid] = 0u;
    __syncthreads();
    const XcdBarrier bar = xcd_barrier_post((unsigned*)(a.ws + WS_CTL) + CW_BAR, (volatile LAS unsigned*)(lds + MISC_OFF) + 8);
#define IN(k) (lo <= (k) && (k) < hi)
#define PHASE(k) do { if (IN(k)) { run_phase<k>(a, lds, tid, G, 0); if ((PROBE_MASK >> (k)) & 1u) { xcd_barrier(bar); run_phase<k>(a, lds, tid, G, 1); } } \
        if (IN(k) && IN((k) + 1)) xcd_barrier(bar); } while (0)
    PHASE(0); PHASE(1); PHASE(2); PHASE(3); PHASE(4); PHASE(5); PHASE(6); PHASE(7); PHASE(8); PHASE(9); PHASE(10); PHASE(11); PHASE(12); PHASE(13); PHASE(14); PHASE(15); PHASE(16);
#undef IN
#undef PHASE
}

extern "C" void kernel_launch(void* const* d_in, const int* in_sizes, int n_in,
                              void* d_out, int out_size, void* d_ws, size_t ws_size,
                              hipStream_t stream) {
    static int grid_blocks = 0;
    if (!grid_blocks) {
        int dev = 0, cus = 0, per_cu = 0;
        (void)hipGetDevice(&dev);
        (void)hipDeviceGetAttribute(&cus, hipDeviceAttributeMultiprocessorCount, dev);
        (void)hipFuncSetAttribute((const void*)fwd_kernel, hipFuncAttributeMaxDynamicSharedMemorySize, LDS_BYTES);
        (void)hipOccupancyMaxActiveBlocksPerMultiprocessor(&per_cu, (const void*)fwd_kernel, NT, LDS_BYTES);
        (void)hipGetLastError();
        grid_blocks = cus > 0 ? cus : 256;
        fprintf(stderr, "kernel_launch: cus=%d per_cu=%d grid=%d ws=%zu\n", cus, per_cu, grid_blocks, ws_size);
        if (n_in != 33 || ws_size < WS_END) { fprintf(stderr, "kernel_launch: unexpected n_in %d / ws %zu\n", n_in, ws_size); }
    }
    (void)hipMemsetAsync((char*)d_ws + WS_CTL, 0, CTL_ZERO_BYTES, stream);
    Args a{};
    for (int i = 0; i < 33; ++i) a.in[i] = (const float*)d_in[i];
    a.out = (float*)d_out; a.ws = (unsigned char*)d_ws; a.ph_lo = 0; a.ph_hi = N_PHASES;
    void* args[] = {&a};
    hipError_t e = hipLaunchCooperativeKernel((const void*)fwd_kernel, dim3(grid_blocks), dim3(NT), args, LDS_BYTES, stream);
    if (e != hipSuccess) fprintf(stderr, "cooperative launch failed: %s (grid %d)\n", hipGetErrorString(e), grid_blocks);
}
```

```cpp
#include <hip/hip_runtime.h>
#include <cstdio>
#include <cstdint>

#define LAS __attribute__((address_space(3)))
#define GAS __attribute__((address_space(1)))
typedef unsigned short bf16_t;
typedef short bf16x8 __attribute__((ext_vector_type(8)));
typedef float f32x4 __attribute__((ext_vector_type(4)));
typedef float f32x2 __attribute__((ext_vector_type(2)));
typedef unsigned u32x4 __attribute__((ext_vector_type(4)));
typedef unsigned u32x2 __attribute__((ext_vector_type(2)));

namespace pg8 {
#define PG8_LAS __attribute__((address_space(3)))
constexpr int BM = 256, BK = 64, HALF = 128, HTB = HALF * BK * 2, STAGE_BYTES = 8 * HTB, NXCD = 8, WGM = 8;

__host__ __device__ __forceinline__ int lds_byte(int r, int c) { const int st = (r >> 4) * 2 + (c >> 5), rr = r & 15, cc = c & 31, ob = rr * 64 + cc * 2; return st * 1024 + (ob ^ (((ob >> 9) & 1) << 5)); }
__host__ __device__ __forceinline__ void stage_rc(int b, int& R, int& C) { const int st = b / 1024, sb = b % 1024, swz = sb ^ (((sb >> 9) & 1) << 5); R = (st >> 1) * 16 + swz / 64; C = (st & 1) * 32 + (swz % 64) / 2; }
__host__ __device__ __forceinline__ int perm32(int rho) { const int n = rho >> 4, i = rho & 15; return 8 * (i >> 2) + 4 * n + (i & 3); }

struct Unit { int pm, pn, ks; };
struct Gemm { const bf16_t* A; const bf16_t* Bt; int M, N, K, ld; };

struct StaticOrder {
    int nM, nN, nwg, G, c;
    __host__ __device__ void init(int M, int N, int G_, int c_) { nM = M / BM; nN = N / BM; nwg = nM * nN; G = G_; c = c_; }
    __host__ __device__ bool next(int i, Unit& u) const {
        const long L = (long)i * G + c; if (L >= nwg) return false;
        int wgid = (int)L; { const int q = nwg / NXCD, r = nwg % NXCD, xcd = wgid % NXCD, off = wgid / NXCD; wgid = (xcd < r ? xcd * (q + 1) : r * (q + 1) + (xcd - r) * q) + off; }
        const int nig = WGM * nN, gid = wgid / nig, fm = gid * WGM, gsz = (nM - fm) < WGM ? (nM - fm) : WGM;
        u.pm = fm + ((wgid % nig) % gsz); u.pn = (wgid % nig) / gsz; u.ks = 0; return true;
    }
    __device__ __forceinline__ void a_ready(const Unit&) const {}
    __device__ __forceinline__ void done(const Unit&) const {}
};
struct LowRankOrder { StaticOrder S;
    __host__ __device__ bool next(int i, Unit& u) const { if (!S.next(i, u)) return false; u.ks = u.pn >> 3; return true; }
    __device__ __forceinline__ void a_ready(const Unit&) const {}
    __device__ __forceinline__ void done(const Unit&) const {}
};
struct SplitKOrder {
    int G, c;
    __host__ __device__ bool next(int i, Unit& u) const {
        const long L = (long)i * G + c; if (L >= 256) return false;
        u.pm = (int)(L >> 3); u.pn = (int)((L >> 1) & 3); u.ks = (int)(L & 1); return true;
    }
    __device__ __forceinline__ void a_ready(const Unit&) const {}
    __device__ __forceinline__ void done(const Unit&) const {}
};

__device__ __forceinline__ unsigned cvt_pk_bf16(float lo, float hi) { unsigned r; asm volatile("v_cvt_pk_bf16_f32 %0, %1, %2" : "=v"(r) : "v"(lo), "v"(hi)); return r; }

struct EpiBf16 {
    static constexpr bool PERM = true, AFTER_DRAIN = false;
    bf16_t* O; int ldc;
    __device__ __forceinline__ void operator()(const f32x4 (&acc)[2][2][4][2], const Unit& u, int wr, int wc, int fr, int fq) const {
        const int row0 = u.pm * BM + wr * 64 + fr; const int col0 = u.pn * BM + wc * 32 + 8 * fq;
#pragma unroll
        for (int ai = 0; ai < 2; ++ai)
#pragma unroll
            for (int m = 0; m < 4; ++m) { bf16_t* rowp = O + (size_t)(row0 + ai * HALF + m * 16) * ldc + col0;
#pragma unroll
                for (int bj = 0; bj < 2; ++bj) { const f32x4 v0 = acc[ai][bj][m][0], v1 = acc[ai][bj][m][1];
                    u32x4 w; w.x = cvt_pk_bf16(v0[0], v0[1]); w.y = cvt_pk_bf16(v0[2], v0[3]); w.z = cvt_pk_bf16(v1[0], v1[1]); w.w = cvt_pk_bf16(v1[2], v1[3]);
                    *(u32x4*)(rowp + bj * HALF) = w; } }
    }
};
struct EpiBf16Part {
    static constexpr bool PERM = true, AFTER_DRAIN = false;
    bf16_t* O; int ldc; size_t part_stride;
    __device__ __forceinline__ void operator()(const f32x4 (&acc)[2][2][4][2], const Unit& u, int wr, int wc, int fr, int fq) const {
        const int row0 = u.pm * BM + wr * 64 + fr; const int col0 = u.pn * BM + wc * 32 + 8 * fq;
        bf16_t* base = O + (size_t)u.ks * part_stride;
#pragma unroll
        for (int ai = 0; ai < 2; ++ai)
#pragma unroll
            for (int m = 0; m < 4; ++m) { bf16_t* rowp = base + (size_t)(row0 + ai * HALF + m * 16) * ldc + col0;
#pragma unroll
                for (int bj = 0; bj < 2; ++bj) { const f32x4 v0 = acc[ai][bj][m][0], v1 = acc[ai][bj][m][1];
                    u32x4 w; w.x = cvt_pk_bf16(v0[0], v0[1]); w.y = cvt_pk_bf16(v0[2], v0[3]); w.z = cvt_pk_bf16(v1[0], v1[1]); w.w = cvt_pk_bf16(v1[2], v1[3]);
                    *(u32x4*)(rowp + bj * HALF) = w; } }
    }
};
struct EpiF32Part {
    static constexpr bool PERM = false, AFTER_DRAIN = false;
    float* P; int ldc; size_t part_stride;
    __device__ __forceinline__ void operator()(const f32x4 (&acc)[2][2][4][2], const Unit& u, int wr, int wc, int fr, int fq) const {
        const int row0 = u.pm * BM + wr * 64 + fr; const int col0 = u.pn * BM + wc * 32 + 4 * fq;
        float* base = P + (size_t)u.ks * part_stride;
#pragma unroll
        for (int ai = 0; ai < 2; ++ai)
#pragma unroll
            for (int m = 0; m < 4; ++m) { float* rowp = base + (size_t)(row0 + ai * HALF + m * 16) * ldc + col0;
#pragma unroll
                for (int bj = 0; bj < 2; ++bj)
#pragma unroll
                    for (int n = 0; n < 2; ++n) *(f32x4*)(rowp + bj * HALF + n * 16) = acc[ai][bj][m][n]; }
    }
};

template <class Epi, class Sched, bool ALIGN_EPI = false, bool SP2 = false>
__device__ __forceinline__ void gemm_phase(PG8_LAS unsigned char* lds, const Gemm g, const Sched& S, const Epi& E) {
    const int tid = threadIdx.x, wid = __builtin_amdgcn_readfirstlane(tid >> 6), lane = tid & 63, wr = wid >> 2, wc = wid & 3, fr = lane & 15, fq = lane >> 4;
    const int K = g.K, nt = K / BK, LD = g.ld;
    unsigned voffA[2], voffB[2];
#pragma unroll
    for (int i = 0; i < 2; ++i) { int R, C; stage_rc(tid * 16 + i * 8192, R, C); const int Rb = Epi::PERM ? ((R & ~31) + perm32(R & 31)) : R;
        voffA[i] = (unsigned)(R * LD + C) * 2u; voffB[i] = (unsigned)(Rb * LD + C) * 2u; }
    const size_t kstep = (size_t)(BK * 2);
    const size_t hstep = (size_t)HALF * LD * 2;
    const size_t tstep = 2 * hstep;
    const size_t sstep = (size_t)K * 2;
    const unsigned ldsw = (unsigned)wid * 1024u;
    const int aoff = lds_byte(wr * 64 + fr, fq * 8), boff = lds_byte(wc * 32 + fr, fq * 8);
#define PG8_SA(b, h) (((b) * 2 + (h)) * HTB)
#define PG8_SB(b, h) ((4 + (b) * 2 + (h)) * HTB)
#define PG8_STAGE(bufoff, gbase, voff) do { _Pragma("unroll") for (int _i = 0; _i < 2; ++_i) \
        __builtin_amdgcn_global_load_lds((const unsigned*)((const char*)(gbase) + (voff)[_i]), (PG8_LAS unsigned*)(lds + (bufoff) + ldsw + _i * 8192), 16, 0, 0); } while (0)
#define PG8_LDA(dst, b, h) do { _Pragma("unroll") for (int m = 0; m < 4; ++m) _Pragma("unroll") for (int k = 0; k < 2; ++k) dst[m][k] = *(const PG8_LAS bf16x8*)(lds + PG8_SA(b, h) + aoff + m * 2048 + k * 1024); } while (0)
#define PG8_LDB(dst, b, h) do { _Pragma("unroll") for (int n = 0; n < 2; ++n) _Pragma("unroll") for (int k = 0; k < 2; ++k) dst[n][k] = *(const PG8_LAS bf16x8*)(lds + PG8_SB(b, h) + boff + n * 2048 + k * 1024); } while (0)
#define PG8_MMA(ai, bj, At, Bt) do { __builtin_amdgcn_s_setprio(1); _Pragma("unroll") for (int m = 0; m < 4; ++m) _Pragma("unroll") for (int n = 0; n < 2; ++n) _Pragma("unroll") for (int k = 0; k < 2; ++k) \
        acc[ai][bj][m][n] = __builtin_amdgcn_mfma_f32_16x16x32_bf16(Bt[n][k], At[m][k], acc[ai][bj][m][n], 0, 0, 0); __builtin_amdgcn_s_setprio(0); } while (0)
#define PG8_WAIT_V(n) asm volatile("s_waitcnt vmcnt(" #n ")" ::: "memory")
#define PG8_WAIT_L(n) asm volatile("s_waitcnt lgkmcnt(" #n ")" ::: "memory")
#define PG8_BAR __builtin_amdgcn_s_barrier()
#define PG8_SCHED __builtin_amdgcn_sched_barrier(0)
    Unit cur, nxt; int ui = 0;
    if (!S.next(0, cur)) return;
    f32x4 acc[2][2][4][2];
#pragma unroll
    for (int a = 0; a < 2; ++a)
#pragma unroll
        for (int b = 0; b < 2; ++b)
#pragma unroll
            for (int m = 0; m < 4; ++m)
#pragma unroll
                for (int n = 0; n < 2; ++n) acc[a][b][m][n] = (f32x4){0.f, 0.f, 0.f, 0.f};
    bf16x8 At[4][2], B0[2][2], B1[2][2];
    const char* cA = (const char*)g.A + (size_t)cur.pm * tstep + (size_t)cur.ks * sstep; const char* cB = (const char*)g.Bt + (size_t)cur.pn * tstep + (size_t)cur.ks * sstep;
    S.a_ready(cur);
    if constexpr (SP2) {
        PG8_STAGE(PG8_SB(0, 0), cB, voffB); PG8_STAGE(PG8_SB(0, 1), cB + hstep, voffB); PG8_STAGE(PG8_SA(0, 0), cA, voffA); PG8_STAGE(PG8_SA(0, 1), cA + hstep, voffA);
        if (wr == 1) PG8_BAR;
        PG8_WAIT_V(2); PG8_BAR;
        PG8_STAGE(PG8_SB(1, 0), cB + kstep, voffB); PG8_STAGE(PG8_SA(1, 0), cA + kstep, voffA); PG8_STAGE(PG8_SB(1, 1), cB + hstep + kstep, voffB);
        PG8_WAIT_V(6); PG8_BAR;
    } else {
        PG8_STAGE(PG8_SB(0, 0), cB, voffB); PG8_STAGE(PG8_SA(0, 0), cA, voffA); PG8_STAGE(PG8_SB(0, 1), cB + hstep, voffB); PG8_STAGE(PG8_SA(0, 1), cA + hstep, voffA);
        if (wr == 1) PG8_BAR;
        PG8_WAIT_V(4); PG8_BAR;
        PG8_STAGE(PG8_SB(1, 0), cB + kstep, voffB); PG8_STAGE(PG8_SA(1, 0), cA + kstep, voffA); PG8_STAGE(PG8_SB(1, 1), cB + hstep + kstep, voffB);
        PG8_WAIT_V(6); PG8_BAR;
    }
    for (;;) {
        const bool has_next = S.next(ui + 1, nxt);
        const char* nA = has_next ? (const char*)g.A + (size_t)nxt.pm * tstep + (size_t)nxt.ks * sstep : cA; const char* nB = has_next ? (const char*)g.Bt + (size_t)nxt.pn * tstep + (size_t)nxt.ks * sstep : cB;
        for (int t = 0; t < nt; t += 2) {
            const bool last = (t == nt - 2);
            const char* a1 = cA + (size_t)(t + 1) * kstep;
            const char* a2 = last ? nA : cA + (size_t)(t + 2) * kstep; const char* b2 = last ? nB : cB + (size_t)(t + 2) * kstep;
            const char* a3 = a2 + kstep; const char* b3 = b2 + kstep;
            if (last && has_next) S.a_ready(nxt);
            if constexpr (SP2) {
            PG8_LDB(B0, 0, 0); PG8_LDB(B1, 0, 1); PG8_SCHED; PG8_LDA(At, 0, 0); PG8_STAGE(PG8_SA(1, 1), a1 + hstep, voffA);
            PG8_WAIT_V(8); PG8_WAIT_L(0); PG8_BAR; PG8_MMA(0, 0, At, B0); PG8_MMA(0, 1, At, B1); PG8_BAR; PG8_SCHED;
            PG8_LDA(At, 0, 1); PG8_STAGE(PG8_SB(0, 0), b2, voffB); PG8_STAGE(PG8_SB(0, 1), b2 + hstep, voffB); PG8_STAGE(PG8_SA(0, 0), a2, voffA);
            PG8_WAIT_V(8); PG8_WAIT_L(0); PG8_BAR; PG8_MMA(1, 0, At, B0); PG8_MMA(1, 1, At, B1); PG8_BAR; PG8_SCHED;
            PG8_LDB(B0, 1, 0); PG8_LDB(B1, 1, 1); PG8_SCHED; PG8_LDA(At, 1, 0); PG8_STAGE(PG8_SA(0, 1), a2 + hstep, voffA);
            PG8_WAIT_V(8); PG8_WAIT_L(0); PG8_BAR; PG8_MMA(0, 0, At, B0); PG8_MMA(0, 1, At, B1); PG8_BAR; PG8_SCHED;
            PG8_LDA(At, 1, 1); PG8_STAGE(PG8_SB(1, 0), b3, voffB); PG8_STAGE(PG8_SB(1, 1), b3 + hstep, voffB); PG8_STAGE(PG8_SA(1, 0), a3, voffA);
            PG8_WAIT_V(8); PG8_WAIT_L(0); PG8_BAR; PG8_MMA(1, 0, At, B0); PG8_MMA(1, 1, At, B1); PG8_BAR; PG8_SCHED;
            } else {
            PG8_LDB(B0, 0, 0); PG8_SCHED; PG8_LDA(At, 0, 0); PG8_STAGE(PG8_SA(1, 1), a1 + hstep, voffA);
            PG8_WAIT_L(8); PG8_BAR; PG8_WAIT_L(0); PG8_MMA(0, 0, At, B0); PG8_BAR; PG8_SCHED;
            PG8_LDB(B1, 0, 1); PG8_STAGE(PG8_SB(0, 0), b2, voffB);
            PG8_BAR; PG8_WAIT_L(0); PG8_MMA(0, 1, At, B1); PG8_BAR;
            PG8_LDA(At, 0, 1); PG8_STAGE(PG8_SA(0, 0), a2, voffA);
            PG8_BAR; PG8_WAIT_L(0); PG8_MMA(1, 0, At, B0); PG8_BAR; PG8_SCHED;
            PG8_STAGE(PG8_SB(0, 1), b2 + hstep, voffB);
            PG8_WAIT_V(6); PG8_BAR; PG8_MMA(1, 1, At, B1); PG8_BAR;
            PG8_LDB(B0, 1, 0); PG8_SCHED; PG8_LDA(At, 1, 0); PG8_STAGE(PG8_SA(0, 1), a2 + hstep, voffA);
            PG8_WAIT_L(8); PG8_BAR; PG8_WAIT_L(0); PG8_MMA(0, 0, At, B0); PG8_BAR; PG8_SCHED;
            PG8_LDB(B1, 1, 1); PG8_STAGE(PG8_SB(1, 0), b3, voffB);
            PG8_BAR; PG8_WAIT_L(0); PG8_MMA(0, 1, At, B1); PG8_BAR;
            PG8_LDA(At, 1, 1); PG8_STAGE(PG8_SA(1, 0), a3, voffA);
            PG8_BAR; PG8_WAIT_L(0); PG8_MMA(1, 0, At, B0); PG8_BAR; PG8_SCHED;
            PG8_STAGE(PG8_SB(1, 1), b3 + hstep, voffB);
            PG8_WAIT_V(6); PG8_BAR; PG8_MMA(1, 1, At, B1); PG8_BAR;
            }
        }
        if constexpr (ALIGN_EPI) { if (wr == 0) PG8_BAR; }
        if constexpr (!Epi::AFTER_DRAIN) { E(acc, cur, wr, wc, fr, fq); S.done(cur); }
        if (!has_next) break;
#pragma unroll
        for (int a = 0; a < 2; ++a)
#pragma unroll
            for (int b = 0; b < 2; ++b)
#pragma unroll
                for (int m = 0; m < 4; ++m)
#pragma unroll
                    for (int n = 0; n < 2; ++n) acc[a][b][m][n] = (f32x4){0.f, 0.f, 0.f, 0.f};
        cur = nxt; cA = nA; cB = nB; ++ui;
        if constexpr (ALIGN_EPI) { if (wr == 1) PG8_BAR; }
    }
    PG8_WAIT_V(0);
    if constexpr (!ALIGN_EPI) { if (wr == 0) PG8_BAR; }
    PG8_BAR;
#undef PG8_SA
#undef PG8_SB
#undef PG8_STAGE
#undef PG8_LDA
#undef PG8_LDB
#undef PG8_MMA
#undef PG8_WAIT_V
#undef PG8_WAIT_L
#undef PG8_BAR
#undef PG8_SCHED
}
}

constexpr int NT = 512, NWAVES = 8;
constexpr int LDS_BYTES = 159744;
constexpr int MISC_OFF = 155648;
constexpr int NTOK = 8192, DM = 1024;
constexpr int IN_EVEN = 9472, IN_ODD = 10256, IN_ODD_MAIN = 10240;
constexpr float EPS = 1e-6f, GN_EPS = 64e-5f;
constexpr size_t OUT_Y = 0, OUT_HGRN = 8388608, OUT_RWKV = 12582912, OUT_C = 14680064, OUT_N = 48234496, OUT_M = 48300032;
constexpr size_t MiB = 1u << 20;
constexpr size_t WS_CTL = 0, CTL_ZERO_BYTES = 64 * 1024;
constexpr size_t WS_MOD = 1 * MiB;
constexpr size_t WS_GW = 1 * MiB + 512 * 1024;
constexpr size_t WS_GATES = 1 * MiB + 768 * 1024;
constexpr size_t WS_WINE = 4 * MiB;
constexpr size_t WS_WOUTE = 24 * MiB;
constexpr size_t WS_WINO = 28 * MiB;
constexpr size_t WS_WOUTO = 48 * MiB;
constexpr size_t WS_XN = 52 * MiB;
constexpr size_t WS_X1 = 68 * MiB;
constexpr size_t WS_PROJ = 100 * MiB;
constexpr size_t WS_OF = 260 * MiB, WS_OB = 292 * MiB;
constexpr size_t WS_QKC = 260 * MiB;
constexpr size_t WS_YF = 324 * MiB, WS_YB = 356 * MiB;
constexpr size_t WS_HF = 324 * MiB, WS_HB = 388 * MiB;
constexpr size_t WS_U4 = 260 * MiB;
constexpr size_t WS_RS = 324 * MiB, WS_KS = 340 * MiB, WS_KKS = 356 * MiB;
constexpr size_t WS_RWREC = 388 * MiB;
constexpr size_t WS_Y = 564 * MiB;
constexpr size_t WS_PART = 596 * MiB;
constexpr size_t WS_BS = 660 * MiB;
constexpr size_t WS_GT = 662 * MiB;
constexpr size_t WS_DEN = 662 * MiB + 512 * 1024;
constexpr size_t WS_V = 664 * MiB;
constexpr size_t WS_LR = 680 * MiB;
constexpr size_t WS_W2B = 684 * MiB;
constexpr size_t WS_HQA0 = 52 * MiB, WS_HKT0 = 68 * MiB, WS_HQA1 = 84 * MiB, WS_HKT1 = 616 * MiB;
constexpr size_t WS_HSC = 632 * MiB;
constexpr size_t WS_MP = 686 * MiB;
constexpr size_t WS_MLREC = 596 * MiB;
constexpr size_t WS_END = 687 * MiB;
constexpr int CW_Q0 = 64, CW_Q2 = 192, CW_Q1 = 1024, CW_BAR = 4096;

struct Args { const float* in[33]; float* out; unsigned char* ws; int ph_lo, ph_hi; };

__device__ __forceinline__ float bf2f(unsigned short u) { return __uint_as_float((unsigned)u << 16); }
typedef __bf16 bf16x2_t __attribute__((ext_vector_type(2)));
__device__ __forceinline__ unsigned pk2(float lo, float hi) { const f32x2 v = {lo, hi}; const bf16x2_t b = __builtin_convertvector(v, bf16x2_t); return __builtin_bit_cast(unsigned, b); }
__device__ __forceinline__ unsigned f2bf(float f) { return (unsigned)__builtin_bit_cast(unsigned short, (__bf16)f); }
__device__ __forceinline__ float sigm(float x) { return 1.f / (1.f + __expf(-x)); }
__device__ __forceinline__ float silu(float x) { return x / (1.f + __expf(-x)); }
__device__ __forceinline__ void tok_info(int m, int& t, int& T, int& cr) {
    if (m < 4096) { t = m & 255; T = 256; cr = 0; } else { const int mm = m - 4096; t = mm & 2047; T = 2048; cr = 1 + (mm >> 11); }
}
__device__ __forceinline__ const float* x_row(const Args& a, int m) { return m < 4096 ? a.in[0] + (size_t)m * DM : a.in[1] + (size_t)(m - 4096) * DM; }
template <int CTRL> __device__ __forceinline__ float dpp_mov(float v) { return __uint_as_float((unsigned)__builtin_amdgcn_update_dpp(0, (int)__float_as_uint(v), CTRL, 0xF, 0xF, false)); }
__device__ __forceinline__ float row16_sum(float v) {
    v += dpp_mov<0xB1>(v);
    v += dpp_mov<0x4E>(v);
    v += dpp_mov<0x141>(v);
    v += dpp_mov<0x140>(v);
    return v;
}
__device__ __forceinline__ float bflo(unsigned u) { return __uint_as_float(u << 16); }
__device__ __forceinline__ float bfhi(unsigned u) { return __uint_as_float(u & 0xffff0000u); }
__device__ __forceinline__ float quad_sum(float v) { v += dpp_mov<0xB1>(v); v += dpp_mov<0x4E>(v); return v; }
__device__ __forceinline__ float oct_sum(float v) { v = quad_sum(v); v += dpp_mov<0x141>(v); return v; }
__device__ __forceinline__ float wave_sum(float v) {
    v = row16_sum(v);
    const int vi = (int)__float_as_uint(v);
    const float s0 = __uint_as_float((unsigned)__builtin_amdgcn_readlane(vi, 0)), s1 = __uint_as_float((unsigned)__builtin_amdgcn_readlane(vi, 16));
    const float s2 = __uint_as_float((unsigned)__builtin_amdgcn_readlane(vi, 32)), s3 = __uint_as_float((unsigned)__builtin_amdgcn_readlane(vi, 48));
    return (s0 + s1) + (s2 + s3);
}

__device__ __forceinline__ void p0_transpose_item(const float* W, int ldw, int K, int nblk, bf16_t* WT, LAS float* scr, int item, int lane) {
    const int kb = item / nblk, nb = item % nblk, k0 = 64 * kb, n0 = 32 * nb;
    f32x4 v[8];
#pragma unroll
    for (int i = 0; i < 8; ++i) v[i] = *(const f32x4*)(W + (size_t)(k0 + 8 * i + (lane >> 3)) * ldw + n0 + 4 * (lane & 7));
    __builtin_amdgcn_sched_barrier(0);
#pragma unroll
    for (int i = 0; i < 8; ++i) { LAS float* d = scr + (8 * i + (lane >> 3)) * 33 + 4 * (lane & 7); d[0] = v[i].x; d[1] = v[i].y; d[2] = v[i].z; d[3] = v[i].w; }
    asm volatile("s_waitcnt lgkmcnt(0)" ::: "memory");
    const int c = lane & 7;
#pragma unroll
    for (int j = 0; j < 4; ++j) { const int n = (lane >> 3) + 8 * j; const LAS float* s = scr + (8 * c) * 33 + n;
        u32x4 o; o.x = pk2(s[0 * 33], s[1 * 33]); o.y = pk2(s[2 * 33], s[3 * 33]); o.z = pk2(s[4 * 33], s[5 * 33]); o.w = pk2(s[6 * 33], s[7 * 33]);
        *(u32x4*)(WT + (size_t)(n0 + n) * K + k0 + 8 * c) = o; }
    asm volatile("s_waitcnt lgkmcnt(0)" ::: "memory");
}

__device__ __forceinline__ void phase_prologue(const Args& a, LAS unsigned char* lds, int tid, int lane, int wave, int G) {
    unsigned char* ws = a.ws;
    if ((int)blockIdx.x < 96) {
        const int item = blockIdx.x, layer = item / 48, g = item % 48, col = g * 64 + lane;
        const float* wm = a.in[9] + (size_t)layer * 1024 * 3072;
        const float* cctx = a.in[8]; const float* cc = a.in[2];
        float a0 = 0.f, a1 = 0.f, a2 = 0.f;
        const int k0 = wave * 128;
#pragma unroll 8
        for (int k = k0; k < k0 + 128; ++k) {
            const float wv = wm[(size_t)k * 3072 + col];
            a0 += silu(cctx[k]) * wv; a1 += silu(cc[k]) * wv; a2 += silu(cc[1024 + k]) * wv;
        }
        LAS float* red = (LAS float*)lds;
        red[(wave * 3 + 0) * 64 + lane] = a0; red[(wave * 3 + 1) * 64 + lane] = a1; red[(wave * 3 + 2) * 64 + lane] = a2;
        __syncthreads();
        if (tid < 192) { const int r = tid >> 6, l = tid & 63; float s = 0.f;
#pragma unroll
            for (int w = 0; w < 8; ++w) s += red[(w * 3 + r) * 64 + l];
            ((float*)(ws + WS_MOD))[(layer * 3 + r) * 3072 + g * 64 + l] = s + a.in[10][layer * 3072 + g * 64 + l]; }
        __syncthreads();
    }
    for (int idx = blockIdx.x * NT + tid; idx < 16384; idx += G * NT) { const int k = idx >> 4, j = idx & 15; ((float*)(ws + WS_GW))[j * 1024 + k] = a.in[27][(size_t)k * IN_ODD + IN_ODD_MAIN + j]; }
    for (int idx = blockIdx.x * NT + tid; idx < 4096 * 256; idx += G * NT) { const int n = idx >> 8, k = idx & 255, qn = n >> 10, c = n & 1023, qk = k >> 6, j = k & 63;
        float wv = 0.f; if (qn == qk) wv = (qn < 2 ? a.in[19] : a.in[21])[(size_t)((qn & 1) * 64 + j) * 1024 + c];
        ((bf16_t*)(ws + WS_W2B))[idx] = (bf16_t)f2bf(wv); }
    LAS float* scr = (LAS float*)(lds + wave * 16384);
    const int gw = blockIdx.x * NWAVES + wave, NGW = G * NWAVES;
    constexpr int I_E = 16 * 296, I_OE = 32 * 32, NITEMS = I_E + I_OE;
    for (int it = gw; it < NITEMS; it += NGW) {
        int r = it;
        if (r < I_E) { p0_transpose_item(a.in[13], IN_EVEN, 1024, 296, (bf16_t*)(ws + WS_WINE), scr, r, lane); continue; } r -= I_E;
        p0_transpose_item(a.in[14], 1024, 2048, 32, (bf16_t*)(ws + WS_WOUTE), scr, r, lane);
    }
}

__device__ __forceinline__ void modnorm_store(const f32x4 (&v)[4], const float* ng, const float* mod, bf16_t* orow, int lane, f32x4 (&h)[4]) {
    float s = 0.f;
#pragma unroll
    for (int j = 0; j < 4; ++j) s += (v[j].x * v[j].x + v[j].y * v[j].y) + (v[j].z * v[j].z + v[j].w * v[j].w);
    const float rstd = rsqrtf(wave_sum(s) * (1.f / 1024.f) + EPS);
#pragma unroll
    for (int j = 0; j < 4; ++j) { const int col = 4 * lane + 256 * j;
        const f32x4 g4 = *(const f32x4*)(ng + col), sh = *(const f32x4*)(mod + col), sc = *(const f32x4*)(mod + 1024 + col);
        h[j] = v[j] * rstd * g4 * (sc + 1.f) + sh;
        u32x2 o; o.x = pk2(h[j].x, h[j].y); o.y = pk2(h[j].z, h[j].w);
        *(u32x2*)(orow + col) = o; }
}

__device__ __forceinline__ void phase_modnorm0(const Args& a, int lane, int wave, int G) {
    const int gw = blockIdx.x * NWAVES + wave, NGW = G * NWAVES;
    const float* MOD = (const float*)(a.ws + WS_MOD);
    bf16_t* XN = (bf16_t*)(a.ws + WS_XN);
    for (int m = gw; m < NTOK; m += NGW) {
        int t, T, cr; tok_info(m, t, T, cr);
        const f32x4* xr = (const f32x4*)x_row(a, m) + lane;
        f32x4 v[4], h[4];
#pragma unroll
        for (int j = 0; j < 4; ++j) v[j] = xr[64 * j];
        modnorm_store(v, a.in[11], MOD + (0 * 3 + cr) * 3072, XN + (size_t)m * DM, lane, h);
    }
}

__device__ __forceinline__ float shiftv(const bf16_t* P, const float* mu, int m, int t, int T, int cc) {
    const bf16_t* p = P + (size_t)m * IN_EVEN + 5120 + cc;
    const float cur = bf2f(p[0]);
    const float prev = t > 0 ? bf2f(p[-IN_EVEN]) : 0.f;
    const float nxt = t < T - 1 ? bf2f(p[IN_EVEN]) : 0.f;
    return cur + mu[cc] * (prev - cur) + mu[3328 + cc] * (nxt - cur);
}
__device__ __forceinline__ void phase_rwkv_lr(const Args& a, int tid, int G) {
    const bf16_t* P = (const bf16_t*)(a.ws + WS_PROJ); bf16_t* LR = (bf16_t*)(a.ws + WS_LR); const float* mu = a.in[17];
    for (int idx = blockIdx.x * NT + tid; idx < NTOK * 256; idx += G * NT) { const int m = idx >> 8, jj = idx & 255;
        int t, T, cr; tok_info(m, t, T, cr);
        float val = shiftv(P, mu, m, t, T, 3072 + jj);
        if (jj < 128) val = 1.f - 2.f * __builtin_amdgcn_rcpf(1.f + __expf(2.f * val));
        LR[idx] = (bf16_t)f2bf(val); }
    bf16_t* RS = (bf16_t*)(a.ws + WS_RS); bf16_t* KS = (bf16_t*)(a.ws + WS_KS); bf16_t* KKS = (bf16_t*)(a.ws + WS_KKS); bf16_t* oV = (bf16_t*)(a.ws + WS_V);
    const int lane = tid & 63, gw = blockIdx.x * NWAVES + (tid >> 6), NGW = G * NWAVES;
    const int hc = (gw & 15) * 64 + lane;
    float m0c[3], m1c[3];
#pragma unroll
    for (int arr = 0; arr < 3; ++arr) { m0c[arr] = mu[arr * 1024 + hc]; m1c[arr] = mu[3328 + arr * 1024 + hc]; }
    const float kkw = a.in[22][hc];
    for (int item = gw; item < NTOK * 16; item += 2 * NGW) {
        unsigned raw[2][3][3]; float pm[2], nm[2]; int mm[2];
#pragma unroll
        for (int u = 0; u < 2; ++u) { const int it2 = item + u * NGW; const int m = it2 < NTOK * 16 ? (it2 >> 4) : (item >> 4); mm[u] = m;
            int t, T, cr; tok_info(m, t, T, cr);
            const int mp = t > 0 ? m - 1 : m, mn = t < T - 1 ? m + 1 : m; pm[u] = t > 0 ? 1.f : 0.f; nm[u] = t < T - 1 ? 1.f : 0.f;
#pragma unroll
            for (int arr = 0; arr < 3; ++arr) { const int col = 5120 + arr * 1024 + hc;
                raw[u][arr][0] = P[(size_t)mp * IN_EVEN + col]; raw[u][arr][1] = P[(size_t)m * IN_EVEN + col]; raw[u][arr][2] = P[(size_t)mn * IN_EVEN + col]; } }
        __builtin_amdgcn_sched_barrier(0);
#pragma unroll
        for (int u = 0; u < 2; ++u) { float x[3];
#pragma unroll
            for (int arr = 0; arr < 3; ++arr) { const float prev = bflo(raw[u][arr][0]) * pm[u], cur = bflo(raw[u][arr][1]), nxt = bflo(raw[u][arr][2]) * nm[u];
                x[arr] = cur + m0c[arr] * (prev - cur) + m1c[arr] * (nxt - cur); }
            const float kkr = x[1] * kkw; const float nrm = wave_sum(kkr * kkr);
            if (item + u * NGW < NTOK * 16) { const size_t o = (size_t)mm[u] * 1024 + hc;
                RS[o] = (bf16_t)f2bf(x[0]); KS[o] = (bf16_t)f2bf(x[1]); KKS[o] = (bf16_t)f2bf(kkr / fmaxf(sqrtf(nrm), 1e-12f)); oV[o] = (bf16_t)f2bf(x[2]); } }
    }
}

typedef short s16x4g __attribute__((ext_vector_type(4)));
template <int PITCH>
__device__ __forceinline__ bf16x8 tr_frag_p(const LAS unsigned char* img, int rowb, int col0, int r16) {
    const LAS unsigned char* p = img + (rowb + (r16 >> 2)) * PITCH + (col0 + 4 * (r16 & 3)) * 2;
    const s16x4g t0 = __builtin_amdgcn_ds_read_tr16_b64_v4i16((LAS s16x4g*)p), t1 = __builtin_amdgcn_ds_read_tr16_b64_v4i16((LAS s16x4g*)(p + 4 * PITCH));
    return (bf16x8){t0[0], t0[1], t0[2], t0[3], t1[0], t1[1], t1[2], t1[3]};
}
constexpr int RW_RECSZ = 29184, RW_WL = 18432;
__device__ __forceinline__ void rwkv_chunk_job(const Args& a, LAS unsigned char* wl, int lane, int gtb, int h) {
    const bf16_t* U4 = (const bf16_t*)(a.ws + WS_U4);
    const bf16_t* RS = (const bf16_t*)(a.ws + WS_RS); const bf16_t* KS = (const bf16_t*)(a.ws + WS_KS); const bf16_t* KKS = (const bf16_t*)(a.ws + WS_KKS); const bf16_t* Vs = (const bf16_t*)(a.ws + WS_V);
    float* oBS = (float*)(a.ws + WS_BS);
    const int m0 = gtb * 32;
    const int hc = h * 64 + lane, q = lane >> 4, r16 = lane & 15;
    LAS unsigned char* X0 = wl; LAS unsigned char* X1 = wl + 4608; LAS unsigned char* X2 = wl + 9216; LAS unsigned char* X3 = wl + 13824;
    const float ka = a.in[23][hc], rk = a.in[24][hc];
    { u32x4 vp[4];
#pragma unroll
      for (int i = 0; i < 4; ++i) { const int p = lane + 64 * i; vp[i] = *(const u32x4*)(Vs + (size_t)(m0 + (p >> 3)) * 1024 + h * 64 + (p & 7) * 8); }
#pragma unroll
      for (int i = 0; i < 4; ++i) { const int p = lane + 64 * i; *(LAS u32x4*)(X0 + (p >> 3) * 144 + (p & 7) * 16) = vp[i]; }
#pragma unroll
      for (int vt = 0; vt < 4; ++vt) { const bf16x8 ff = tr_frag_p<144>(X0, 8 * q, 16 * vt, r16), fr = tr_frag_p<144>(X0, 24 - 8 * q, 16 * vt, r16);
          *(bf16x8*)(a.ws + WS_RWREC + (size_t)((gtb * 16 + h) * 2 + 0) * RW_RECSZ + (24 + vt) * 1024 + lane * 16) = ff;
          *(bf16x8*)(a.ws + WS_RWREC + (size_t)((gtb * 16 + h) * 2 + 1) * RW_RECSZ + (24 + vt) * 1024 + lane * 16) = (bf16x8){fr[7], fr[6], fr[5], fr[4], fr[3], fr[2], fr[1], fr[0]}; } }
#pragma unroll
    for (int dir = 0; dir < 2; ++dir) {
        unsigned char* rec = a.ws + WS_RWREC + (size_t)((gtb * 16 + h) * 2 + dir) * RW_RECSZ;
        const float w0c = a.in[18][dir * 1024 + hc], a0c = a.in[20][dir * 1024 + hc];
        float cum = 0.f;
        unsigned nlw[8], nav[8], nr[8], nk[8], nkk[8];
#define RW_JLOAD(jo_) do { _Pragma("unroll") for (int ji = 0; ji < 8; ++ji) { const int j = 8 * (jo_) + ji; const int t = dir ? 31 - j : j; \
            const bf16_t* up = U4 + (size_t)(m0 + t) * 4096 + dir * 1024 + hc; const size_t o = (size_t)(m0 + t) * 1024 + hc; \
            nlw[ji] = up[0]; nav[ji] = up[2048]; nr[ji] = RS[o]; nk[ji] = KS[o]; nkk[ji] = KKS[o]; } } while (0)
        RW_JLOAD(0);
#pragma unroll 1
        for (int jo = 0; jo < 4; ++jo) {
            float lw8[8], av8[8], r8[8], k8[8], kk8[8], bs8[8];
#pragma unroll
            for (int ji = 0; ji < 8; ++ji) { lw8[ji] = __uint_as_float(nlw[ji] << 16); av8[ji] = __uint_as_float(nav[ji] << 16); r8[ji] = __uint_as_float(nr[ji] << 16); k8[ji] = __uint_as_float(nk[ji] << 16); kk8[ji] = __uint_as_float(nkk[ji] << 16); }
            if (jo < 3) RW_JLOAD(jo + 1);
            __builtin_amdgcn_sched_barrier(0);
#pragma unroll
            for (int ji = 0; ji < 8; ++ji) { const int j = 8 * jo + ji;
                const float lw = -0.60653066f * sigm(w0c + lw8[ji]), av = sigm(a0c + av8[ji]);
                const float cprev = cum; cum += lw;
                const float kka = kk8[ji] * av, kd = k8[ji] * (1.f + (av - 1.f) * ka);
                bs8[ji] = r8[ji] * kd * rk;
                const float ei = __expf(-cum);
                *(LAS unsigned short*)(X0 + j * 144 + lane * 2) = (unsigned short)f2bf(__expf(cprev) * kk8[ji]);
                *(LAS unsigned short*)(X3 + j * 144 + lane * 2) = (unsigned short)f2bf(__expf(cum) * r8[ji]);
                *(LAS unsigned short*)(X1 + j * 144 + lane * 2) = (unsigned short)f2bf(-kka * ei);
                *(LAS unsigned short*)(X2 + j * 144 + lane * 2) = (unsigned short)f2bf(kd * ei); }
#pragma unroll
            for (int ji = 0; ji < 8; ++ji) { const int j = 8 * jo + ji; const int t = dir ? 31 - j : j; const float bs = wave_sum(bs8[ji]);
                if (lane == 0) oBS[(size_t)dir * NTOK * 16 + (size_t)(m0 + t) * 16 + h] = bs; }
        }
#undef RW_JLOAD
        const float wend = __expf(cum);
        *(float*)(rec + 28672 + lane * 4) = wend;
#define RWF(X, rt, ks) (*(const LAS bf16x8*)((X) + (16 * (rt) + r16) * 144 + (32 * (ks) + 8 * q) * 2))
        f32x4 A1[3], A2T[3], B1[3], B2[3];
#pragma unroll
        for (int tl = 0; tl < 3; ++tl) { const int jt = tl > 0 ? 1 : 0, it = tl == 2 ? 1 : 0;
            f32x4 c1 = (f32x4){0.f, 0.f, 0.f, 0.f}, c2 = c1, c3 = c1, c4 = c1;
#pragma unroll
            for (int ks = 0; ks < 2; ++ks) { const bf16x8 kbj = RWF(X0, jt, ks), rbj = RWF(X3, jt, ks), aci = RWF(X1, it, ks), bci = RWF(X2, it, ks);
                c1 = __builtin_amdgcn_mfma_f32_16x16x32_bf16(kbj, aci, c1, 0, 0, 0);
                c2 = __builtin_amdgcn_mfma_f32_16x16x32_bf16(bci, kbj, c2, 0, 0, 0);
                c3 = __builtin_amdgcn_mfma_f32_16x16x32_bf16(rbj, aci, c3, 0, 0, 0);
                c4 = __builtin_amdgcn_mfma_f32_16x16x32_bf16(rbj, bci, c4, 0, 0, 0); }
#pragma unroll
            for (int rr = 0; rr < 4; ++rr) { const int jrow = 16 * jt + 4 * q + rr, icol = 16 * it + r16;
                c1[rr] = (icol < jrow) ? c1[rr] : 0.f; c3[rr] = (icol <= jrow) ? c3[rr] : 0.f; c4[rr] = (icol <= jrow) ? c4[rr] : 0.f;
                const int irow = 16 * it + 4 * q + rr, jcol = 16 * jt + r16;
                c2[rr] = (irow < jcol) ? c2[rr] : 0.f; }
            A1[tl] = c1; A2T[tl] = c2; B1[tl] = c3; B2[tl] = c4; }
#pragma unroll
        for (int jt = 0; jt < 2; ++jt)
#pragma unroll
            for (int ks = 0; ks < 2; ++ks) { *(bf16x8*)(rec + (jt * 2 + ks) * 1024 + lane * 16) = RWF(X0, jt, ks); *(bf16x8*)(rec + (4 + jt * 2 + ks) * 1024 + lane * 16) = RWF(X3, jt, ks); }
#pragma unroll
        for (int kt = 0; kt < 4; ++kt) { const float we = __shfl(wend, 16 * kt + r16);
            const u32x4 ra = __builtin_bit_cast(u32x4, tr_frag_p<144>(X1, 8 * q, 16 * kt, r16)), rb = __builtin_bit_cast(u32x4, tr_frag_p<144>(X2, 8 * q, 16 * kt, r16));
            u32x4 wa, wb;
#pragma unroll
            for (int x = 0; x < 4; ++x) { wa[x] = pk2(bflo(ra[x]) * we, bfhi(ra[x]) * we); wb[x] = pk2(bflo(rb[x]) * we, bfhi(rb[x]) * we); }
            *(u32x4*)(rec + (16 + kt) * 1024 + lane * 16) = wa;
            *(u32x4*)(rec + (20 + kt) * 1024 + lane * 16) = wb; }
#undef RWF
        LAS float* AS = (LAS float*)X0;
#pragma unroll
        for (int tl = 0; tl < 3; ++tl) { const int jt = tl > 0 ? 1 : 0, it = tl == 2 ? 1 : 0;
#pragma unroll
            for (int rr = 0; rr < 4; ++rr) AS[(16 * jt + 4 * q + rr) * 33 + 16 * it + r16] = A1[tl][rr]; }
#pragma unroll
        for (int rr = 0; rr < 4; ++rr) AS[(4 * q + rr) * 33 + 16 + r16] = 0.f;
        { const int col = lane & 31; float Tr[32];
#pragma unroll
          for (int j = 0; j < 32; ++j) { const float rowv = AS[j * 33 + col]; float acc = (col == j) ? 1.f : 0.f;
#pragma unroll
              for (int i = 0; i < j; ++i) acc += __uint_as_float((unsigned)__builtin_amdgcn_readlane((int)__float_as_uint(rowv), i)) * Tr[i];
              Tr[j] = acc;
              if (lane < 32) *(LAS unsigned short*)(X1 + j * 80 + col * 2) = (unsigned short)f2bf(acc); } }
#pragma unroll
        for (int tl = 0; tl < 3; ++tl) { const int it = tl == 2 ? 1 : 0, jt = tl > 0 ? 1 : 0;
#pragma unroll
            for (int rr = 0; rr < 4; ++rr) *(LAS unsigned short*)(X2 + (16 * it + 4 * q + rr) * 80 + (16 * jt + r16) * 2) = (unsigned short)f2bf(A2T[tl][rr]); }
#pragma unroll
        for (int rr = 0; rr < 4; ++rr) *(LAS unsigned short*)(X2 + (16 + 4 * q + rr) * 80 + r16 * 2) = (unsigned short)0;
        { bf16x8 tf[2], af[2];
#pragma unroll
          for (int x = 0; x < 2; ++x) { tf[x] = *(const LAS bf16x8*)(X1 + (16 * x + r16) * 80 + 8 * q * 2); af[x] = *(const LAS bf16x8*)(X2 + (16 * x + r16) * 80 + 8 * q * 2);
              *(bf16x8*)(rec + (8 + x) * 1024 + lane * 16) = tf[x]; }
#pragma unroll
          for (int jt = 0; jt < 2; ++jt)
#pragma unroll
              for (int it = 0; it < 2; ++it) { f32x4 c = (f32x4){0.f, 0.f, 0.f, 0.f}; c = __builtin_amdgcn_mfma_f32_16x16x32_bf16(tf[jt], af[it], c, 0, 0, 0);
#pragma unroll
                  for (int rr = 0; rr < 4; ++rr) *(LAS unsigned short*)(X3 + (16 * jt + 4 * q + rr) * 80 + (16 * it + r16) * 2) = (unsigned short)f2bf(c[rr]); } }
#pragma unroll
        for (int x = 0; x < 2; ++x) *(bf16x8*)(rec + (10 + x) * 1024 + lane * 16) = *(const LAS bf16x8*)(X3 + (16 * x + r16) * 80 + 8 * q * 2);
#pragma unroll
        for (int which = 0; which < 2; ++which) {
#pragma unroll
            for (int tl = 0; tl < 3; ++tl) { const int jt = tl > 0 ? 1 : 0, it = tl == 2 ? 1 : 0;
#pragma unroll
                for (int rr = 0; rr < 4; ++rr) *(LAS unsigned short*)(X3 + (16 * jt + 4 * q + rr) * 80 + (16 * it + r16) * 2) = (unsigned short)f2bf(which ? B2[tl][rr] : B1[tl][rr]); }
#pragma unroll
            for (int rr = 0; rr < 4; ++rr) *(LAS unsigned short*)(X3 + (4 * q + rr) * 80 + (16 + r16) * 2) = (unsigned short)0;
#pragma unroll
            for (int x = 0; x < 2; ++x) *(bf16x8*)(rec + (12 + 2 * which + x) * 1024 + lane * 16) = *(const LAS bf16x8*)(X3 + (16 * x + r16) * 80 + 8 * q * 2);
        }
    }
}
__device__ __forceinline__ void phase_rwkv_chunks(const Args& a, LAS unsigned char* lds, int lane, int wave, int G) {
    const int gw = blockIdx.x * NWAVES + wave, NGW = G * NWAVES;
    for (int job = gw; job < 256 * 16; job += NGW) rwkv_chunk_job(a, lds + wave * RW_WL, lane, job >> 4, job & 15);
}

constexpr int HP_QA = 0, HP_KT = 8704, HP_TOT = 17408;
__device__ __forceinline__ void hgrn_pre_load(const Args& a, int tid, int gtb, int h, int dir, unsigned (&pq)[8], unsigned (&pf)[8]) {
    const bf16_t* P = (const bf16_t*)(a.ws + WS_PROJ);
    const int m0 = gtb * 32, ch = tid & 127, tq = tid >> 7; const int fcol = (dir ? 3072 : 2048) + h * 128 + ch;
#pragma unroll
    for (int i = 0; i < 8; ++i) { const int ii = 8 * tq + i; const int t = dir ? 31 - ii : ii; const bf16_t* row = P + (size_t)(m0 + t) * IN_EVEN; pq[i] = row[h * 128 + ch]; pf[i] = row[fcol]; }
}
__device__ __forceinline__ void hgrn_pre_job(const Args& a, LAS unsigned char* lds, int tid, int gtb, int h, int dir, const unsigned (&pq)[8], const unsigned (&pf)[8]) {
    bf16_t* QA = (bf16_t*)(a.ws + (dir ? WS_HQA1 : WS_HQA0)); bf16_t* KT = (bf16_t*)(a.ws + (dir ? WS_HKT1 : WS_HKT0));
    float* SC = (float*)(a.ws + WS_HSC) + (size_t)(dir * 256 + gtb) * 3072;
    const int m0 = gtb * 32, ch = tid & 127, tq = tid >> 7;
    LAS unsigned char* Qi = lds + HP_QA; LAS unsigned char* Ki = lds + HP_KT; LAS float* tot = (LAS float*)(lds + HP_TOT);
    const float l0 = a.in[15][h * 128 + ch], l1 = a.in[15][1024 + h * 128 + ch];
    const float lb = 1.f / (1.f + __expf(l1 - l0));
    float bl[8], kv[8]; float run = 0.f;
#pragma unroll
    for (int i = 0; i < 8; ++i) { const float f = lb + (1.f - lb) * sigm(bflo(pf[i])); run += __logf(f); bl[i] = run; kv[i] = 1.f - f; }
    tot[tq * 128 + ch] = run;
    __syncthreads();
    { const float t0 = tot[ch], t1 = tot[128 + ch], t2 = tot[256 + ch], t3 = tot[384 + ch];
      const float off = tq == 0 ? 0.f : (tq == 1 ? t0 : (tq == 2 ? t0 + t1 : t0 + t1 + t2));
      const float bmid = t0 + t1, bend = (t0 + t1) + (t2 + t3);
#pragma unroll
      for (int i = 0; i < 8; ++i) { const float b = off + bl[i]; const int s = 8 * tq + i;
          const float ek = __expf(bmid - b), ea = __builtin_amdgcn_rcpf(ek);
          *(LAS unsigned short*)(Qi + s * 272 + ch * 2) = (unsigned short)f2bf(bflo(pq[i]) * ea);
          *(LAS unsigned short*)(Ki + s * 272 + ch * 2) = (unsigned short)f2bf(kv[i] * ek); }
      if (tq == 0) { SC[h * 128 + ch] = __expf(bmid); SC[1024 + h * 128 + ch] = __expf(bend); SC[2048 + h * 128 + ch] = __expf(bend - bmid); } }
    __syncthreads();
    { const int s = tid >> 4, dc = tid & 15; const size_t o = (size_t)(m0 + s) * 1024 + h * 128 + dc * 8;
      *(u32x4*)(QA + o) = *(const LAS u32x4*)(Qi + s * 272 + dc * 16); *(u32x4*)(KT + o) = *(const LAS u32x4*)(Ki + s * 272 + dc * 16); }
    __syncthreads();
}
__device__ __forceinline__ void hgrn_pre_bundle(const Args& a, LAS unsigned char* lds, int tid, int job0) {
    unsigned qA[8], fA[8], qB[8], fB[8];
#define HP_DEC(j) ((j) >> 4), (((j) >> 1) & 7), ((j) & 1)
    hgrn_pre_load(a, tid, HP_DEC(job0), qA, fA);
#pragma unroll 1
    for (int i = 0; i < 16; i += 2) {
        hgrn_pre_load(a, tid, HP_DEC(job0 + i + 1), qB, fB);
        hgrn_pre_job(a, lds, tid, HP_DEC(job0 + i), qA, fA);
        if (i + 2 < 16) hgrn_pre_load(a, tid, HP_DEC(job0 + i + 2), qA, fA);
        hgrn_pre_job(a, lds, tid, HP_DEC(job0 + i + 1), qB, fB);
    }
#undef HP_DEC
}

constexpr int HG_IMG = 0  , HG_ST = 52224, HG_PM = 87040;
typedef short s16x4h __attribute__((ext_vector_type(4)));
__device__ __forceinline__ bf16x8 tr_frag(const LAS unsigned char* img, int row0, int col0, int q, int r16) {
    const LAS unsigned char* p = img + (row0 + 8 * q + (r16 >> 2)) * 272 + (col0 + 4 * (r16 & 3)) * 2;
    const s16x4h t0 = __builtin_amdgcn_ds_read_tr16_b64_v4i16((LAS s16x4h*)p), t1 = __builtin_amdgcn_ds_read_tr16_b64_v4i16((LAS s16x4h*)(p + 4 * 272));
    return (bf16x8){t0[0], t0[1], t0[2], t0[3], t1[0], t1[1], t1[2], t1[3]};
}
__device__ __forceinline__ void hgrn_task(const Args& a, LAS unsigned char* lds, int tid, int seq, int is_sample, int dir, int h, int half) {
    const bf16_t* P = (const bf16_t*)(a.ws + WS_PROJ);
    const bf16_t* QA = (const bf16_t*)(a.ws + (dir ? WS_HQA1 : WS_HQA0)); const bf16_t* KT = (const bf16_t*)(a.ws + (dir ? WS_HKT1 : WS_HKT0));
    const float* SCb = (const float*)(a.ws + WS_HSC) + (size_t)dir * 256 * 3072;
    bf16_t* O = (bf16_t*)(a.ws + (dir ? WS_OB : WS_OF));
    const int T = is_sample ? 2048 : 256, base = is_sample ? 4096 + seq * 2048 : seq * 256, nch = T / 32, gtb0 = base / 32;
    const int cbeg = is_sample ? half * 32 : 0, cend = is_sample ? cbeg + 32 : nch;
    const int lane = tid & 63, w = __builtin_amdgcn_readfirstlane(tid >> 6), q = lane >> 4, r16 = lane & 15;
    LAS unsigned char* St = lds + HG_ST; LAS unsigned char* Pm = lds + HG_PM;
    f32x4 Sacc[8];
    if (is_sample) { const float* s0 = a.in[3] + ((size_t)((seq * 2 + dir) * 8 + h) * 128) * 128;
#pragma unroll
        for (int j = 0; j < 8; ++j)
#pragma unroll
            for (int r = 0; r < 4; ++r) Sacc[j][r] = s0[(size_t)(16 * w + 4 * q + r) * 128 + 16 * j + r16];
    } else {
#pragma unroll
        for (int j = 0; j < 8; ++j) Sacc[j] = (f32x4){0.f, 0.f, 0.f, 0.f};
    }
#define HG_GTB(c) (gtb0 + (dir ? nch - 1 - (c) : (c)))
#define HG_SCAL(dst, c, which) do { const float* sp = SCb + (size_t)HG_GTB(c) * 3072 + (which) * 1024 + h * 128 + 16 * w + 4 * q; const f32x4 v4 = *(const f32x4*)sp; dst[0] = v4.x; dst[1] = v4.y; dst[2] = v4.z; dst[3] = v4.w; } while (0)
#define HG_STORE_ST(scl) do { _Pragma("unroll") for (int j = 0; j < 8; ++j) { u32x2 pk; pk.x = pk2(Sacc[j][0] * scl[0], Sacc[j][1] * scl[1]); pk.y = pk2(Sacc[j][2] * scl[2], Sacc[j][3] * scl[3]); \
        *(LAS u32x2*)(St + (16 * j + r16) * 272 + (16 * w + 4 * q) * 2) = pk; } } while (0)
    const int ps = tid >> 4, pdc = tid & 15;
#define HG_LOADIMG(rq, rk, rv, c) do { const int gb = HG_GTB(c); const size_t o = (size_t)(gb * 32 + ps) * 1024 + h * 128 + pdc * 8; rq = *(const u32x4*)(QA + o); rk = *(const u32x4*)(KT + o); \
        rv = *(const u32x4*)(P + (size_t)(gb * 32 + (dir ? 31 - ps : ps)) * IN_EVEN + 1024 + h * 128 + pdc * 8); } while (0)
#define HG_WRITE(rq, rk, rv, buf) do { LAS unsigned char* ib = lds + HG_IMG + (buf) * 26112 + ps * 272 + pdc * 16; *(LAS u32x4*)ib = rq; *(LAS u32x4*)(ib + 8704) = rk; *(LAS u32x4*)(ib + 17408) = rv; } while (0)
#define HG_BUNDLE(X, c) do { if ((c) < cend) { HG_SCAL(ebe##X, c, 1); HG_SCAL(ecc##X, c, 2); if ((c) + 1 < cend) { HG_SCAL(ebm##X, (c) + 1, 0); HG_LOADIMG(rq##X, rk##X, rv##X, (c) + 1); } } } while (0)
    u32x4 rqA, rkA, rvA, rqB, rkB, rvB; float ebeA[4], eccA[4], ebmA[4], ebeB[4], eccB[4], ebmB[4];
    rqA = rkA = rvA = rqB = rkB = rvB = (u32x4){0u, 0u, 0u, 0u};
#pragma unroll
    for (int r = 0; r < 4; ++r) { ebeA[r] = eccA[r] = ebmA[r] = ebeB[r] = eccB[r] = ebmB[r] = 0.f; }
    if (cbeg > 0) {
#define HG_LOADKV(rk, rv, c) do { const int gb = HG_GTB(c); rk = *(const u32x4*)(KT + (size_t)(gb * 32 + ps) * 1024 + h * 128 + pdc * 8); \
        rv = *(const u32x4*)(P + (size_t)(gb * 32 + (dir ? 31 - ps : ps)) * IN_EVEN + 1024 + h * 128 + pdc * 8); } while (0)
#define HG_WRITEKV(rk, rv, buf) do { LAS unsigned char* ib = lds + HG_IMG + (buf) * 26112 + ps * 272 + pdc * 16; *(LAS u32x4*)(ib + 8704) = rk; *(LAS u32x4*)(ib + 17408) = rv; } while (0)
#define HG_LBUNDLE(X, c) do { if ((c) < cbeg) { HG_SCAL(ebe##X, c, 1); HG_SCAL(ecc##X, c, 2); if ((c) + 1 < cbeg) HG_LOADKV(rk##X, rv##X, (c) + 1); } } while (0)
#define HG_LIGHT(X, c) do { const LAS unsigned char* Ki = lds + HG_IMG + ((c) & 1) * 26112 + 8704; const LAS unsigned char* Vi = Ki + 8704; \
        __syncthreads(); \
        const bf16x8 kta = tr_frag(Ki, 0, 16 * w, q, r16); \
        _Pragma("unroll") for (int j = 0; j < 8; ++j) { const bf16x8 vfj = tr_frag(Vi, 0, 16 * j, q, r16); f32x4 t4 = (f32x4){0.f, 0.f, 0.f, 0.f}; t4 = __builtin_amdgcn_mfma_f32_16x16x32_bf16(kta, vfj, t4, 0, 0, 0); \
            _Pragma("unroll") for (int r = 0; r < 4; ++r) Sacc[j][r] = ebe##X[r] * Sacc[j][r] + ecc##X[r] * t4[r]; } \
        if ((c) + 1 < cbeg) HG_WRITEKV(rk##X, rv##X, ((c) + 1) & 1); \
        HG_LBUNDLE(X, (c) + 2); } while (0)
        { u32x4 k0, v0; HG_LOADKV(k0, v0, 0); HG_WRITEKV(k0, v0, 0); }
        HG_LBUNDLE(A, 0); HG_LBUNDLE(B, 1);
#pragma unroll 1
        for (int c = 0; c < cbeg; c += 2) { HG_LIGHT(A, c); HG_LIGHT(B, c + 1); }
#undef HG_LIGHT
#undef HG_LBUNDLE
#undef HG_WRITEKV
#undef HG_LOADKV
    }
    { float e0[4]; HG_SCAL(e0, cbeg, 0); u32x4 q0, k0, v0; HG_LOADIMG(q0, k0, v0, cbeg); HG_STORE_ST(e0); HG_WRITE(q0, k0, v0, 0); }
    HG_BUNDLE(A, cbeg); HG_BUNDLE(B, cbeg + 1);
#define HG_CHUNK(X, c) do { \
        const LAS unsigned char* Qi = lds + HG_IMG + ((c) & 1) * 26112; const LAS unsigned char* Ki = Qi + 8704; const LAS unsigned char* Vi = Qi + 17408; \
        __syncthreads();                                             \
        if (w < 3) { const int tt = w > 0 ? 1 : 0, ss = w == 2 ? 1 : 0; \
            f32x4 s4 = (f32x4){0.f, 0.f, 0.f, 0.f}; \
            _Pragma("unroll") for (int ks = 0; ks < 4; ++ks) { const bf16x8 af = *(const LAS bf16x8*)(Qi + (16 * tt + r16) * 272 + (32 * ks + 8 * q) * 2); const bf16x8 bf = *(const LAS bf16x8*)(Ki + (16 * ss + r16) * 272 + (32 * ks + 8 * q) * 2); \
                s4 = __builtin_amdgcn_mfma_f32_16x16x32_bf16(af, bf, s4, 0, 0, 0); } \
            _Pragma("unroll") for (int r = 0; r < 4; ++r) { const int trow = 16 * tt + 4 * q + r, scol = 16 * ss + r16; \
                *(LAS unsigned short*)(Pm + trow * 80 + scol * 2) = (unsigned short)((scol <= trow) ? f2bf(s4[r]) : 0u); } \
        } else if (w == 3) { \
            _Pragma("unroll") for (int r = 0; r < 4; ++r) *(LAS unsigned short*)(Pm + (4 * q + r) * 80 + (16 + r16) * 2) = (unsigned short)0; \
        } \
        f32x4 oacc[2]; \
        _Pragma("unroll") for (int tt = 0; tt < 2; ++tt) { oacc[tt] = (f32x4){0.f, 0.f, 0.f, 0.f}; \
            _Pragma("unroll") for (int ks = 0; ks < 4; ++ks) { const bf16x8 af = *(const LAS bf16x8*)(Qi + (16 * tt + r16) * 272 + (32 * ks + 8 * q) * 2); const bf16x8 bf = *(const LAS bf16x8*)(St + (16 * w + r16) * 272 + (32 * ks + 8 * q) * 2); \
                oacc[tt] = __builtin_amdgcn_mfma_f32_16x16x32_bf16(af, bf, oacc[tt], 0, 0, 0); } } \
        bf16x8 vf[8]; \
        _Pragma("unroll") for (int j = 0; j < 8; ++j) vf[j] = tr_frag(Vi, 0, 16 * j, q, r16); \
        const bf16x8 kta = tr_frag(Ki, 0, 16 * w, q, r16); \
        __syncthreads();                                             \
        { const bf16x8 vown = tr_frag(Vi, 0, 16 * w, q, r16);        \
          _Pragma("unroll") for (int tt = 0; tt < 2; ++tt) { const bf16x8 pf_ = *(const LAS bf16x8*)(Pm + (16 * tt + r16) * 80 + q * 16); \
              oacc[tt] = __builtin_amdgcn_mfma_f32_16x16x32_bf16(pf_, vown, oacc[tt], 0, 0, 0); \
              _Pragma("unroll") for (int r = 0; r < 4; ++r) { const int ii = (c) * 32 + 16 * tt + 4 * q + r; const int t = dir ? (T - 1 - ii) : ii; \
                  O[(size_t)(base + t) * 1024 + h * 128 + 16 * w + r16] = (bf16_t)f2bf(oacc[tt][r]); } } } \
        _Pragma("unroll") for (int j = 0; j < 8; ++j) { f32x4 t4 = (f32x4){0.f, 0.f, 0.f, 0.f}; t4 = __builtin_amdgcn_mfma_f32_16x16x32_bf16(kta, vf[j], t4, 0, 0, 0); \
            _Pragma("unroll") for (int r = 0; r < 4; ++r) Sacc[j][r] = ebe##X[r] * Sacc[j][r] + ecc##X[r] * t4[r]; } \
        if ((c) + 1 < cend) { HG_STORE_ST(ebm##X); HG_WRITE(rq##X, rk##X, rv##X, ((c) + 1) & 1); } \
        HG_BUNDLE(X, (c) + 2); \
    } while (0)
    for (int c = cbeg; c < cend; c += 2) { HG_CHUNK(A, c); HG_CHUNK(B, c + 1); }
#undef HG_CHUNK
#undef HG_BUNDLE
#undef HG_LOADIMG
#undef HG_WRITE
#undef HG_SCAL
#undef HG_GTB
#undef HG_STORE_ST
    if (!is_sample) { float* so = a.out + OUT_HGRN + ((size_t)((seq * 2 + dir) * 8 + h) * 128) * 128;
#pragma unroll
        for (int j = 0; j < 8; ++j)
#pragma unroll
            for (int r = 0; r < 4; ++r) so[(size_t)(16 * w + 4 * q + r) * 128 + 16 * j + r16] = Sacc[j][r]; }
    __syncthreads();
}

constexpr int RWS_STAGE = 32768;
__device__ __forceinline__ void rwkv_scan_block(const Args& a, LAS unsigned char* lds, int tid, int rid0, int nrec, int is_sample) {
    const int lane = tid & 63, wave = __builtin_amdgcn_readfirstlane(tid >> 6);
    const int rsel = nrec == 2 ? wave >> 2 : 0, vt = wave & 3, nf = 3 * nrec;
    const bool comp = nrec == 2 || wave < 4;
    const int lf0 = nrec == 2 ? vt * 6 : wave * 3;
    const int rid = rid0 + rsel, h = rid & 15, dir = (rid >> 4) & 1, seq = rid >> 5;
    const int T = is_sample ? 2048 : 256, base = is_sample ? 4096 + seq * 2048 : seq * 256;
    const int nblk = T / 32, gtb0 = base / 32;
    const int q = lane >> 4, r16 = lane & 15;
    LAS unsigned char* SA = lds + wave * 4096; LAS unsigned char* UA = SA + 2304;
    LAS unsigned char* stg = lds + RWS_STAGE + rsel * 24576 + lane * 16;
    bf16_t* Y = (bf16_t*)(a.ws + (dir ? WS_YB : WS_YF));
    f32x4 S[4];
    if (is_sample) { const float* sp = a.in[4] + (size_t)((seq * 2 + dir) * 16 + h) * 4096;
#pragma unroll
        for (int kt = 0; kt < 4; ++kt)
#pragma unroll
            for (int r = 0; r < 4; ++r) S[kt][r] = sp[(size_t)(16 * vt + 4 * q + r) * 64 + 16 * kt + r16];
    } else {
#pragma unroll
        for (int kt = 0; kt < 4; ++kt) S[kt] = (f32x4){0.f, 0.f, 0.f, 0.f};
    }
#define RW_REC(c) (a.ws + WS_RWREC + (size_t)(((gtb0 + (dir ? nblk - 1 - (c) : (c))) * 16 + h) * 2 + dir) * RW_RECSZ)
#define RW_FR(rec, f) (*(const bf16x8*)((rec) + (f) * 1024 + lane * 16))
#define RW_LF(buf, f) (*(const LAS bf16x8*)(stg + (buf) * 49152 + (f) * 1024))
#define RW_GLOAD(g, rec) do { _Pragma("unroll") for (int i_ = 0; i_ < 6; ++i_) if (i_ < nf) g[i_] = *(const u32x4*)((rec) + (lf0 + i_) * 1024 + lane * 16); } while (0)
#define RW_GWRITE(g, buf) do { _Pragma("unroll") for (int i_ = 0; i_ < 6; ++i_) if (i_ < nf) *(LAS u32x4*)(stg + (buf) * 49152 + (lf0 + i_) * 1024) = g[i_]; } while (0)
    u32x4 gA[6], gB[6]; bf16x8 VA; float we[4];
#pragma unroll
    for (int i = 0; i < 6; ++i) { gA[i] = (u32x4){0u, 0u, 0u, 0u}; gB[i] = gA[i]; }
    { const unsigned char* rec0 = RW_REC(0); const unsigned char* rec1 = RW_REC(1);
      RW_GLOAD(gB, rec0); RW_GLOAD(gA, rec1);
      VA = RW_FR(rec0, 24 + vt);
#pragma unroll
      for (int x = 0; x < 4; ++x) we[x] = *(const float*)(rec0 + 28672 + (16 * x + r16) * 4);
      RW_GWRITE(gB, 0); }
    __syncthreads();
#define RW_STEP(GX, GY, c) do { \
        const unsigned char* nrec1 = RW_REC((c) + 1 < nblk ? (c) + 1 : nblk - 1); const unsigned char* nrec2 = RW_REC((c) + 2 < nblk ? (c) + 2 : nblk - 1); \
        const bf16x8 VAn = RW_FR(nrec1, 24 + vt); float wen[4]; \
        _Pragma("unroll") for (int x = 0; x < 4; ++x) wen[x] = *(const float*)(nrec1 + 28672 + (16 * x + r16) * 4); \
        RW_GLOAD(GY, nrec2); \
        if (comp) { const int bf_ = (c) & 1; \
            _Pragma("unroll") for (int kt = 0; kt < 4; ++kt) _Pragma("unroll") for (int r = 0; r < 4; ++r) *(LAS unsigned short*)(SA + (4 * q + r) * 144 + (16 * kt + r16) * 2) = (unsigned short)f2bf(S[kt][r]); \
            const bf16x8 sa0 = *(const LAS bf16x8*)(SA + r16 * 144 + (8 * q) * 2), sa1 = *(const LAS bf16x8*)(SA + r16 * 144 + (32 + 8 * q) * 2); \
            f32x4 ut[2], yt[2]; \
            _Pragma("unroll") for (int jt = 0; jt < 2; ++jt) { ut[jt] = (f32x4){0.f, 0.f, 0.f, 0.f}; yt[jt] = ut[jt]; \
                ut[jt] = __builtin_amdgcn_mfma_f32_16x16x32_bf16(sa0, RW_LF(bf_, jt * 2), ut[jt], 0, 0, 0); ut[jt] = __builtin_amdgcn_mfma_f32_16x16x32_bf16(sa1, RW_LF(bf_, jt * 2 + 1), ut[jt], 0, 0, 0); \
                yt[jt] = __builtin_amdgcn_mfma_f32_16x16x32_bf16(sa0, RW_LF(bf_, 4 + jt * 2), yt[jt], 0, 0, 0); yt[jt] = __builtin_amdgcn_mfma_f32_16x16x32_bf16(sa1, RW_LF(bf_, 4 + jt * 2 + 1), yt[jt], 0, 0, 0); } \
            _Pragma("unroll") for (int jt = 0; jt < 2; ++jt) _Pragma("unroll") for (int r = 0; r < 4; ++r) *(LAS unsigned short*)(UA + (4 * q + r) * 80 + (16 * jt + r16) * 2) = (unsigned short)f2bf(ut[jt][r]); \
            const bf16x8 ua0 = *(const LAS bf16x8*)(UA + r16 * 80 + 8 * q * 2); \
            f32x4 u2[2]; \
            _Pragma("unroll") for (int jt = 0; jt < 2; ++jt) { u2[jt] = (f32x4){0.f, 0.f, 0.f, 0.f}; \
                u2[jt] = __builtin_amdgcn_mfma_f32_16x16x32_bf16(ua0, RW_LF(bf_, 8 + jt), u2[jt], 0, 0, 0); u2[jt] = __builtin_amdgcn_mfma_f32_16x16x32_bf16(VA, RW_LF(bf_, 10 + jt), u2[jt], 0, 0, 0); } \
            _Pragma("unroll") for (int jt = 0; jt < 2; ++jt) _Pragma("unroll") for (int r = 0; r < 4; ++r) *(LAS unsigned short*)(UA + (4 * q + r) * 80 + (16 * jt + r16) * 2) = (unsigned short)f2bf(u2[jt][r]); \
            const bf16x8 ua1 = *(const LAS bf16x8*)(UA + r16 * 80 + 8 * q * 2); \
            _Pragma("unroll") for (int jt = 0; jt < 2; ++jt) { yt[jt] = __builtin_amdgcn_mfma_f32_16x16x32_bf16(ua1, RW_LF(bf_, 12 + jt), yt[jt], 0, 0, 0); yt[jt] = __builtin_amdgcn_mfma_f32_16x16x32_bf16(VA, RW_LF(bf_, 14 + jt), yt[jt], 0, 0, 0); } \
            { const int tb = dir ? nblk - 1 - (c) : (c); \
              _Pragma("unroll") for (int jt = 0; jt < 2; ++jt) { const int j = 16 * jt + r16; const int tl = dir ? 31 - j : j; \
                  *(u32x2*)(Y + (size_t)(base + tb * 32 + tl) * 1024 + h * 64 + 16 * vt + 4 * q) = (u32x2){pk2(yt[jt][0], yt[jt][1]), pk2(yt[jt][2], yt[jt][3])}; } } \
            _Pragma("unroll") for (int kt = 0; kt < 4; ++kt) { S[kt] *= we[kt]; \
                S[kt] = __builtin_amdgcn_mfma_f32_16x16x32_bf16(ua1, RW_LF(bf_, 16 + kt), S[kt], 0, 0, 0); S[kt] = __builtin_amdgcn_mfma_f32_16x16x32_bf16(VA, RW_LF(bf_, 20 + kt), S[kt], 0, 0, 0); } \
        } \
        RW_GWRITE(GX, ((c) + 1) & 1); \
        __syncthreads(); \
        VA = VAn; \
        _Pragma("unroll") for (int x = 0; x < 4; ++x) we[x] = wen[x]; \
    } while (0)
    for (int c = 0; c < nblk; c += 2) { RW_STEP(gA, gB, c); RW_STEP(gB, gA, c + 1); }
#undef RW_STEP
#undef RW_GLOAD
#undef RW_GWRITE
#undef RW_LF
#undef RW_REC
#undef RW_FR
    if (!is_sample) { float* so = a.out + OUT_RWKV + (size_t)((seq * 2 + dir) * 16 + h) * 4096;
#pragma unroll
        for (int kt = 0; kt < 4; ++kt)
#pragma unroll
            for (int r = 0; r < 4; ++r) so[(size_t)(16 * vt + 4 * q + r) * 64 + 16 * kt + r16] = S[kt][r]; }
}

__device__ __forceinline__ int queue_pop(unsigned* head, volatile LAS unsigned* slot, int tid) {
    __syncthreads();
    if (tid == 0) slot[0] = __hip_atomic_fetch_add(head, 1u, __ATOMIC_RELAXED, __HIP_MEMORY_SCOPE_AGENT);
    __syncthreads();
    return (int)slot[0];
}

__device__ __forceinline__ void phase_scans_even(const Args& a, LAS unsigned char* lds, int tid, int qoff) {
    unsigned* head = (unsigned*)(a.ws + WS_CTL) + CW_Q0 + qoff;
    volatile LAS unsigned* slot = (volatile LAS unsigned*)(lds + MISC_OFF);
    const int lane = tid & 63, wave = __builtin_amdgcn_readfirstlane(tid >> 6);
    for (;;) {
        int task = queue_pop(head, slot, tid);
        if (task >= 1408) break;
        if (task >= 128 && task < 896) { LAS float* scr = (LAS float*)(lds + wave * 16384); const int r = (task - 128) * 8 + wave;
            if (r < 5120) p0_transpose_item(a.in[27], IN_ODD, 1024, 320, (bf16_t*)(a.ws + WS_WINO), scr, r, lane);
            else p0_transpose_item(a.in[28], 1024, 2048, 32, (bf16_t*)(a.ws + WS_WOUTO), scr, r - 5120, lane);
            continue; }
        const bool is_h = task < 64 || (task >= 896 && task < 1152);
        if (is_h) { const int is_sample = task < 64; const int k = is_sample ? task & 31 : task - 896; hgrn_task(a, lds, tid, k >> 4, is_sample, (k >> 3) & 1, k & 7, 1 - (task >> 5)); }
        else { const int is_sample = task < 128; rwkv_scan_block(a, lds, tid, is_sample ? task - 64 : 2 * (task - 1152), is_sample ? 1 : 2, is_sample); }
    }
}

__device__ __forceinline__ void phase_combine_even(const Args& a, int lane, int wave, int G) {
    const int gw = blockIdx.x * NWAVES + wave, NGW = G * NWAVES;
    const bf16_t* OF = (const bf16_t*)(a.ws + WS_OF); const bf16_t* OB = (const bf16_t*)(a.ws + WS_OB);
    const bf16_t* YF = (const bf16_t*)(a.ws + WS_YF); const bf16_t* YB = (const bf16_t*)(a.ws + WS_YB);
    const bf16_t* P = (const bf16_t*)(a.ws + WS_PROJ); const bf16_t* V = (const bf16_t*)(a.ws + WS_V); const float* BS = (const float*)(a.ws + WS_BS);
    bf16_t* Yo = (bf16_t*)(a.ws + WS_Y);
    const int c0 = 16 * lane, hh = lane >> 2;
    f32x4 hg4[4], gg4[4], gb4[4];
#pragma unroll
    for (int q = 0; q < 4; ++q) { hg4[q] = *(const f32x4*)(a.in[16] + c0 + 4 * q); gg4[q] = *(const f32x4*)(a.in[25] + c0 + 4 * q); gb4[q] = *(const f32x4*)(a.in[26] + c0 + 4 * q); }
    for (int m = gw; m < NTOK; m += NGW) {
        f32x4 of[4], ob[4], yf[4], yb[4]; u32x4 za[2], zb[2], vv[2], rof[2], rob[2], ryf[2], ryb[2];
#pragma unroll
        for (int x = 0; x < 2; ++x) { rof[x] = *(const u32x4*)(OF + (size_t)m * 1024 + c0 + 8 * x); rob[x] = *(const u32x4*)(OB + (size_t)m * 1024 + c0 + 8 * x);
            ryf[x] = *(const u32x4*)(YF + (size_t)m * 1024 + c0 + 8 * x); ryb[x] = *(const u32x4*)(YB + (size_t)m * 1024 + c0 + 8 * x); }
#pragma unroll
        for (int x = 0; x < 2; ++x) { za[x] = *(const u32x4*)(P + (size_t)m * IN_EVEN + 4096 + c0 + 8 * x); zb[x] = *(const u32x4*)(P + (size_t)m * IN_EVEN + 8448 + c0 + 8 * x); vv[x] = *(const u32x4*)(V + (size_t)m * 1024 + c0 + 8 * x); }
#pragma unroll
        for (int q = 0; q < 4; ++q) { const int x = q >> 1, j = (q & 1) * 2;
            of[q] = (f32x4){bflo(rof[x][j]), bfhi(rof[x][j]), bflo(rof[x][j + 1]), bfhi(rof[x][j + 1])}; ob[q] = (f32x4){bflo(rob[x][j]), bfhi(rob[x][j]), bflo(rob[x][j + 1]), bfhi(rob[x][j + 1])};
            yf[q] = (f32x4){bflo(ryf[x][j]), bfhi(ryf[x][j]), bflo(ryf[x][j + 1]), bfhi(ryf[x][j + 1])}; yb[q] = (f32x4){bflo(ryb[x][j]), bfhi(ryb[x][j]), bflo(ryb[x][j + 1]), bfhi(ryb[x][j + 1])}; }
        const float bon = BS[(size_t)m * 16 + hh] + BS[(size_t)NTOK * 16 + (size_t)m * 16 + hh];
        float ss = 0.f;
#pragma unroll
        for (int q = 0; q < 4; ++q) { of[q] = of[q] + ob[q]; ss += (of[q].x * of[q].x + of[q].y * of[q].y) + (of[q].z * of[q].z + of[q].w * of[q].w); }
        const float rs = rsqrtf(oct_sum(ss) * (1.f / 128.f) + EPS);
        { unsigned w[8];
#pragma unroll
          for (int q = 0; q < 4; ++q) { const unsigned z01 = za[q >> 1][(q & 1) * 2], z23 = za[q >> 1][(q & 1) * 2 + 1]; const f32x4 o = of[q] * rs * hg4[q];
              w[2 * q] = pk2(o.x * silu(bflo(z01)), o.y * silu(bfhi(z01))); w[2 * q + 1] = pk2(o.z * silu(bflo(z23)), o.w * silu(bfhi(z23))); }
          u32x4* dst = (u32x4*)(Yo + (size_t)m * 2048 + c0);
          dst[0] = (u32x4){w[0], w[1], w[2], w[3]}; dst[1] = (u32x4){w[4], w[5], w[6], w[7]}; }
        float sm = 0.f;
#pragma unroll
        for (int q = 0; q < 4; ++q) { yf[q] = yf[q] + yb[q]; sm += (yf[q].x + yf[q].y) + (yf[q].z + yf[q].w); }
        const float mean = quad_sum(sm) * (1.f / 64.f); float sq = 0.f;
#pragma unroll
        for (int q = 0; q < 4; ++q) { yf[q] = yf[q] - mean; sq += (yf[q].x * yf[q].x + yf[q].y * yf[q].y) + (yf[q].z * yf[q].z + yf[q].w * yf[q].w); }
        const float rg = rsqrtf(quad_sum(sq) * (1.f / 64.f) + GN_EPS);
        { unsigned w[8];
#pragma unroll
          for (int q = 0; q < 4; ++q) { const unsigned z01 = zb[q >> 1][(q & 1) * 2], z23 = zb[q >> 1][(q & 1) * 2 + 1], v01 = vv[q >> 1][(q & 1) * 2], v23 = vv[q >> 1][(q & 1) * 2 + 1];
              const f32x4 g = yf[q] * rg * gg4[q] + gb4[q];
              w[2 * q] = pk2((g.x + bon * bflo(v01)) * silu(bflo(z01)), (g.y + bon * bfhi(v01)) * silu(bfhi(z01)));
              w[2 * q + 1] = pk2((g.z + bon * bflo(v23)) * silu(bflo(z23)), (g.w + bon * bfhi(v23)) * silu(bfhi(z23))); }
          u32x4* dst = (u32x4*)(Yo + (size_t)m * 2048 + 1024 + c0);
          dst[0] = (u32x4){w[0], w[1], w[2], w[3]}; dst[1] = (u32x4){w[4], w[5], w[6], w[7]}; }
    }
}

__device__ __forceinline__ void phase_res_modnorm1(const Args& a, int lane, int wave, int G) {
    const int gw = blockIdx.x * NWAVES + wave, NGW = G * NWAVES;
    const float* MOD = (const float*)(a.ws + WS_MOD); const bf16_t* PART = (const bf16_t*)(a.ws + WS_PART); const float* GW = (const float*)(a.ws + WS_GW);
    float* X1 = (float*)(a.ws + WS_X1); bf16_t* XN = (bf16_t*)(a.ws + WS_XN); float* GT = (float*)(a.ws + WS_GT);
    for (int m = gw; m < NTOK; m += NGW) {
        int t, T, cr; tok_info(m, t, T, cr);
        const f32x4* xr = (const f32x4*)x_row(a, m) + lane;
        const u32x2* p0 = (const u32x2*)(PART + (size_t)m * 1024) + lane; const u32x2* p1 = (const u32x2*)(PART + (size_t)NTOK * 1024 + (size_t)m * 1024) + lane;
        const f32x4* gt = (const f32x4*)(MOD + (0 * 3 + cr) * 3072 + 2048) + lane;
        f32x4 v[4], h[4];
#pragma unroll
        for (int j = 0; j < 4; ++j) { { const u32x2 a0 = p0[64 * j], a1 = p1[64 * j]; const f32x4 ps = (f32x4){bflo(a0.x) + bflo(a1.x), bfhi(a0.x) + bfhi(a1.x), bflo(a0.y) + bflo(a1.y), bfhi(a0.y) + bfhi(a1.y)}; v[j] = xr[64 * j] + gt[64 * j] * ps; } ((f32x4*)(X1 + (size_t)m * 1024))[lane + 64 * j] = v[j]; }
        modnorm_store(v, a.in[11] + 1024, MOD + (1 * 3 + cr) * 3072, XN + (size_t)m * DM, lane, h);
        float myg = 0.f;
#pragma unroll
        for (int jg = 0; jg < 16; ++jg) { float d = 0.f;
#pragma unroll
            for (int j = 0; j < 4; ++j) { const f32x4 w4 = *(const f32x4*)(GW + jg * 1024 + 4 * lane + 256 * j); d += (h[j].x * w4.x + h[j].y * w4.y) + (h[j].z * w4.z + h[j].w * w4.w); }
            d = wave_sum(d);
            if (lane == jg) myg = d; }
        if (lane < 16) GT[(size_t)m * 16 + lane] = myg + a.in[31][lane];
    }
}

__device__ __forceinline__ void conv_fma8(float (&acc)[8], const u32x4 x, const f32x4 w0, const f32x4 w1) {
    acc[0] += bflo(x.x) * w0.x; acc[1] += bfhi(x.x) * w0.y; acc[2] += bflo(x.y) * w0.z; acc[3] += bfhi(x.y) * w0.w;
    acc[4] += bflo(x.z) * w1.x; acc[5] += bfhi(x.z) * w1.y; acc[6] += bflo(x.w) * w1.z; acc[7] += bfhi(x.w) * w1.w;
}
__device__ __forceinline__ u32x4 conv_out8(const float (&acc)[8], float sc) {
    u32x4 o; o.x = pk2(silu(acc[0]) * sc, silu(acc[1]) * sc); o.y = pk2(silu(acc[2]) * sc, silu(acc[3]) * sc); o.z = pk2(silu(acc[4]) * sc, silu(acc[5]) * sc); o.w = pk2(silu(acc[6]) * sc, silu(acc[7]) * sc); return o;
}
__device__ __forceinline__ void phase_conv(const Args& a, int tid, int G) {
    const bf16_t* P = (const bf16_t*)(a.ws + WS_PROJ); bf16_t* QKC = (bf16_t*)(a.ws + WS_QKC);
    const float* cw = a.in[29]; const float* cb = a.in[30];
    const int c0 = tid * 8;
    const float sc = c0 >= 2048 ? 0.044194173824159216f : 1.f;
    const f32x4 b0 = *(const f32x4*)(cb + c0), b1 = *(const f32x4*)(cb + c0 + 4);
    const u32x4 zero4 = (u32x4){0u, 0u, 0u, 0u};
    for (int gtb = blockIdx.x; gtb < 256; gtb += G) {
        const int m0 = gtb * 32;
        if (m0 < 4096) {
            f32x4 w0[3], w1[3];
#pragma unroll
            for (int j = 0; j < 3; ++j) { w0[j] = *(const f32x4*)(cw + (size_t)(3 + j) * 4096 + c0); w1[j] = *(const f32x4*)(cw + (size_t)(3 + j) * 4096 + c0 + 4); }
            const int t0 = m0 & 255;
#pragma unroll 1
            for (int s8 = 0; s8 < 4; ++s8) { u32x4 x[10];
#pragma unroll
                for (int i = 0; i < 10; ++i) { const int t = t0 + 8 * s8 + i - 1; x[i] = (t >= 0 && t < 256) ? *(const u32x4*)(P + (size_t)(m0 + 8 * s8 + i - 1) * IN_ODD_MAIN + c0) : zero4; }
                __builtin_amdgcn_sched_barrier(0);
#pragma unroll
                for (int i = 0; i < 8; ++i) { float acc[8] = {b0.x, b0.y, b0.z, b0.w, b1.x, b1.y, b1.z, b1.w};
#pragma unroll
                    for (int j = 0; j < 3; ++j) conv_fma8(acc, x[i + j], w0[j], w1[j]);
                    *(u32x4*)(QKC + (size_t)(m0 + 8 * s8 + i) * 4096 + c0) = conv_out8(acc, sc); } }
        } else {
            f32x4 w0[9], w1[9];
#pragma unroll
            for (int j = 0; j < 9; ++j) { w0[j] = *(const f32x4*)(cw + (size_t)j * 4096 + c0); w1[j] = *(const f32x4*)(cw + (size_t)j * 4096 + c0 + 4); }
            const int tl = (m0 - 4096) & 2047, r = tl >> 6, cw0 = tl & 63;
#pragma unroll 1
            for (int s4 = 0; s4 < 8; ++s4) { u32x4 x[3][6];
#pragma unroll
                for (int i3 = 0; i3 < 3; ++i3)
#pragma unroll
                    for (int i = 0; i < 6; ++i) { const int rr = r + i3 - 1, cc = cw0 + 4 * s4 + i - 1;
                        x[i3][i] = (rr >= 0 && rr < 32 && cc >= 0 && cc < 64) ? *(const u32x4*)(P + (size_t)(m0 + (i3 - 1) * 64 + 4 * s4 + i - 1) * IN_ODD_MAIN + c0) : zero4; }
                __builtin_amdgcn_sched_barrier(0);
#pragma unroll
                for (int i = 0; i < 4; ++i) { float acc[8] = {b0.x, b0.y, b0.z, b0.w, b1.x, b1.y, b1.z, b1.w};
#pragma unroll
                    for (int i3 = 0; i3 < 3; ++i3)
#pragma unroll
                        for (int j = 0; j < 3; ++j) conv_fma8(acc, x[i3][i + j], w0[i3 * 3 + j], w1[i3 * 3 + j]);
                    *(u32x4*)(QKC + (size_t)(m0 + 4 * s4 + i) * 4096 + c0) = conv_out8(acc, sc); } }
        }
    }
}

constexpr int ML_RECSZ = 2560;
__device__ __forceinline__ float logsig(float x) { return fminf(x, 0.f) - log1pf(__expf(-fabsf(x))); }
__device__ __forceinline__ void mlstm_gate_scan(const Args& a, int lane, int rid) {
    const float* GT = (const float*)(a.ws + WS_GT); float* MP = (float*)(a.ws + WS_MP);
    const int is_sample = rid < 16, k = is_sample ? rid : rid - 16, h = k & 3, dir = (k >> 2) & 1, seq = k >> 3;
    const int T = is_sample ? 2048 : 256, base = is_sample ? 4096 + seq * 2048 : seq * 256, nch = T / 32;
    float B = 0.f, Gm = -3.0e38f;
    if (lane < nch) { float gi[32], gf[32];
#pragma unroll
        for (int i = 0; i < 32; ++i) { const int ii = lane * 32 + i; const int t = dir ? (T - 1 - ii) : ii; gi[i] = GT[(size_t)(base + t) * 16 + dir * 4 + h]; gf[i] = GT[(size_t)(base + t) * 16 + (2 + dir) * 4 + h]; }
#pragma unroll
        for (int i = 0; i < 32; ++i) { B += logsig(gf[i]); Gm = fmaxf(Gm, gi[i] - B); } }
    float m = is_sample ? a.in[7][(seq * 2 + dir) * 4 + h] : 0.f;
    for (int c = 0; c < nch; ++c) { const float Bc = __shfl(B, c), Gc = __shfl(Gm, c);
        if (lane == 0) MP[rid * 64 + c] = m;
        m = Bc + fmaxf(m, Gc); }
    if (!is_sample && lane == 0) a.out[OUT_M + (seq * 2 + dir) * 4 + h] = m;
}
__device__ __forceinline__ void mlstm_sp_job(const Args& a, LAS unsigned char* wl, int lane, int gtb, int h) {
    const bf16_t* QKC = (const bf16_t*)(a.ws + WS_QKC); const float* GT = (const float*)(a.ws + WS_GT); const float* MP = (const float*)(a.ws + WS_MP);
    const int m0 = gtb * 32, is_sample = m0 >= 4096;
    const int seq = is_sample ? (m0 - 4096) >> 11 : m0 >> 8, T = is_sample ? 2048 : 256, base = is_sample ? 4096 + seq * 2048 : seq * 256;
    const int tb = (m0 - base) >> 5, nblk = T / 32, q = lane >> 4, r16 = lane & 15;
    LAS unsigned char* PL = wl; LAS float* sc = (LAS float*)(wl + 2560);
    f32x4 S[2][2];
#pragma unroll
    for (int x = 0; x < 2; ++x)
#pragma unroll
        for (int y = 0; y < 2; ++y) S[x][y] = (f32x4){0.f, 0.f, 0.f, 0.f};
#pragma unroll 1
    for (int kg = 0; kg < 4; ++kg) { bf16x8 qf[2][4], kf[2][4];
#pragma unroll
        for (int x = 0; x < 2; ++x)
#pragma unroll
            for (int k4 = 0; k4 < 4; ++k4) { const bf16_t* row = QKC + (size_t)(m0 + 16 * x + r16) * 4096 + h * 512 + 32 * (4 * kg + k4) + 8 * q;
                qf[x][k4] = *(const bf16x8*)row; kf[x][k4] = *(const bf16x8*)(row + 2048); }
        __builtin_amdgcn_sched_barrier(0);
#pragma unroll
        for (int k4 = 0; k4 < 4; ++k4)
#pragma unroll
            for (int x = 0; x < 2; ++x)
#pragma unroll
                for (int y = 0; y < 2; ++y) S[x][y] = __builtin_amdgcn_mfma_f32_16x16x32_bf16(qf[x][k4], kf[y][k4], S[x][y], 0, 0, 0); }
#pragma unroll
    for (int dir = 0; dir < 2; ++dir) {
        const int rid = is_sample ? (seq * 2 + dir) * 4 + h : 16 + (seq * 2 + dir) * 4 + h, c = dir ? nblk - 1 - tb : tb;
        const float m_prev = MP[rid * 64 + c];
        unsigned char* rec = a.ws + WS_MLREC + (size_t)(rid * 64 + c) * ML_RECSZ;
        { const int i = lane & 31, t = dir ? 31 - i : i;
          const float li = GT[(size_t)(m0 + t) * 16 + dir * 4 + h], lf = logsig(GT[(size_t)(m0 + t) * 16 + (2 + dir) * 4 + h]);
          float b = lf;
#pragma unroll
          for (int o = 1; o < 32; o <<= 1) { const float x = __shfl_up(b, o, 32); if (i >= o) b += x; }
          const float g = li - b; float G = g;
#pragma unroll
          for (int o = 1; o < 32; o <<= 1) { const float x = __shfl_up(G, o, 32); if (i >= o) G = fmaxf(G, x); }
          const float M = fmaxf(m_prev, G), Mend = __shfl(M, 31);
          if (lane < 32) { sc[i] = g; sc[32 + i] = M;
              *(float*)(rec + 2048 + i * 4) = __expf(m_prev - M); *(float*)(rec + 2176 + i * 4) = __expf(g - Mend); *(float*)(rec + 2304 + i * 4) = __expf(-(b + M));
              if (lane == 0) *(float*)(rec + 2432) = __expf(m_prev - Mend); } }
#pragma unroll
        for (int x = 0; x < 2; ++x)
#pragma unroll
            for (int y = 0; y < 2; ++y)
#pragma unroll
                for (int r = 0; r < 4; ++r) { const int t = 16 * x + 4 * q + r, s = 16 * y + r16; const int i = dir ? 31 - t : t, j = dir ? 31 - s : s;
                    const float v = (j <= i) ? S[x][y][r] * __expf(sc[j] - sc[32 + i]) : 0.f;
                    *(LAS unsigned short*)(PL + i * 80 + j * 2) = (unsigned short)f2bf(v); }
#pragma unroll
        for (int x = 0; x < 2; ++x) *(bf16x8*)(rec + x * 1024 + lane * 16) = *(const LAS bf16x8*)(PL + (16 * x + r16) * 80 + 8 * q * 2);
    }
}
__device__ __forceinline__ void phase_mlstm_pre(const Args& a, LAS unsigned char* lds, int lane, int wave, int G) {
    const int gw = blockIdx.x * NWAVES + wave, NGW = G * NWAVES;
    for (int job = gw; job < 256 * 4; job += NGW) mlstm_sp_job(a, lds + wave * 3072, lane, job >> 2, job & 3);
}

constexpr int ML_PITCH = 1040;
#ifndef ML_TR
#define ML_TR 1
#endif
typedef short s16x4 __attribute__((ext_vector_type(4)));
constexpr int M2_QS = 0, M2_KS = 33280, M2_PS = 66560, M2_VT = 132096;
template <bool DEN>
__device__ __forceinline__ void mlstm_scan_task(const Args& a, LAS unsigned char* lds, int tid, int seq, int is_sample, int dir, int h, int sl) {
    constexpr int ne = DEN ? 1 : 4;
    const bf16_t* QKC = (const bf16_t*)(a.ws + WS_QKC); const bf16_t* P = (const bf16_t*)(a.ws + WS_PROJ);
    bf16_t* H = (bf16_t*)(a.ws + (dir ? WS_HB : WS_HF)); float* DN = (float*)(a.ws + WS_DEN) + (size_t)dir * NTOK * 4;
    const int T = is_sample ? 2048 : 256, base = is_sample ? 4096 + seq * 2048 : seq * 256, nch = T / 32;
    const int rid = is_sample ? (seq * 2 + dir) * 4 + h : 16 + (seq * 2 + dir) * 4 + h;
    const unsigned char* rec0 = a.ws + WS_MLREC + (size_t)rid * 64 * ML_RECSZ;
    asm volatile("" : "+v"(tid));
    const int lane = tid & 63, w = __builtin_amdgcn_readfirstlane(tid >> 6), tt = w & 1, et = w >> 1, q = lane >> 4, r16 = lane & 15;
    LAS unsigned char* Qs = lds + M2_QS; LAS unsigned char* Ks = lds + M2_KS; LAS unsigned char* PS = lds + M2_PS; LAS unsigned char* VT = lds + M2_VT;
    const size_t sb = (size_t)((seq * 2 + dir) * 4 + h);
    f32x4 Cacc[4][4];
    if (is_sample && !DEN) { const float* src = a.in[5] + (sb * 512) * 512 + sl * 64;
        for (int i = tid; i < 512 * 16; i += NT) { const int d = i >> 4, c4 = i & 15; *(LAS f32x4*)(lds + d * 272 + c4 * 16) = *(const f32x4*)(src + (size_t)d * 512 + 4 * c4); }
        __syncthreads(); }
#pragma unroll
    for (int dt = 0; dt < 4; ++dt)
#pragma unroll
        for (int e = 0; e < 4; ++e)
#pragma unroll
            for (int r = 0; r < 4; ++r) { float v = 0.f;
                if (is_sample) { if (DEN) { if (e == 0) v = (r16 == 0) ? a.in[6][sb * 512 + 64 * w + 16 * dt + 4 * q + r] : 0.f; }
                                 else v = *(const LAS float*)(lds + (64 * w + 16 * dt + 4 * q + r) * 272 + (16 * e + r16) * 4); }
                Cacc[dt][e][r] = v; }
    __syncthreads();
    if (DEN) { for (int i = tid; i < 5120; i += NT) ((LAS unsigned*)VT)[i] = 0u;
        __syncthreads();
        if (tid < 80) *(LAS unsigned short*)(VT + (tid >= 40 ? 10240 : 0) + (tid % 40) * 2) = (unsigned short)0x3F80; }
    u32x4 pq[4], pk_[4]; u32x4 pv = (u32x4){0u, 0u, 0u, 0u}; float pws = 0.f;
#define M2_LOAD(c) do { const unsigned char* rc = rec0 + (size_t)(c) * ML_RECSZ; \
        _Pragma("unroll") for (int i = 0; i < 4; ++i) { const int idx = tid + 512 * i; const int j = idx >> 6, c16 = idx & 63; const int ii = (c) * 32 + j; const int t = dir ? (T - 1 - ii) : ii; \
        const bf16_t* row = QKC + (size_t)(base + t) * 4096 + h * 512 + c16 * 8; pq[i] = *(const u32x4*)row; pk_[i] = *(const u32x4*)(row + 2048); } \
        if (!DEN && tid < 256) { const int j = tid & 31, c16 = tid >> 5; const int ii = (c) * 32 + j; const int t = dir ? (T - 1 - ii) : ii; \
            pv = *(const u32x4*)(P + (size_t)(base + t) * IN_ODD_MAIN + 4096 + h * 512 + sl * 64 + c16 * 8); pws = *(const float*)(rc + 2176 + j * 4); } \
        if (DEN && tid < 32) pws = *(const float*)(rc + 2176 + tid * 4); } while (0)
#define M2_STORE(buf) do { LAS unsigned char* vb = VT + (buf) * 10240; \
        _Pragma("unroll") for (int i = 0; i < 4; ++i) { const int idx = tid + 512 * i; const int j = idx >> 6, c16 = idx & 63; \
            *(LAS u32x4*)(Qs + j * ML_PITCH + c16 * 16) = pq[i]; *(LAS u32x4*)(Ks + j * ML_PITCH + c16 * 16) = pk_[i]; } \
        if (!DEN && tid < 256) { const int j = tid & 31, c16 = tid >> 5; const unsigned vv[4] = {pv.x, pv.y, pv.z, pv.w}; \
            _Pragma("unroll") for (int i = 0; i < 4; ++i) { const int e0 = c16 * 8 + 2 * i; \
                *(LAS unsigned short*)(vb + e0 * 80 + j * 2) = (unsigned short)(vv[i] & 0xffffu); *(LAS unsigned short*)(vb + (e0 + 1) * 80 + j * 2) = (unsigned short)(vv[i] >> 16); \
                *(LAS unsigned short*)(vb + 5120 + e0 * 80 + j * 2) = (unsigned short)f2bf(bflo(vv[i]) * pws); *(LAS unsigned short*)(vb + 5120 + (e0 + 1) * 80 + j * 2) = (unsigned short)f2bf(bfhi(vv[i]) * pws); } } \
        if (DEN && tid < 32) *(LAS unsigned short*)(vb + 5120 + tid * 2) = (unsigned short)f2bf(pws); } while (0)
    LAS float* wold_s = (LAS float*)(lds + 152576);
    if (tid < nch) wold_s[tid] = *(const float*)(rec0 + (size_t)tid * ML_RECSZ + 2432);
    M2_LOAD(0);
    M2_STORE(0);
    __syncthreads();
    for (int c = 0; c < nch; ++c) {
        const unsigned char* rc = rec0 + (size_t)c * ML_RECSZ;
        const int buf = c & 1;
        bf16x8 pfrag = (bf16x8){0, 0, 0, 0, 0, 0, 0, 0}; float wp[4] = {0.f, 0.f, 0.f, 0.f}, cl[4] = {0.f, 0.f, 0.f, 0.f};
        if (et < ne) { pfrag = *(const bf16x8*)(rc + tt * 1024 + lane * 16);
#pragma unroll
            for (int r = 0; r < 4; ++r) { wp[r] = *(const float*)(rc + 2048 + (16 * tt + 4 * q + r) * 4); if constexpr (DEN) cl[r] = *(const float*)(rc + 2304 + (16 * tt + 4 * q + r) * 4); } }
        const float w_old = wold_s[c];
        if (c + 1 < nch) M2_LOAD(c + 1);
#pragma unroll
        for (int x = 0; x < 2; ++x) { f32x4 part[4];
#pragma unroll
          for (int e = 0; e < 4; ++e) part[e] = (f32x4){0.f, 0.f, 0.f, 0.f};
#pragma unroll
          for (int s = 0; s < 2; ++s) {
              const LAS unsigned char* qp = Qs + (16 * x + r16) * ML_PITCH + (64 * w + 32 * s + 4 * q) * 2;
              const u32x2 lo = *(const LAS u32x2*)qp, hi = *(const LAS u32x2*)(qp + 32);
              const u32x4 af = (u32x4){lo.x, lo.y, hi.x, hi.y};
#pragma unroll
              for (int e = 0; e < 4; ++e) if (e < ne) { u32x4 bfr; bfr.x = pk2(Cacc[2 * s][e][0], Cacc[2 * s][e][1]); bfr.y = pk2(Cacc[2 * s][e][2], Cacc[2 * s][e][3]);
                  bfr.z = pk2(Cacc[2 * s + 1][e][0], Cacc[2 * s + 1][e][1]); bfr.w = pk2(Cacc[2 * s + 1][e][2], Cacc[2 * s + 1][e][3]);
                  part[e] = __builtin_amdgcn_mfma_f32_16x16x32_bf16(__builtin_bit_cast(bf16x8, af), __builtin_bit_cast(bf16x8, bfr), part[e], 0, 0, 0); } }
#pragma unroll
          for (int e = 0; e < 4; ++e) if (e < ne) *(LAS u32x2*)(PS + ((w * 2 + x) * 4 + e) * 512 + lane * 8) = (u32x2){pk2(part[e][0], part[e][1]), pk2(part[e][2], part[e][3])};
          __builtin_amdgcn_sched_barrier(0); }
#pragma unroll
        for (int dt = 0; dt < 4; ++dt)
#pragma unroll
            for (int e = 0; e < 4; ++e) Cacc[dt][e] *= w_old;
        { bf16x8 bfr[4];
#pragma unroll
          for (int e = 0; e < 4; ++e) if (e < ne) bfr[e] = *(const LAS bf16x8*)(VT + buf * 10240 + 5120 + (16 * e + r16) * 80 + q * 16);
#pragma unroll
          for (int dt = 0; dt < 4; ++dt) {
#if ML_TR
              const LAS unsigned char* kp = Ks + (8 * q + (r16 >> 2)) * ML_PITCH + (64 * w + 16 * dt + 4 * (r16 & 3)) * 2;
              const s16x4 t0 = __builtin_amdgcn_ds_read_tr16_b64_v4i16((LAS s16x4*)kp), t1 = __builtin_amdgcn_ds_read_tr16_b64_v4i16((LAS s16x4*)(kp + 4 * ML_PITCH));
              const bf16x8 afv = (bf16x8){t0[0], t0[1], t0[2], t0[3], t1[0], t1[1], t1[2], t1[3]};
              const u32x4 af = __builtin_bit_cast(u32x4, afv);
#else
              unsigned kx[8];
#pragma unroll
              for (int j = 0; j < 8; ++j) kx[j] = *(const LAS unsigned short*)(Ks + (8 * q + j) * ML_PITCH + (64 * w + 16 * dt + r16) * 2);
              const u32x4 af = (u32x4){kx[0] | (kx[1] << 16), kx[2] | (kx[3] << 16), kx[4] | (kx[5] << 16), kx[6] | (kx[7] << 16)};
#endif
#pragma unroll
              for (int e = 0; e < 4; ++e) if (e < ne) Cacc[dt][e] = __builtin_amdgcn_mfma_f32_16x16x32_bf16(__builtin_bit_cast(bf16x8, af), bfr[e], Cacc[dt][e], 0, 0, 0);
              __builtin_amdgcn_sched_barrier(0); } }
        __syncthreads();
        if (et < ne) { f32x4 n4 = (f32x4){0.f, 0.f, 0.f, 0.f};
#pragma unroll
            for (int ww = 0; ww < 8; ++ww) { const u32x2 pp = *(const LAS u32x2*)(PS + ((ww * 2 + tt) * 4 + et) * 512 + lane * 8); n4 += (f32x4){bflo(pp.x), bfhi(pp.x), bflo(pp.y), bfhi(pp.y)}; }
#pragma unroll
            for (int r = 0; r < 4; ++r) n4[r] *= wp[r];
            const bf16x8 vf = *(const LAS bf16x8*)(VT + buf * 10240 + (16 * et + r16) * 80 + q * 16);
            n4 = __builtin_amdgcn_mfma_f32_16x16x32_bf16(pfrag, vf, n4, 0, 0, 0);
#pragma unroll
            for (int r = 0; r < 4; ++r) { const int ii = c * 32 + 16 * tt + 4 * q + r; const int t = dir ? (T - 1 - ii) : ii;
                if (DEN) { if (r16 == 0) DN[(size_t)(base + t) * 4 + h] = fmaxf(fabsf(n4[r]), cl[r]); }
                else H[(size_t)(base + t) * 2048 + h * 512 + sl * 64 + 16 * et + r16] = (bf16_t)f2bf(n4[r]); } }
        if (c + 1 < nch) M2_STORE(buf ^ 1);
        __syncthreads();
    }
#undef M2_LOAD
#undef M2_STORE
    if (!is_sample) {
        if (DEN) {
#pragma unroll
            for (int dt = 0; dt < 4; ++dt)
#pragma unroll
                for (int r = 0; r < 4; ++r) if (r16 == 0) a.out[OUT_N + sb * 512 + 64 * w + 16 * dt + 4 * q + r] = Cacc[dt][0][r];
        } else {
#pragma unroll
            for (int dt = 0; dt < 4; ++dt)
#pragma unroll
                for (int e = 0; e < 4; ++e)
#pragma unroll
                    for (int r = 0; r < 4; ++r) *(LAS float*)(lds + (64 * w + 16 * dt + 4 * q + r) * 272 + (16 * e + r16) * 4) = Cacc[dt][e][r];
            __syncthreads();
            float* dst = a.out + OUT_C + (sb * 512) * 512 + sl * 64;
            for (int i = tid; i < 512 * 16; i += NT) { const int d = i >> 4, c4 = i & 15; *(f32x4*)(dst + (size_t)d * 512 + 4 * c4) = *(const LAS f32x4*)(lds + d * 272 + c4 * 16); }
        }
    }
    __syncthreads();
}

__device__ __forceinline__ void phase_scans_odd(const Args& a, LAS unsigned char* lds, int tid, int qoff) {
    const int xg = blockIdx.x & 7;
    unsigned* head = (unsigned*)(a.ws + WS_CTL) + CW_Q1 + qoff + 64 * xg;
    volatile LAS unsigned* slot = (volatile LAS unsigned*)(lds + MISC_OFF);
    for (;;) {
        const int task = queue_pop(head, slot, tid);
        if (task >= 162) break;
        const int rl = task / 9, k9 = task - rl * 9;
        const int is_sample = rl < 2; const int rec = is_sample ? xg * 2 + rl : xg * 16 + (rl - 2);
        const int h = rec & 3, dir = (rec >> 2) & 1, seq = rec >> 3;
        if (k9 == 8) mlstm_scan_task<true>(a, lds, tid, seq, is_sample, dir, h, 0); else mlstm_scan_task<false>(a, lds, tid, seq, is_sample, dir, h, k9);
    }
}

__device__ __forceinline__ void phase_combine_odd(const Args& a, int lane, int wave, int G) {
    const int gw = blockIdx.x * NWAVES + wave, NGW = G * NWAVES;
    const bf16_t* HF = (const bf16_t*)(a.ws + WS_HF); const bf16_t* HB = (const bf16_t*)(a.ws + WS_HB);
    const bf16_t* P = (const bf16_t*)(a.ws + WS_PROJ); bf16_t* Yo = (bf16_t*)(a.ws + WS_Y); const float* DNp = (const float*)(a.ws + WS_DEN);
    const float* ng = a.in[32];
    const int c0 = 32 * lane;
    for (int m = gw; m < NTOK; m += NGW) {
        f32x4 hf[8], hb[8]; u32x4 ov[4], zv[4], rhf[4], rhb[4];
#pragma unroll
        for (int x = 0; x < 4; ++x) { rhf[x] = *(const u32x4*)(HF + (size_t)m * 2048 + c0 + 8 * x); rhb[x] = *(const u32x4*)(HB + (size_t)m * 2048 + c0 + 8 * x); }
#pragma unroll
        for (int x = 0; x < 4; ++x) { ov[x] = *(const u32x4*)(P + (size_t)m * IN_ODD_MAIN + 6144 + c0 + 8 * x); zv[x] = *(const u32x4*)(P + (size_t)m * IN_ODD_MAIN + 8192 + c0 + 8 * x); }
#pragma unroll
        for (int q = 0; q < 8; ++q) { const int x = q >> 1, j = (q & 1) * 2;
            hf[q] = (f32x4){bflo(rhf[x][j]), bfhi(rhf[x][j]), bflo(rhf[x][j + 1]), bfhi(rhf[x][j + 1])}; hb[q] = (f32x4){bflo(rhb[x][j]), bfhi(rhb[x][j]), bflo(rhb[x][j + 1]), bfhi(rhb[x][j + 1])}; }
        const float idf = 1.f / DNp[(size_t)m * 4 + (lane >> 4)], idb = 1.f / DNp[(size_t)NTOK * 4 + (size_t)m * 4 + (lane >> 4)];
        float ss = 0.f;
#pragma unroll
        for (int q = 0; q < 8; ++q) { const unsigned o01 = ov[q >> 1][(q & 1) * 2], o23 = ov[q >> 1][(q & 1) * 2 + 1];
            f32x4 y = hf[q] * idf + hb[q] * idb;
            y.x *= sigm(bflo(o01)); y.y *= sigm(bfhi(o01)); y.z *= sigm(bflo(o23)); y.w *= sigm(bfhi(o23));
            hf[q] = y; ss += (y.x * y.x + y.y * y.y) + (y.z * y.z + y.w * y.w); }
        const float rs = rsqrtf(row16_sum(ss) * (1.f / 512.f) + EPS);
        unsigned w[16];
#pragma unroll
        for (int q = 0; q < 8; ++q) { const unsigned z01 = zv[q >> 1][(q & 1) * 2], z23 = zv[q >> 1][(q & 1) * 2 + 1]; const f32x4 g4 = *(const f32x4*)(ng + c0 + 4 * q); const f32x4 y = hf[q] * rs * g4;
            w[2 * q] = pk2(y.x * silu(bflo(z01)), y.y * silu(bfhi(z01))); w[2 * q + 1] = pk2(y.z * silu(bflo(z23)), y.w * silu(bfhi(z23))); }
        u32x4* dst = (u32x4*)(Yo + (size_t)m * 2048 + c0);
#pragma unroll
        for (int q = 0; q < 4; ++q) dst[q] = (u32x4){w[4 * q], w[4 * q + 1], w[4 * q + 2], w[4 * q + 3]};
    }
}

__device__ __forceinline__ void phase_final(const Args& a, int lane, int wave, int G) {
    const int gw = blockIdx.x * NWAVES + wave, NGW = G * NWAVES;
    const float* MOD = (const float*)(a.ws + WS_MOD); const bf16_t* PART = (const bf16_t*)(a.ws + WS_PART); const float* X1 = (const float*)(a.ws + WS_X1);
    const float* fg = a.in[12];
    for (int m = gw; m < NTOK; m += NGW) {
        int t, T, cr; tok_info(m, t, T, cr);
        const f32x4* xr = (const f32x4*)(X1 + (size_t)m * 1024) + lane;
        const u32x2* p0 = (const u32x2*)(PART + (size_t)m * 1024) + lane; const u32x2* p1 = (const u32x2*)(PART + (size_t)NTOK * 1024 + (size_t)m * 1024) + lane;
        const f32x4* gt = (const f32x4*)(MOD + (1 * 3 + cr) * 3072 + 2048) + lane;
        f32x4 v[4]; float s = 0.f;
#pragma unroll
        for (int j = 0; j < 4; ++j) { { const u32x2 a0 = p0[64 * j], a1 = p1[64 * j]; const f32x4 ps = (f32x4){bflo(a0.x) + bflo(a1.x), bfhi(a0.x) + bfhi(a1.x), bflo(a0.y) + bflo(a1.y), bfhi(a0.y) + bfhi(a1.y)}; v[j] = xr[64 * j] + gt[64 * j] * ps; } s += (v[j].x * v[j].x + v[j].y * v[j].y) + (v[j].z * v[j].z + v[j].w * v[j].w); }
        const float rstd = rsqrtf(wave_sum(s) * (1.f / 1024.f) + EPS);
#pragma unroll
        for (int j = 0; j < 4; ++j) { const f32x4 g4 = *(const f32x4*)(fg + 4 * lane + 256 * j); ((f32x4*)(a.out + OUT_Y + (size_t)m * 1024))[lane + 64 * j] = v[j] * rstd * g4; }
    }
}


#define XB_TMO      128
#define XB_XCNT(j)  (256  + 64 * (j))
#define XB_XSUB(j)  (1280 + 64 * (j))
#define XB_XGEN(j)  (2304 + 64 * (j))
#define XB_TOP      3328
#define XB_TOPGEN   3392
#define XCD_BAR_WORDS 3456
#define XB_SPIN_CAP (1u << 18)
__device__ __forceinline__ unsigned xb_ld(unsigned* p)              { return __hip_atomic_load(p, __ATOMIC_RELAXED, __HIP_MEMORY_SCOPE_AGENT); }
__device__ __forceinline__ unsigned xb_add(unsigned* p, unsigned v) { return __hip_atomic_fetch_add(p, v, __ATOMIC_RELAXED, __HIP_MEMORY_SCOPE_AGENT); }
__device__ __forceinline__ unsigned xb_xcc_id() { return (unsigned)__builtin_amdgcn_s_getreg((3 << 11) | 20) & 0xFu; }
#define XB_SPIN(cond, bar) do { unsigned _sp = 0; while (cond) { __builtin_amdgcn_s_sleep(1); \
    if ((++_sp & 255u) == 0u) { if (xb_ld(&(bar)[XB_TMO])) break; if (_sp > XB_SPIN_CAP) { atomicAdd(&(bar)[XB_TMO], 1u); break; } } } } while (0)
struct XcdBarrier { unsigned* bar; unsigned x; volatile LAS unsigned* st; };
__device__ __forceinline__ XcdBarrier xcd_barrier_post(unsigned* bar, volatile LAS unsigned* st) {
    XcdBarrier b; b.bar = bar; b.x = xb_xcc_id(); b.st = st;
    if (threadIdx.x == 0) (void)xb_add(&bar[XB_XCNT(b.x)], 1u);
    return b;
}
__device__ __forceinline__ void xcd_barrier_complete(unsigned* bar, unsigned x, unsigned& nloc, unsigned& nx) {
    const unsigned G = gridDim.x * gridDim.y * gridDim.z;
    unsigned sum, cnt, mine, sp = 0u;
    for (;;) {
        sum = 0u; cnt = 0u; mine = 0u;
#pragma unroll
        for (unsigned j = 0; j < 16; ++j) { const unsigned c = xb_ld(&bar[XB_XCNT(j)]); sum += c; cnt += (c > 0u) ? 1u : 0u; mine = (j == x) ? c : mine; }
        if (sum == G) break;
        __builtin_amdgcn_s_sleep(1);
        if ((++sp & 255u) == 0u) { if (xb_ld(&bar[XB_TMO])) break; if (sp > XB_SPIN_CAP) { atomicAdd(&bar[XB_TMO], 1u); break; } }
    }
    nloc = mine > 0u ? mine : 1u; nx = cnt > 0u ? cnt : 1u;
}
__device__ __forceinline__ void xcd_barrier(const XcdBarrier& b) {
    asm volatile("s_waitcnt vmcnt(0)" ::: "memory");
    __syncthreads();
    if (threadIdx.x == 0) {
        unsigned* bar = b.bar;
        __builtin_amdgcn_s_waitcnt(0);
        unsigned nloc = b.st[0], nx = b.st[1];
        if (nloc == 0u) { xcd_barrier_complete(bar, b.x, nloc, nx); b.st[0] = nloc; b.st[1] = nx; }
        const unsigned old = xb_add(&bar[XB_XSUB(b.x)], 1u);
        const unsigned gen = old / nloc;
        if (old + 1u == (gen + 1u) * nloc) {
            __builtin_amdgcn_fence(__ATOMIC_RELEASE, "agent");
            asm volatile("s_waitcnt vmcnt(0)" ::: "memory");
            const unsigned og = xb_add(&bar[XB_TOP], 1u);
            const unsigned tg = og / nx;
            if (og + 1u == (tg + 1u) * nx) xb_add(&bar[XB_TOPGEN], 1u);
            else XB_SPIN(xb_ld(&bar[XB_TOPGEN]) == tg, bar);
            __builtin_amdgcn_fence(__ATOMIC_ACQUIRE, "agent");
            xb_add(&bar[XB_XGEN(b.x)], 1u);
            asm volatile("s_waitcnt vmcnt(0)" ::: "memory");
        } else {
            XB_SPIN(xb_ld(&bar[XB_XGEN(b.x)]) == gen, bar);
            __builtin_amdgcn_fence(__ATOMIC_ACQUIRE, "agent");
            asm volatile("s_waitcnt vmcnt(0)" ::: "memory");
        }
    }
    __syncthreads();
}

constexpr int N_PHASES = 17;
#ifndef PROBE_MASK
#define PROBE_MASK 0u
#endif
template <int K>
__device__ __forceinline__ void run_phase(const Args& a, LAS unsigned char* lds, int tid_, int G, int rep) {
    int tid = tid_; asm volatile("" : "+v"(tid)); const int lane = tid & 63, wave = __builtin_amdgcn_readfirstlane(tid >> 6);
    if constexpr (K == 0) phase_prologue(a, lds, tid, lane, wave, G);
    else if constexpr (K == 1) phase_modnorm0(a, lane, wave, G);
    else if constexpr (K == 2) { pg8::Gemm g{(const bf16_t*)(a.ws + WS_XN), (const bf16_t*)(a.ws + WS_WINE), NTOK, IN_EVEN, 1024, 1024}; pg8::StaticOrder S; S.init(NTOK, IN_EVEN, G, (int)blockIdx.x);
        pg8::EpiBf16 E{(bf16_t*)(a.ws + WS_PROJ), IN_EVEN};
        pg8::gemm_phase<pg8::EpiBf16, pg8::StaticOrder, true, true>(lds, g, S, E); }
    else if constexpr (K == 3) phase_rwkv_lr(a, tid, G);
    else if constexpr (K == 4) { pg8::Gemm g{(const bf16_t*)(a.ws + WS_LR), (const bf16_t*)(a.ws + WS_W2B), NTOK, 4096, 128, 256}; pg8::LowRankOrder S; S.S.init(NTOK, 4096, G, (int)blockIdx.x);
        pg8::EpiBf16 E{(bf16_t*)(a.ws + WS_U4), 4096};
        pg8::gemm_phase<pg8::EpiBf16, pg8::LowRankOrder, true, true>(lds, g, S, E); }
    else if constexpr (K == 5) {
        unsigned* head = (unsigned*)(a.ws + WS_CTL) + CW_Q2 + rep * 2048; volatile LAS unsigned* slot = (volatile LAS unsigned*)(lds + MISC_OFF);
        for (;;) { const int task = queue_pop(head, slot, tid); if (task >= 768) break;
            const int grp = task / 3, sub = task - grp * 3;
            if (sub < 2) { const int job = (grp * 2 + sub) * 8 + wave; rwkv_chunk_job(a, lds + wave * RW_WL, lane, job >> 4, job & 15); }
            else hgrn_pre_bundle(a, lds, tid, grp * 16); } }
    else if constexpr (K == 6) phase_scans_even(a, lds, tid, rep * 2048);
    else if constexpr (K == 7) phase_combine_even(a, lane, wave, G);
    else if constexpr (K == 8) { pg8::Gemm g{(const bf16_t*)(a.ws + WS_Y), (const bf16_t*)(a.ws + WS_WOUTE), NTOK, 1024, 1024, 2048}; pg8::SplitKOrder S{G, (int)blockIdx.x};
        pg8::EpiBf16Part E{(bf16_t*)(a.ws + WS_PART), 1024, (size_t)NTOK * 1024};
        pg8::gemm_phase<pg8::EpiBf16Part, pg8::SplitKOrder, false, true>(lds, g, S, E); }
    else if constexpr (K == 9) phase_res_modnorm1(a, lane, wave, G);
    else if constexpr (K == 10) { pg8::Gemm g{(const bf16_t*)(a.ws + WS_XN), (const bf16_t*)(a.ws + WS_WINO), NTOK, IN_ODD_MAIN, 1024, 1024}; pg8::StaticOrder S; S.init(NTOK, IN_ODD_MAIN, G, (int)blockIdx.x);
        pg8::EpiBf16 E{(bf16_t*)(a.ws + WS_PROJ), IN_ODD_MAIN};
        pg8::gemm_phase<pg8::EpiBf16, pg8::StaticOrder, true, true>(lds, g, S, E); }
    else if constexpr (K == 11) { { const int gw = blockIdx.x * NWAVES + wave; if (gw < 144) mlstm_gate_scan(a, lane, gw); } phase_conv(a, tid, G); }
    else if constexpr (K == 12) phase_mlstm_pre(a, lds, lane, wave, G);
    else if constexpr (K == 13) phase_scans_odd(a, lds, tid, rep * 2048);
    else if constexpr (K == 14) phase_combine_odd(a, lane, wave, G);
    else if constexpr (K == 15) { pg8::Gemm g{(const bf16_t*)(a.ws + WS_Y), (const bf16_t*)(a.ws + WS_WOUTO), NTOK, 1024, 1024, 2048}; pg8::SplitKOrder S{G, (int)blockIdx.x};
        pg8::EpiBf16Part E{(bf16_t*)(a.ws + WS_PART), 1024, (size_t)NTOK * 1024};
        pg8::gemm_phase<pg8::EpiBf16Part, pg8::SplitKOrder, false, true>(lds, g, S, E); }
    else if constexpr (K == 16) phase_final(a, lane, wave, G);
}
__global__ void __launch_bounds__(NT, 2) fwd_kernel(Args a) {
    extern __shared__ __attribute__((aligned(16))) unsigned char lds_raw[];
    LAS unsigned char* lds = (LAS unsigned char*)lds_raw;
    const int tid = threadIdx.x, G = gridDim.x;
    const int lo = a.ph_lo, hi = a.ph_hi;
    if (tid < 16) ((volatile LAS unsigned*)(lds + MISC_OFF))[tid] = 0u;
    __syncthreads();
    const XcdBarrier bar = xcd_barrier_post((unsigned*)(a.ws + WS_CTL) + CW_BAR, (volatile LAS unsigned*)(lds + MISC_OFF) + 8);
#define IN(k) (lo <= (k) && (k) < hi)
#define PHASE(k) do { if (IN(k)) { run_phase<k>(a, lds, tid, G, 0); if ((PROBE_MASK >> (k)) & 1u) { xcd_barrier(bar); run_phase<k>(a, lds, tid, G, 1); } } \
        if (IN(k) && IN((k) + 1)) xcd_barrier(bar); } while (0)
    PHASE(0); PHASE(1); PHASE(2); PHASE(3); PHASE(4); PHASE(5); PHASE(6); PHASE(7); PHASE(8); PHASE(9); PHASE(10); PHASE(11); PHASE(12); PHASE(13); PHASE(14); PHASE(15); PHASE(16);
#undef IN
#undef PHASE
}

extern "C" void kernel_launch(void* const* d_in, const int* in_sizes, int n_in,
                              void* d_out, int out_size, void* d_ws, size_t ws_size,
                              hipStream_t stream) {
    static int grid_blocks = 0;
    if (!grid_blocks) {
        int dev = 0, cus = 0, per_cu = 0;
        (void)hipGetDevice(&dev);
        (void)hipDeviceGetAttribute(&cus, hipDeviceAttributeMultiprocessorCount, dev);
        (void)hipFuncSetAttribute((const void*)fwd_kernel, hipFuncAttributeMaxDynamicSharedMemorySize, LDS_BYTES);
        (void)hipOccupancyMaxActiveBlocksPerMultiprocessor(&per_cu, (const void*)fwd_kernel, NT, LDS_BYTES);
        (void)hipGetLastError();
        grid_blocks = cus > 0 ? cus : 256;
        fprintf(stderr, "kernel_launch: cus=%d per_cu=%d grid=%d ws=%zu\n", cus, per_cu, grid_blocks, ws_size);
        if (n_in != 33 || ws_size < WS_END) { fprintf(stderr, "kernel_launch: unexpected n_in %d / ws %zu\n", n_in, ws_size); }
    }
    (void)hipMemsetAsync((char*)d_ws + WS_CTL, 0, CTL_ZERO_BYTES, stream);
    Args a{};
    for (int i = 0; i < 33; ++i) a.in[i] = (const float*)d_in[i];
    a.out = (float*)d_out; a.ws = (unsigned char*)d_ws; a.ph_lo = 0; a.ph_hi = N_PHASES;
    void* args[] = {&a};
    hipError_t e = hipLaunchCooperativeKernel((const void*)fwd_kernel, dim3(grid_blocks), dim3(NT), args, LDS_BYTES, stream);
    if (e != hipSuccess) fprintf(stderr, "cooperative launch failed: %s (grid %d)\n", hipGetErrorString(e), grid_blocks);
}
```

```cpp
#include <hip/hip_runtime.h>
#include <cstdio>
#include <cstdint>

#define LAS __attribute__((address_space(3)))
#define GAS __attribute__((address_space(1)))
typedef unsigned short bf16_t;
typedef short bf16x8 __attribute__((ext_vector_type(8)));
typedef float f32x4 __attribute__((ext_vector_type(4)));
typedef float f32x2 __attribute__((ext_vector_type(2)));
typedef unsigned u32x4 __attribute__((ext_vector_type(4)));
typedef unsigned u32x2 __attribute__((ext_vector_type(2)));

namespace pg8 {
#define PG8_LAS __attribute__((address_space(3)))
constexpr int BM = 256, BK = 64, HALF = 128, HTB = HALF * BK * 2, STAGE_BYTES = 8 * HTB, NXCD = 8, WGM = 8;

__host__ __device__ __forceinline__ int lds_byte(int r, int c) { const int st = (r >> 4) * 2 + (c >> 5), rr = r & 15, cc = c & 31, ob = rr * 64 + cc * 2; return st * 1024 + (ob ^ (((ob >> 9) & 1) << 5)); }
__host__ __device__ __forceinline__ void stage_rc(int b, int& R, int& C) { const int st = b / 1024, sb = b % 1024, swz = sb ^ (((sb >> 9) & 1) << 5); R = (st >> 1) * 16 + swz / 64; C = (st & 1) * 32 + (swz % 64) / 2; }
__host__ __device__ __forceinline__ int perm32(int rho) { const int n = rho >> 4, i = rho & 15; return 8 * (i >> 2) + 4 * n + (i & 3); }

struct Unit { int pm, pn, ks; };
struct Gemm { const bf16_t* A; const bf16_t* Bt; int M, N, K, ld; };

struct StaticOrder {
    int nM, nN, nwg, G, c;
    __host__ __device__ void init(int M, int N, int G_, int c_) { nM = M / BM; nN = N / BM; nwg = nM * nN; G = G_; c = c_; }
    __host__ __device__ bool next(int i, Unit& u) const {
        const long L = (long)i * G + c; if (L >= nwg) return false;
        int wgid = (int)L; { const int q = nwg / NXCD, r = nwg % NXCD, xcd = wgid % NXCD, off = wgid / NXCD; wgid = (xcd < r ? xcd * (q + 1) : r * (q + 1) + (xcd - r) * q) + off; }
        const int nig = WGM * nN, gid = wgid / nig, fm = gid * WGM, gsz = (nM - fm) < WGM ? (nM - fm) : WGM;
        u.pm = fm + ((wgid % nig) % gsz); u.pn = (wgid % nig) / gsz; u.ks = 0; return true;
    }
    __device__ __forceinline__ void a_ready(const Unit&) const {}
    __device__ __forceinline__ void done(const Unit&) const {}
};
struct LowRankOrder { StaticOrder S;
    __host__ __device__ bool next(int i, Unit& u) const { if (!S.next(i, u)) return false; u.ks = u.pn >> 3; return true; }
    __device__ __forceinline__ void a_ready(const Unit&) const {}
    __device__ __forceinline__ void done(const Unit&) const {}
};
struct SplitKOrder {
    int G, c;
    __host__ __device__ bool next(int i, Unit& u) const {
        const long L = (long)i * G + c; if (L >= 256) return false;
        u.pm = (int)(L >> 3); u.pn = (int)((L >> 1) & 3); u.ks = (int)(L & 1); return true;
    }
    __device__ __forceinline__ void a_ready(const Unit&) const {}
    __device__ __forceinline__ void done(const Unit&) const {}
};

__device__ __forceinline__ unsigned cvt_pk_bf16(float lo, float hi) { unsigned r; asm volatile("v_cvt_pk_bf16_f32 %0, %1, %2" : "=v"(r) : "v"(lo), "v"(hi)); return r; }

struct EpiBf16 {
    static constexpr bool PERM = true, AFTER_DRAIN = false;
    bf16_t* O; int ldc;
    __device__ __forceinline__ void operator()(const f32x4 (&acc)[2][2][4][2], const Unit& u, int wr, int wc, int fr, int fq) const {
        const int row0 = u.pm * BM + wr * 64 + fr; const int col0 = u.pn * BM + wc * 32 + 8 * fq;
#pragma unroll
        for (int ai = 0; ai < 2; ++ai)
#pragma unroll
            for (int m = 0; m < 4; ++m) { bf16_t* rowp = O + (size_t)(row0 + ai * HALF + m * 16) * ldc + col0;
#pragma unroll
                for (int bj = 0; bj < 2; ++bj) { const f32x4 v0 = acc[ai][bj][m][0], v1 = acc[ai][bj][m][1];
                    u32x4 w; w.x = cvt_pk_bf16(v0[0], v0[1]); w.y = cvt_pk_bf16(v0[2], v0[3]); w.z = cvt_pk_bf16(v1[0], v1[1]); w.w = cvt_pk_bf16(v1[2], v1[3]);
                    *(u32x4*)(rowp + bj * HALF) = w; } }
    }
};
struct EpiBf16Part {
    static constexpr bool PERM = true, AFTER_DRAIN = false;
    bf16_t* O; int ldc; size_t part_stride;
    __device__ __forceinline__ void operator()(const f32x4 (&acc)[2][2][4][2], const Unit& u, int wr, int wc, int fr, int fq) const {
        const int row0 = u.pm * BM + wr * 64 + fr; const int col0 = u.pn * BM + wc * 32 + 8 * fq;
        bf16_t* base = O + (size_t)u.ks * part_stride;
#pragma unroll
        for (int ai = 0; ai < 2; ++ai)
#pragma unroll
            for (int m = 0; m < 4; ++m) { bf16_t* rowp = base + (size_t)(row0 + ai * HALF + m * 16) * ldc + col0;
#pragma unroll
                for (int bj = 0; bj < 2; ++bj) { const f32x4 v0 = acc[ai][bj][m][0], v1 = acc[ai][bj][m][1];
                    u32x4 w; w.x = cvt_pk_bf16(v0[0], v0[1]); w.y = cvt_pk_bf16(v0[2], v0[3]); w.z = cvt_pk_bf16(v1[0], v1[1]); w.w = cvt_pk_bf16(v1[2], v1[3]);
                    *(u32x4*)(rowp + bj * HALF) = w; } }
    }
};
struct EpiF32Part {
    static constexpr bool PERM = false, AFTER_DRAIN = false;
    float* P; int ldc; size_t part_stride;
    __device__ __forceinline__ void operator()(const f32x4 (&acc)[2][2][4][2], const Unit& u, int wr, int wc, int fr, int fq) const {
        const int row0 = u.pm * BM + wr * 64 + fr; const int col0 = u.pn * BM + wc * 32 + 4 * fq;
        float* base = P + (size_t)u.ks * part_stride;
#pragma unroll
        for (int ai = 0; ai < 2; ++ai)
#pragma unroll
            for (int m = 0; m < 4; ++m) { float* rowp = base + (size_t)(row0 + ai * HALF + m * 16) * ldc + col0;
#pragma unroll
                for (int bj = 0; bj < 2; ++bj)
#pragma unroll
                    for (int n = 0; n < 2; ++n) *(f32x4*)(rowp + bj * HALF + n * 16) = acc[ai][bj][m][n]; }
    }
};

template <class Epi, class Sched, bool ALIGN_EPI = false, bool SP2 = false>
__device__ __forceinline__ void gemm_phase(PG8_LAS unsigned char* lds, const Gemm g, const Sched& S, const Epi& E) {
    const int tid = threadIdx.x, wid = __builtin_amdgcn_readfirstlane(tid >> 6), lane = tid & 63, wr = wid >> 2, wc = wid & 3, fr = lane & 15, fq = lane >> 4;
    const int K = g.K, nt = K / BK, LD = g.ld;
    unsigned voffA[2], voffB[2];
#pragma unroll
    for (int i = 0; i < 2; ++i) { int R, C; stage_rc(tid * 16 + i * 8192, R, C); const int Rb = Epi::PERM ? ((R & ~31) + perm32(R & 31)) : R;
        voffA[i] = (unsigned)(R * LD + C) * 2u; voffB[i] = (unsigned)(Rb * LD + C) * 2u; }
    const size_t kstep = (size_t)(BK * 2);
    const size_t hstep = (size_t)HALF * LD * 2;
    const size_t tstep = 2 * hstep;
    const size_t sstep = (size_t)K * 2;
    const unsigned ldsw = (unsigned)wid * 1024u;
    const int aoff = lds_byte(wr * 64 + fr, fq * 8), boff = lds_byte(wc * 32 + fr, fq * 8);
#define PG8_SA(b, h) (((b) * 2 + (h)) * HTB)
#define PG8_SB(b, h) ((4 + (b) * 2 + (h)) * HTB)
#define PG8_STAGE(bufoff, gbase, voff) do { _Pragma("unroll") for (int _i = 0; _i < 2; ++_i) \
        __builtin_amdgcn_global_load_lds((const unsigned*)((const char*)(gbase) + (voff)[_i]), (PG8_LAS unsigned*)(lds + (bufoff) + ldsw + _i * 8192), 16, 0, 0); } while (0)
#define PG8_LDA(dst, b, h) do { _Pragma("unroll") for (int m = 0; m < 4; ++m) _Pragma("unroll") for (int k = 0; k < 2; ++k) dst[m][k] = *(const PG8_LAS bf16x8*)(lds + PG8_SA(b, h) + aoff + m * 2048 + k * 1024); } while (0)
#define PG8_LDB(dst, b, h) do { _Pragma("unroll") for (int n = 0; n < 2; ++n) _Pragma("unroll") for (int k = 0; k < 2; ++k) dst[n][k] = *(const PG8_LAS bf16x8*)(lds + PG8_SB(b, h) + boff + n * 2048 + k * 1024); } while (0)
#define PG8_MMA(ai, bj, At, Bt) do { __builtin_amdgcn_s_setprio(1); _Pragma("unroll") for (int m = 0; m < 4; ++m) _Pragma("unroll") for (int n = 0; n < 2; ++n) _Pragma("unroll") for (int k = 0; k < 2; ++k) \
        acc[ai][bj][m][n] = __builtin_amdgcn_mfma_f32_16x16x32_bf16(Bt[n][k], At[m][k], acc[ai][bj][m][n], 0, 0, 0); __builtin_amdgcn_s_setprio(0); } while (0)
#define PG8_WAIT_V(n) asm volatile("s_waitcnt vmcnt(" #n ")" ::: "memory")
#define PG8_WAIT_L(n) asm volatile("s_waitcnt lgkmcnt(" #n ")" ::: "memory")
#define PG8_BAR __builtin_amdgcn_s_barrier()
#define PG8_SCHED __builtin_amdgcn_sched_barrier(0)
    Unit cur, nxt; int ui = 0;
    if (!S.next(0, cur)) return;
    f32x4 acc[2][2][4][2];
#pragma unroll
    for (int a = 0; a < 2; ++a)
#pragma unroll
        for (int b = 0; b < 2; ++b)
#pragma unroll
            for (int m = 0; m < 4; ++m)
#pragma unroll
                for (int n = 0; n < 2; ++n) acc[a][b][m][n] = (f32x4){0.f, 0.f, 0.f, 0.f};
    bf16x8 At[4][2], B0[2][2], B1[2][2];
    const char* cA = (const char*)g.A + (size_t)cur.pm * tstep + (size_t)cur.ks * sstep; const char* cB = (const char*)g.Bt + (size_t)cur.pn * tstep + (size_t)cur.ks * sstep;
    S.a_ready(cur);
    if constexpr (SP2) {
        PG8_STAGE(PG8_SB(0, 0), cB, voffB); PG8_STAGE(PG8_SB(0, 1), cB + hstep, voffB); PG8_STAGE(PG8_SA(0, 0), cA, voffA); PG8_STAGE(PG8_SA(0, 1), cA + hstep, voffA);
        if (wr == 1) PG8_BAR;
        PG8_WAIT_V(2); PG8_BAR;
        PG8_STAGE(PG8_SB(1, 0), cB + kstep, voffB); PG8_STAGE(PG8_SA(1, 0), cA + kstep, voffA); PG8_STAGE(PG8_SB(1, 1), cB + hstep + kstep, voffB);
        PG8_WAIT_V(6); PG8_BAR;
    } else {
        PG8_STAGE(PG8_SB(0, 0), cB, voffB); PG8_STAGE(PG8_SA(0, 0), cA, voffA); PG8_STAGE(PG8_SB(0, 1), cB + hstep, voffB); PG8_STAGE(PG8_SA(0, 1), cA + hstep, voffA);
        if (wr == 1) PG8_BAR;
        PG8_WAIT_V(4); PG8_BAR;
        PG8_STAGE(PG8_SB(1, 0), cB + kstep, voffB); PG8_STAGE(PG8_SA(1, 0), cA + kstep, voffA); PG8_STAGE(PG8_SB(1, 1), cB + hstep + kstep, voffB);
        PG8_WAIT_V(6); PG8_BAR;
    }
    for (;;) {
        const bool has_next = S.next(ui + 1, nxt);
        const char* nA = has_next ? (const char*)g.A + (size_t)nxt.pm * tstep + (size_t)nxt.ks * sstep : cA; const char* nB = has_next ? (const char*)g.Bt + (size_t)nxt.pn * tstep + (size_t)nxt.ks * sstep : cB;
        for (int t = 0; t < nt; t += 2) {
            const bool last = (t == nt - 2);
            const char* a1 = cA + (size_t)(t + 1) * kstep;
            const char* a2 = last ? nA : cA + (size_t)(t + 2) * kstep; const char* b2 = last ? nB : cB + (size_t)(t + 2) * kstep;
            const char* a3 = a2 + kstep; const char* b3 = b2 + kstep;
            if (last && has_next) S.a_ready(nxt);
            if constexpr (SP2) {
            PG8_LDB(B0, 0, 0); PG8_LDB(B1, 0, 1); PG8_SCHED; PG8_LDA(At, 0, 0); PG8_STAGE(PG8_SA(1, 1), a1 + hstep, voffA);
            PG8_WAIT_V(8); PG8_WAIT_L(0); PG8_BAR; PG8_MMA(0, 0, At, B0); PG8_MMA(0, 1, At, B1); PG8_BAR; PG8_SCHED;
            PG8_LDA(At, 0, 1); PG8_STAGE(PG8_SB(0, 0), b2, voffB); PG8_STAGE(PG8_SB(0, 1), b2 + hstep, voffB); PG8_STAGE(PG8_SA(0, 0), a2, voffA);
            PG8_WAIT_V(8); PG8_WAIT_L(0); PG8_BAR; PG8_MMA(1, 0, At, B0); PG8_MMA(1, 1, At, B1); PG8_BAR; PG8_SCHED;
            PG8_LDB(B0, 1, 0); PG8_LDB(B1, 1, 1); PG8_SCHED; PG8_LDA(At, 1, 0); PG8_STAGE(PG8_SA(0, 1), a2 + hstep, voffA);
            PG8_WAIT_V(8); PG8_WAIT_L(0); PG8_BAR; PG8_MMA(0, 0, At, B0); PG8_MMA(0, 1, At, B1); PG8_BAR; PG8_SCHED;
            PG8_LDA(At, 1, 1); PG8_STAGE(PG8_SB(1, 0), b3, voffB); PG8_STAGE(PG8_SB(1, 1), b3 + hstep, voffB); PG8_STAGE(PG8_SA(1, 0), a3, voffA);
            PG8_WAIT_V(8); PG8_WAIT_L(0); PG8_BAR; PG8_MMA(1, 0, At, B0); PG8_MMA(1, 1, At, B1); PG8_BAR; PG8_SCHED;
            } else {
            PG8_LDB(B0, 0, 0); PG8_SCHED; PG8_LDA(At, 0, 0); PG8_STAGE(PG8_SA(1, 1), a1 + hstep, voffA);
            PG8_WAIT_L(8); PG8_BAR; PG8_WAIT_L(0); PG8_MMA(0, 0, At, B0); PG8_BAR; PG8_SCHED;
            PG8_LDB(B1, 0, 1); PG8_STAGE(PG8_SB(0, 0), b2, voffB);
            PG8_BAR; PG8_WAIT_L(0); PG8_MMA(0, 1, At, B1); PG8_BAR;
            PG8_LDA(At, 0, 1); PG8_STAGE(PG8_SA(0, 0), a2, voffA);
            PG8_BAR; PG8_WAIT_L(0); PG8_MMA(1, 0, At, B0); PG8_BAR; PG8_SCHED;
            PG8_STAGE(PG8_SB(0, 1), b2 + hstep, voffB);
            PG8_WAIT_V(6); PG8_BAR; PG8_MMA(1, 1, At, B1); PG8_BAR;
            PG8_LDB(B0, 1, 0); PG8_SCHED; PG8_LDA(At, 1, 0); PG8_STAGE(PG8_SA(0, 1), a2 + hstep, voffA);
            PG8_WAIT_L(8); PG8_BAR; PG8_WAIT_L(0); PG8_MMA(0, 0, At, B0); PG8_BAR; PG8_SCHED;
            PG8_LDB(B1, 1, 1); PG8_STAGE(PG8_SB(1, 0), b3, voffB);
            PG8_BAR; PG8_WAIT_L(0); PG8_MMA(0, 1, At, B1); PG8_BAR;
            PG8_LDA(At, 1, 1); PG8_STAGE(PG8_SA(1, 0), a3, voffA);
            PG8_BAR; PG8_WAIT_L(0); PG8_MMA(1, 0, At, B0); PG8_BAR; PG8_SCHED;
            PG8_STAGE(PG8_SB(1, 1), b3 + hstep, voffB);
            PG8_WAIT_V(6); PG8_BAR; PG8_MMA(1, 1, At, B1); PG8_BAR;
            }
        }
        if constexpr (ALIGN_EPI) { if (wr == 0) PG8_BAR; }
        if constexpr (!Epi::AFTER_DRAIN) { E(acc, cur, wr, wc, fr, fq); S.done(cur); }
        if (!has_next) break;
#pragma unroll
        for (int a = 0; a < 2; ++a)
#pragma unroll
            for (int b = 0; b < 2; ++b)
#pragma unroll
                for (int m = 0; m < 4; ++m)
#pragma unroll
                    for (int n = 0; n < 2; ++n) acc[a][b][m][n] = (f32x4){0.f, 0.f, 0.f, 0.f};
        cur = nxt; cA = nA; cB = nB; ++ui;
        if constexpr (ALIGN_EPI) { if (wr == 1) PG8_BAR; }
    }
    PG8_WAIT_V(0);
    if constexpr (!ALIGN_EPI) { if (wr == 0) PG8_BAR; }
    PG8_BAR;
#undef PG8_SA
#undef PG8_SB
#undef PG8_STAGE
#undef PG8_LDA
#undef PG8_LDB
#undef PG8_MMA
#undef PG8_WAIT_V
#undef PG8_WAIT_L
#undef PG8_BAR
#undef PG8_SCHED
}
}

constexpr int NT = 512, NWAVES = 8;
constexpr int LDS_BYTES = 159744;
constexpr int MISC_OFF = 155648;
constexpr int NTOK = 8192, DM = 1024;
constexpr int IN_EVEN = 9472, IN_ODD = 10256, IN_ODD_MAIN = 10240;
constexpr float EPS = 1e-6f, GN_EPS = 64e-5f;
constexpr size_t OUT_Y = 0, OUT_HGRN = 8388608, OUT_RWKV = 12582912, OUT_C = 14680064, OUT_N = 48234496, OUT_M = 48300032;
constexpr size_t MiB = 1u << 20;
constexpr size_t WS_CTL = 0, CTL_ZERO_BYTES = 64 * 1024;
constexpr size_t WS_MOD = 1 * MiB;
constexpr size_t WS_GW = 1 * MiB + 512 * 1024;
constexpr size_t WS_GATES = 1 * MiB + 768 * 1024;
constexpr size_t WS_WINE = 4 * MiB;
constexpr size_t WS_WOUTE = 24 * MiB;
constexpr size_t WS_WINO = 28 * MiB;
constexpr size_t WS_WOUTO = 48 * MiB;
constexpr size_t WS_XN = 52 * MiB;
constexpr size_t WS_X1 = 68 * MiB;
constexpr size_t WS_PROJ = 100 * MiB;
constexpr size_t WS_OF = 260 * MiB, WS_OB = 292 * MiB;
constexpr size_t WS_QKC = 260 * MiB;
constexpr size_t WS_YF = 324 * MiB, WS_YB = 356 * MiB;
constexpr size_t WS_HF = 324 * MiB, WS_HB = 388 * MiB;
constexpr size_t WS_U4 = 260 * MiB;
constexpr size_t WS_RS = 324 * MiB, WS_KS = 340 * MiB, WS_KKS = 356 * MiB;
constexpr size_t WS_RWREC = 388 * MiB;
constexpr size_t WS_Y = 564 * MiB;
constexpr size_t WS_PART = 596 * MiB;
constexpr size_t WS_BS = 660 * MiB;
constexpr size_t WS_GT = 662 * MiB;
constexpr size_t WS_DEN = 662 * MiB + 512 * 1024;
constexpr size_t WS_V = 664 * MiB;
constexpr size_t WS_LR = 680 * MiB;
constexpr size_t WS_W2B = 684 * MiB;
constexpr size_t WS_HQA0 = 52 * MiB, WS_HKT0 = 68 * MiB, WS_HQA1 = 84 * MiB, WS_HKT1 = 616 * MiB;
constexpr size_t WS_HSC = 632 * MiB;
constexpr size_t WS_MP = 686 * MiB;
constexpr size_t WS_MLREC = 596 * MiB;
constexpr size_t WS_QKF = 420 * MiB;
constexpr size_t WS_END = 687 * MiB;
constexpr int CW_Q0 = 64, CW_Q2 = 192, CW_Q1 = 1024, CW_BAR = 4096;

struct Args { const float* in[33]; float* out; unsigned char* ws; int ph_lo, ph_hi; };

__device__ __forceinline__ float bf2f(unsigned short u) { return __uint_as_float((unsigned)u << 16); }
typedef __bf16 bf16x2_t __attribute__((ext_vector_type(2)));
__device__ __forceinline__ unsigned pk2(float lo, float hi) { const f32x2 v = {lo, hi}; const bf16x2_t b = __builtin_convertvector(v, bf16x2_t); return __builtin_bit_cast(unsigned, b); }
__device__ __forceinline__ unsigned f2bf(float f) { return (unsigned)__builtin_bit_cast(unsigned short, (__bf16)f); }
__device__ __forceinline__ float sigm(float x) { return 1.f / (1.f + __expf(-x)); }
__device__ __forceinline__ float silu(float x) { return x / (1.f + __expf(-x)); }
__device__ __forceinline__ void tok_info(int m, int& t, int& T, int& cr) {
    if (m < 4096) { t = m & 255; T = 256; cr = 0; } else { const int mm = m - 4096; t = mm & 2047; T = 2048; cr = 1 + (mm >> 11); }
}
__device__ __forceinline__ const float* x_row(const Args& a, int m) { return m < 4096 ? a.in[0] + (size_t)m * DM : a.in[1] + (size_t)(m - 4096) * DM; }
template <int CTRL> __device__ __forceinline__ float dpp_mov(float v) { return __uint_as_float((unsigned)__builtin_amdgcn_update_dpp(0, (int)__float_as_uint(v), CTRL, 0xF, 0xF, false)); }
__device__ __forceinline__ float row16_sum(float v) {
    v += dpp_mov<0xB1>(v);
    v += dpp_mov<0x4E>(v);
    v += dpp_mov<0x141>(v);
    v += dpp_mov<0x140>(v);
    return v;
}
__device__ __forceinline__ float bflo(unsigned u) { return __uint_as_float(u << 16); }
__device__ __forceinline__ float bfhi(unsigned u) { return __uint_as_float(u & 0xffff0000u); }
__device__ __forceinline__ float quad_sum(float v) { v += dpp_mov<0xB1>(v); v += dpp_mov<0x4E>(v); return v; }
__device__ __forceinline__ float oct_sum(float v) { v = quad_sum(v); v += dpp_mov<0x141>(v); return v; }
__device__ __forceinline__ float wave_sum(float v) {
    v = row16_sum(v);
    const int vi = (int)__float_as_uint(v);
    const float s0 = __uint_as_float((unsigned)__builtin_amdgcn_readlane(vi, 0)), s1 = __uint_as_float((unsigned)__builtin_amdgcn_readlane(vi, 16));
    const float s2 = __uint_as_float((unsigned)__builtin_amdgcn_readlane(vi, 32)), s3 = __uint_as_float((unsigned)__builtin_amdgcn_readlane(vi, 48));
    return (s0 + s1) + (s2 + s3);
}

__device__ __forceinline__ void p0_transpose_item(const float* W, int ldw, int K, int nblk, bf16_t* WT, LAS float* scr, int item, int lane) {
    const int kb = item / nblk, nb = item % nblk, k0 = 64 * kb, n0 = 32 * nb;
    f32x4 v[8];
#pragma unroll
    for (int i = 0; i < 8; ++i) v[i] = *(const f32x4*)(W + (size_t)(k0 + 8 * i + (lane >> 3)) * ldw + n0 + 4 * (lane & 7));
    __builtin_amdgcn_sched_barrier(0);
#pragma unroll
    for (int i = 0; i < 8; ++i) { LAS float* d = scr + (8 * i + (lane >> 3)) * 33 + 4 * (lane & 7); d[0] = v[i].x; d[1] = v[i].y; d[2] = v[i].z; d[3] = v[i].w; }
    asm volatile("s_waitcnt lgkmcnt(0)" ::: "memory");
    const int c = lane & 7;
#pragma unroll
    for (int j = 0; j < 4; ++j) { const int n = (lane >> 3) + 8 * j; const LAS float* s = scr + (8 * c) * 33 + n;
        u32x4 o; o.x = pk2(s[0 * 33], s[1 * 33]); o.y = pk2(s[2 * 33], s[3 * 33]); o.z = pk2(s[4 * 33], s[5 * 33]); o.w = pk2(s[6 * 33], s[7 * 33]);
        *(u32x4*)(WT + (size_t)(n0 + n) * K + k0 + 8 * c) = o; }
    asm volatile("s_waitcnt lgkmcnt(0)" ::: "memory");
}

__device__ __forceinline__ void phase_prologue(const Args& a, LAS unsigned char* lds, int tid, int lane, int wave, int G) {
    unsigned char* ws = a.ws;
    if ((int)blockIdx.x < 96) {
        const int item = blockIdx.x, layer = item / 48, g = item % 48, col = g * 64 + lane;
        const float* wm = a.in[9] + (size_t)layer * 1024 * 3072;
        const float* cctx = a.in[8]; const float* cc = a.in[2];
        float a0 = 0.f, a1 = 0.f, a2 = 0.f;
        const int k0 = wave * 128;
#pragma unroll 8
        for (int k = k0; k < k0 + 128; ++k) {
            const float wv = wm[(size_t)k * 3072 + col];
            a0 += silu(cctx[k]) * wv; a1 += silu(cc[k]) * wv; a2 += silu(cc[1024 + k]) * wv;
        }
        LAS float* red = (LAS float*)lds;
        red[(wave * 3 + 0) * 64 + lane] = a0; red[(wave * 3 + 1) * 64 + lane] = a1; red[(wave * 3 + 2) * 64 + lane] = a2;
        __syncthreads();
        if (tid < 192) { const int r = tid >> 6, l = tid & 63; float s = 0.f;
#pragma unroll
            for (int w = 0; w < 8; ++w) s += red[(w * 3 + r) * 64 + l];
            ((float*)(ws + WS_MOD))[(layer * 3 + r) * 3072 + g * 64 + l] = s + a.in[10][layer * 3072 + g * 64 + l]; }
        __syncthreads();
    }
    for (int idx = blockIdx.x * NT + tid; idx < 16384; idx += G * NT) { const int k = idx >> 4, j = idx & 15; ((float*)(ws + WS_GW))[j * 1024 + k] = a.in[27][(size_t)k * IN_ODD + IN_ODD_MAIN + j]; }
    for (int idx = blockIdx.x * NT + tid; idx < 4096 * 256; idx += G * NT) { const int n = idx >> 8, k = idx & 255, qn = n >> 10, c = n & 1023, qk = k >> 6, j = k & 63;
        float wv = 0.f; if (qn == qk) wv = (qn < 2 ? a.in[19] : a.in[21])[(size_t)((qn & 1) * 64 + j) * 1024 + c];
        ((bf16_t*)(ws + WS_W2B))[idx] = (bf16_t)f2bf(wv); }
    LAS float* scr = (LAS float*)(lds + wave * 16384);
    const int gw = blockIdx.x * NWAVES + wave, NGW = G * NWAVES;
    constexpr int I_E = 16 * 296, I_OE = 32 * 32, NITEMS = I_E + I_OE;
    for (int it = gw; it < NITEMS; it += NGW) {
        int r = it;
        if (r < I_E) { p0_transpose_item(a.in[13], IN_EVEN, 1024, 296, (bf16_t*)(ws + WS_WINE), scr, r, lane); continue; } r -= I_E;
        p0_transpose_item(a.in[14], 1024, 2048, 32, (bf16_t*)(ws + WS_WOUTE), scr, r, lane);
    }
}

__device__ __forceinline__ void modnorm_store(const f32x4 (&v)[4], const float* ng, const float* mod, bf16_t* orow, int lane, f32x4 (&h)[4]) {
    float s = 0.f;
#pragma unroll
    for (int j = 0; j < 4; ++j) s += (v[j].x * v[j].x + v[j].y * v[j].y) + (v[j].z * v[j].z + v[j].w * v[j].w);
    const float rstd = rsqrtf(wave_sum(s) * (1.f / 1024.f) + EPS);
#pragma unroll
    for (int j = 0; j < 4; ++j) { const int col = 4 * lane + 256 * j;
        const f32x4 g4 = *(const f32x4*)(ng + col), sh = *(const f32x4*)(mod + col), sc = *(const f32x4*)(mod + 1024 + col);
        h[j] = v[j] * rstd * g4 * (sc + 1.f) + sh;
        u32x2 o; o.x = pk2(h[j].x, h[j].y); o.y = pk2(h[j].z, h[j].w);
        *(u32x2*)(orow + col) = o; }
}

__device__ __forceinline__ void phase_modnorm0(const Args& a, int lane, int wave, int G) {
    const int gw = blockIdx.x * NWAVES + wave, NGW = G * NWAVES;
    const float* MOD = (const float*)(a.ws + WS_MOD);
    bf16_t* XN = (bf16_t*)(a.ws + WS_XN);
    for (int m = gw; m < NTOK; m += NGW) {
        int t, T, cr; tok_info(m, t, T, cr);
        const f32x4* xr = (const f32x4*)x_row(a, m) + lane;
        f32x4 v[4], h[4];
#pragma unroll
        for (int j = 0; j < 4; ++j) v[j] = xr[64 * j];
        modnorm_store(v, a.in[11], MOD + (0 * 3 + cr) * 3072, XN + (size_t)m * DM, lane, h);
    }
}

__device__ __forceinline__ float shiftv(const bf16_t* P, const float* mu, int m, int t, int T, int cc) {
    const bf16_t* p = P + (size_t)m * IN_EVEN + 5120 + cc;
    const float cur = bf2f(p[0]);
    const float prev = t > 0 ? bf2f(p[-IN_EVEN]) : 0.f;
    const float nxt = t < T - 1 ? bf2f(p[IN_EVEN]) : 0.f;
    return cur + mu[cc] * (prev - cur) + mu[3328 + cc] * (nxt - cur);
}
__device__ __forceinline__ void phase_rwkv_lr(const Args& a, int tid, int G) {
    const bf16_t* P = (const bf16_t*)(a.ws + WS_PROJ); bf16_t* LR = (bf16_t*)(a.ws + WS_LR); const float* mu = a.in[17];
    for (int idx = blockIdx.x * NT + tid; idx < NTOK * 256; idx += G * NT) { const int m = idx >> 8, jj = idx & 255;
        int t, T, cr; tok_info(m, t, T, cr);
        float val = shiftv(P, mu, m, t, T, 3072 + jj);
        if (jj < 128) val = 1.f - 2.f * __builtin_amdgcn_rcpf(1.f + __expf(2.f * val));
        LR[idx] = (bf16_t)f2bf(val); }
    bf16_t* RS = (bf16_t*)(a.ws + WS_RS); bf16_t* KS = (bf16_t*)(a.ws + WS_KS); bf16_t* KKS = (bf16_t*)(a.ws + WS_KKS); bf16_t* oV = (bf16_t*)(a.ws + WS_V);
    const int lane = tid & 63, gw = blockIdx.x * NWAVES + (tid >> 6), NGW = G * NWAVES;
    const int hc = (gw & 15) * 64 + lane;
    float m0c[3], m1c[3];
#pragma unroll
    for (int arr = 0; arr < 3; ++arr) { m0c[arr] = mu[arr * 1024 + hc]; m1c[arr] = mu[3328 + arr * 1024 + hc]; }
    const float kkw = a.in[22][hc];
    for (int item = gw; item < NTOK * 16; item += 2 * NGW) {
        unsigned raw[2][3][3]; float pm[2], nm[2]; int mm[2];
#pragma unroll
        for (int u = 0; u < 2; ++u) { const int it2 = item + u * NGW; const int m = it2 < NTOK * 16 ? (it2 >> 4) : (item >> 4); mm[u] = m;
            int t, T, cr; tok_info(m, t, T, cr);
            const int mp = t > 0 ? m - 1 : m, mn = t < T - 1 ? m + 1 : m; pm[u] = t > 0 ? 1.f : 0.f; nm[u] = t < T - 1 ? 1.f : 0.f;
#pragma unroll
            for (int arr = 0; arr < 3; ++arr) { const int col = 5120 + arr * 1024 + hc;
                raw[u][arr][0] = P[(size_t)mp * IN_EVEN + col]; raw[u][arr][1] = P[(size_t)m * IN_EVEN + col]; raw[u][arr][2] = P[(size_t)mn * IN_EVEN + col]; } }
        __builtin_amdgcn_sched_barrier(0);
#pragma unroll
        for (int u = 0; u < 2; ++u) { float x[3];
#pragma unroll
            for (int arr = 0; arr < 3; ++arr) { const float prev = bflo(raw[u][arr][0]) * pm[u], cur = bflo(raw[u][arr][1]), nxt = bflo(raw[u][arr][2]) * nm[u];
                x[arr] = cur + m0c[arr] * (prev - cur) + m1c[arr] * (nxt - cur); }
            const float kkr = x[1] * kkw; const float nrm = wave_sum(kkr * kkr);
            if (item + u * NGW < NTOK * 16) { const size_t o = (size_t)mm[u] * 1024 + hc;
                RS[o] = (bf16_t)f2bf(x[0]); KS[o] = (bf16_t)f2bf(x[1]); KKS[o] = (bf16_t)f2bf(kkr / fmaxf(sqrtf(nrm), 1e-12f)); oV[o] = (bf16_t)f2bf(x[2]); } }
    }
}

typedef short s16x4g __attribute__((ext_vector_type(4)));
template <int PITCH>
__device__ __forceinline__ bf16x8 tr_frag_p(const LAS unsigned char* img, int rowb, int col0, int r16) {
    const LAS unsigned char* p = img + (rowb + (r16 >> 2)) * PITCH + (col0 + 4 * (r16 & 3)) * 2;
    const s16x4g t0 = __builtin_amdgcn_ds_read_tr16_b64_v4i16((LAS s16x4g*)p), t1 = __builtin_amdgcn_ds_read_tr16_b64_v4i16((LAS s16x4g*)(p + 4 * PITCH));
    return (bf16x8){t0[0], t0[1], t0[2], t0[3], t1[0], t1[1], t1[2], t1[3]};
}
constexpr int RW_RECSZ = 29184, RW_WL = 18432;
__device__ __forceinline__ void rwkv_chunk_job(const Args& a, LAS unsigned char* wl, int lane, int gtb, int h) {
    const bf16_t* U4 = (const bf16_t*)(a.ws + WS_U4);
    const bf16_t* RS = (const bf16_t*)(a.ws + WS_RS); const bf16_t* KS = (const bf16_t*)(a.ws + WS_KS); const bf16_t* KKS = (const bf16_t*)(a.ws + WS_KKS); const bf16_t* Vs = (const bf16_t*)(a.ws + WS_V);
    float* oBS = (float*)(a.ws + WS_BS);
    const int m0 = gtb * 32;
    const int hc = h * 64 + lane, q = lane >> 4, r16 = lane & 15;
    LAS unsigned char* X0 = wl; LAS unsigned char* X1 = wl + 4608; LAS unsigned char* X2 = wl + 9216; LAS unsigned char* X3 = wl + 13824;
    const float ka = a.in[23][hc], rk = a.in[24][hc];
    { u32x4 vp[4];
#pragma unroll
      for (int i = 0; i < 4; ++i) { const int p = lane + 64 * i; vp[i] = *(const u32x4*)(Vs + (size_t)(m0 + (p >> 3)) * 1024 + h * 64 + (p & 7) * 8); }
#pragma unroll
      for (int i = 0; i < 4; ++i) { const int p = lane + 64 * i; *(LAS u32x4*)(X0 + (p >> 3) * 144 + (p & 7) * 16) = vp[i]; }
#pragma unroll
      for (int vt = 0; vt < 4; ++vt) { const bf16x8 ff = tr_frag_p<144>(X0, 8 * q, 16 * vt, r16), fr = tr_frag_p<144>(X0, 24 - 8 * q, 16 * vt, r16);
          *(bf16x8*)(a.ws + WS_RWREC + (size_t)((gtb * 16 + h) * 2 + 0) * RW_RECSZ + (24 + vt) * 1024 + lane * 16) = ff;
          *(bf16x8*)(a.ws + WS_RWREC + (size_t)((gtb * 16 + h) * 2 + 1) * RW_RECSZ + (24 + vt) * 1024 + lane * 16) = (bf16x8){fr[7], fr[6], fr[5], fr[4], fr[3], fr[2], fr[1], fr[0]}; } }
#pragma unroll
    for (int dir = 0; dir < 2; ++dir) {
        unsigned char* rec = a.ws + WS_RWREC + (size_t)((gtb * 16 + h) * 2 + dir) * RW_RECSZ;
        const float w0c = a.in[18][dir * 1024 + hc], a0c = a.in[20][dir * 1024 + hc];
        float cum = 0.f;
        unsigned nlw[8], nav[8], nr[8], nk[8], nkk[8];
#define RW_JLOAD(jo_) do { _Pragma("unroll") for (int ji = 0; ji < 8; ++ji) { const int j = 8 * (jo_) + ji; const int t = dir ? 31 - j : j; \
            const bf16_t* up = U4 + (size_t)(m0 + t) * 4096 + dir * 1024 + hc; const size_t o = (size_t)(m0 + t) * 1024 + hc; \
            nlw[ji] = up[0]; nav[ji] = up[2048]; nr[ji] = RS[o]; nk[ji] = KS[o]; nkk[ji] = KKS[o]; } } while (0)
        RW_JLOAD(0);
#pragma unroll 1
        for (int jo = 0; jo < 4; ++jo) {
            float lw8[8], av8[8], r8[8], k8[8], kk8[8], bs8[8];
#pragma unroll
            for (int ji = 0; ji < 8; ++ji) { lw8[ji] = __uint_as_float(nlw[ji] << 16); av8[ji] = __uint_as_float(nav[ji] << 16); r8[ji] = __uint_as_float(nr[ji] << 16); k8[ji] = __uint_as_float(nk[ji] << 16); kk8[ji] = __uint_as_float(nkk[ji] << 16); }
            if (jo < 3) RW_JLOAD(jo + 1);
            __builtin_amdgcn_sched_barrier(0);
#pragma unroll
            for (int ji = 0; ji < 8; ++ji) { const int j = 8 * jo + ji;
                const float lw = -0.60653066f * sigm(w0c + lw8[ji]), av = sigm(a0c + av8[ji]);
                const float cprev = cum; cum += lw;
                const float kka = kk8[ji] * av, kd = k8[ji] * (1.f + (av - 1.f) * ka);
                bs8[ji] = r8[ji] * kd * rk;
                const float ei = __expf(-cum);
                *(LAS unsigned short*)(X0 + j * 144 + lane * 2) = (unsigned short)f2bf(__expf(cprev) * kk8[ji]);
                *(LAS unsigned short*)(X3 + j * 144 + lane * 2) = (unsigned short)f2bf(__expf(cum) * r8[ji]);
                *(LAS unsigned short*)(X1 + j * 144 + lane * 2) = (unsigned short)f2bf(-kka * ei);
                *(LAS unsigned short*)(X2 + j * 144 + lane * 2) = (unsigned short)f2bf(kd * ei); }
#pragma unroll
            for (int ji = 0; ji < 8; ++ji) { const int j = 8 * jo + ji; const int t = dir ? 31 - j : j; const float bs = wave_sum(bs8[ji]);
                if (lane == 0) oBS[(size_t)dir * NTOK * 16 + (size_t)(m0 + t) * 16 + h] = bs; }
        }
#undef RW_JLOAD
        const float wend = __expf(cum);
        *(float*)(rec + 28672 + lane * 4) = wend;
#define RWF(X, rt, ks) (*(const LAS bf16x8*)((X) + (16 * (rt) + r16) * 144 + (32 * (ks) + 8 * q) * 2))
        f32x4 A1[3], A2T[3], B1[3], B2[3];
#pragma unroll
        for (int tl = 0; tl < 3; ++tl) { const int jt = tl > 0 ? 1 : 0, it = tl == 2 ? 1 : 0;
            f32x4 c1 = (f32x4){0.f, 0.f, 0.f, 0.f}, c2 = c1, c3 = c1, c4 = c1;
#pragma unroll
            for (int ks = 0; ks < 2; ++ks) { const bf16x8 kbj = RWF(X0, jt, ks), rbj = RWF(X3, jt, ks), aci = RWF(X1, it, ks), bci = RWF(X2, it, ks);
                c1 = __builtin_amdgcn_mfma_f32_16x16x32_bf16(kbj, aci, c1, 0, 0, 0);
                c2 = __builtin_amdgcn_mfma_f32_16x16x32_bf16(bci, kbj, c2, 0, 0, 0);
                c3 = __builtin_amdgcn_mfma_f32_16x16x32_bf16(rbj, aci, c3, 0, 0, 0);
                c4 = __builtin_amdgcn_mfma_f32_16x16x32_bf16(rbj, bci, c4, 0, 0, 0); }
#pragma unroll
            for (int rr = 0; rr < 4; ++rr) { const int jrow = 16 * jt + 4 * q + rr, icol = 16 * it + r16;
                c1[rr] = (icol < jrow) ? c1[rr] : 0.f; c3[rr] = (icol <= jrow) ? c3[rr] : 0.f; c4[rr] = (icol <= jrow) ? c4[rr] : 0.f;
                const int irow = 16 * it + 4 * q + rr, jcol = 16 * jt + r16;
                c2[rr] = (irow < jcol) ? c2[rr] : 0.f; }
            A1[tl] = c1; A2T[tl] = c2; B1[tl] = c3; B2[tl] = c4; }
#pragma unroll
        for (int jt = 0; jt < 2; ++jt)
#pragma unroll
            for (int ks = 0; ks < 2; ++ks) { *(bf16x8*)(rec + (jt * 2 + ks) * 1024 + lane * 16) = RWF(X0, jt, ks); *(bf16x8*)(rec + (4 + jt * 2 + ks) * 1024 + lane * 16) = RWF(X3, jt, ks); }
#pragma unroll
        for (int kt = 0; kt < 4; ++kt) { const float we = __shfl(wend, 16 * kt + r16);
            const u32x4 ra = __builtin_bit_cast(u32x4, tr_frag_p<144>(X1, 8 * q, 16 * kt, r16)), rb = __builtin_bit_cast(u32x4, tr_frag_p<144>(X2, 8 * q, 16 * kt, r16));
            u32x4 wa, wb;
#pragma unroll
            for (int x = 0; x < 4; ++x) { wa[x] = pk2(bflo(ra[x]) * we, bfhi(ra[x]) * we); wb[x] = pk2(bflo(rb[x]) * we, bfhi(rb[x]) * we); }
            *(u32x4*)(rec + (16 + kt) * 1024 + lane * 16) = wa;
            *(u32x4*)(rec + (20 + kt) * 1024 + lane * 16) = wb; }
#undef RWF
        LAS float* AS = (LAS float*)X0;
#pragma unroll
        for (int tl = 0; tl < 3; ++tl) { const int jt = tl > 0 ? 1 : 0, it = tl == 2 ? 1 : 0;
#pragma unroll
            for (int rr = 0; rr < 4; ++rr) AS[(16 * jt + 4 * q + rr) * 33 + 16 * it + r16] = A1[tl][rr]; }
#pragma unroll
        for (int rr = 0; rr < 4; ++rr) AS[(4 * q + rr) * 33 + 16 + r16] = 0.f;
        { const int col = lane & 31; float Tr[32];
#pragma unroll
          for (int j = 0; j < 32; ++j) { const float rowv = AS[j * 33 + col]; float acc = (col == j) ? 1.f : 0.f;
#pragma unroll
              for (int i = 0; i < j; ++i) acc += __uint_as_float((unsigned)__builtin_amdgcn_readlane((int)__float_as_uint(rowv), i)) * Tr[i];
              Tr[j] = acc;
              if (lane < 32) *(LAS unsigned short*)(X1 + j * 80 + col * 2) = (unsigned short)f2bf(acc); } }
#pragma unroll
        for (int tl = 0; tl < 3; ++tl) { const int it = tl == 2 ? 1 : 0, jt = tl > 0 ? 1 : 0;
#pragma unroll
            for (int rr = 0; rr < 4; ++rr) *(LAS unsigned short*)(X2 + (16 * it + 4 * q + rr) * 80 + (16 * jt + r16) * 2) = (unsigned short)f2bf(A2T[tl][rr]); }
#pragma unroll
        for (int rr = 0; rr < 4; ++rr) *(LAS unsigned short*)(X2 + (16 + 4 * q + rr) * 80 + r16 * 2) = (unsigned short)0;
        { bf16x8 tf[2], af[2];
#pragma unroll
          for (int x = 0; x < 2; ++x) { tf[x] = *(const LAS bf16x8*)(X1 + (16 * x + r16) * 80 + 8 * q * 2); af[x] = *(const LAS bf16x8*)(X2 + (16 * x + r16) * 80 + 8 * q * 2);
              *(bf16x8*)(rec + (8 + x) * 1024 + lane * 16) = tf[x]; }
#pragma unroll
          for (int jt = 0; jt < 2; ++jt)
#pragma unroll
              for (int it = 0; it < 2; ++it) { f32x4 c = (f32x4){0.f, 0.f, 0.f, 0.f}; c = __builtin_amdgcn_mfma_f32_16x16x32_bf16(tf[jt], af[it], c, 0, 0, 0);
#pragma unroll
                  for (int rr = 0; rr < 4; ++rr) *(LAS unsigned short*)(X3 + (16 * jt + 4 * q + rr) * 80 + (16 * it + r16) * 2) = (unsigned short)f2bf(c[rr]); } }
#pragma unroll
        for (int x = 0; x < 2; ++x) *(bf16x8*)(rec + (10 + x) * 1024 + lane * 16) = *(const LAS bf16x8*)(X3 + (16 * x + r16) * 80 + 8 * q * 2);
#pragma unroll
        for (int which = 0; which < 2; ++which) {
#pragma unroll
            for (int tl = 0; tl < 3; ++tl) { const int jt = tl > 0 ? 1 : 0, it = tl == 2 ? 1 : 0;
#pragma unroll
                for (int rr = 0; rr < 4; ++rr) *(LAS unsigned short*)(X3 + (16 * jt + 4 * q + rr) * 80 + (16 * it + r16) * 2) = (unsigned short)f2bf(which ? B2[tl][rr] : B1[tl][rr]); }
#pragma unroll
            for (int rr = 0; rr < 4; ++rr) *(LAS unsigned short*)(X3 + (4 * q + rr) * 80 + (16 + r16) * 2) = (unsigned short)0;
#pragma unroll
            for (int x = 0; x < 2; ++x) *(bf16x8*)(rec + (12 + 2 * which + x) * 1024 + lane * 16) = *(const LAS bf16x8*)(X3 + (16 * x + r16) * 80 + 8 * q * 2);
        }
    }
}
__device__ __forceinline__ void phase_rwkv_chunks(const Args& a, LAS unsigned char* lds, int lane, int wave, int G) {
    const int gw = blockIdx.x * NWAVES + wave, NGW = G * NWAVES;
    for (int job = gw; job < 256 * 16; job += NGW) rwkv_chunk_job(a, lds + wave * RW_WL, lane, job >> 4, job & 15);
}

constexpr int HP_QA = 0, HP_KT = 8704, HP_TOT = 17408;
__device__ __forceinline__ void hgrn_pre_load(const Args& a, int tid, int gtb, int h, int dir, unsigned (&pq)[8], unsigned (&pf)[8]) {
    const bf16_t* P = (const bf16_t*)(a.ws + WS_PROJ);
    const int m0 = gtb * 32, ch = tid & 127, tq = tid >> 7; const int fcol = (dir ? 3072 : 2048) + h * 128 + ch;
#pragma unroll
    for (int i = 0; i < 8; ++i) { const int ii = 8 * tq + i; const int t = dir ? 31 - ii : ii; const bf16_t* row = P + (size_t)(m0 + t) * IN_EVEN; pq[i] = row[h * 128 + ch]; pf[i] = row[fcol]; }
}
__device__ __forceinline__ void hgrn_pre_job(const Args& a, LAS unsigned char* lds, int tid, int gtb, int h, int dir, const unsigned (&pq)[8], const unsigned (&pf)[8]) {
    bf16_t* QA = (bf16_t*)(a.ws + (dir ? WS_HQA1 : WS_HQA0)); bf16_t* KT = (bf16_t*)(a.ws + (dir ? WS_HKT1 : WS_HKT0));
    float* SC = (float*)(a.ws + WS_HSC) + (size_t)(dir * 256 + gtb) * 3072;
    const int m0 = gtb * 32, ch = tid & 127, tq = tid >> 7;
    LAS unsigned char* Qi = lds + HP_QA; LAS unsigned char* Ki = lds + HP_KT; LAS float* tot = (LAS float*)(lds + HP_TOT);
    const float l0 = a.in[15][h * 128 + ch], l1 = a.in[15][1024 + h * 128 + ch];
    const float lb = 1.f / (1.f + __expf(l1 - l0));
    float bl[8], kv[8]; float run = 0.f;
#pragma unroll
    for (int i = 0; i < 8; ++i) { const float f = lb + (1.f - lb) * sigm(bflo(pf[i])); run += __logf(f); bl[i] = run; kv[i] = 1.f - f; }
    tot[tq * 128 + ch] = run;
    __syncthreads();
    { const float t0 = tot[ch], t1 = tot[128 + ch], t2 = tot[256 + ch], t3 = tot[384 + ch];
      const float off = tq == 0 ? 0.f : (tq == 1 ? t0 : (tq == 2 ? t0 + t1 : t0 + t1 + t2));
      const float bmid = t0 + t1, bend = (t0 + t1) + (t2 + t3);
#pragma unroll
      for (int i = 0; i < 8; ++i) { const float b = off + bl[i]; const int s = 8 * tq + i;
          const float ek = __expf(bmid - b), ea = __builtin_amdgcn_rcpf(ek);
          *(LAS unsigned short*)(Qi + s * 272 + ch * 2) = (unsigned short)f2bf(bflo(pq[i]) * ea);
          *(LAS unsigned short*)(Ki + s * 272 + ch * 2) = (unsigned short)f2bf(kv[i] * ek); }
      if (tq == 0) { SC[h * 128 + ch] = __expf(bmid); SC[1024 + h * 128 + ch] = __expf(bend); SC[2048 + h * 128 + ch] = __expf(bend - bmid); } }
    __syncthreads();
    { const int s = tid >> 4, dc = tid & 15; const size_t o = (size_t)(m0 + s) * 1024 + h * 128 + dc * 8;
      *(u32x4*)(QA + o) = *(const LAS u32x4*)(Qi + s * 272 + dc * 16); *(u32x4*)(KT + o) = *(const LAS u32x4*)(Ki + s * 272 + dc * 16); }
    __syncthreads();
}
__device__ __forceinline__ void hgrn_pre_bundle(const Args& a, LAS unsigned char* lds, int tid, int job0) {
    unsigned qA[8], fA[8], qB[8], fB[8];
#define HP_DEC(j) ((j) >> 4), (((j) >> 1) & 7), ((j) & 1)
    hgrn_pre_load(a, tid, HP_DEC(job0), qA, fA);
#pragma unroll 1
    for (int i = 0; i < 16; i += 2) {
        hgrn_pre_load(a, tid, HP_DEC(job0 + i + 1), qB, fB);
        hgrn_pre_job(a, lds, tid, HP_DEC(job0 + i), qA, fA);
        if (i + 2 < 16) hgrn_pre_load(a, tid, HP_DEC(job0 + i + 2), qA, fA);
        hgrn_pre_job(a, lds, tid, HP_DEC(job0 + i + 1), qB, fB);
    }
#undef HP_DEC
}

constexpr int HG_IMG = 0  , HG_ST = 52224, HG_PM = 87040;
typedef short s16x4h __attribute__((ext_vector_type(4)));
__device__ __forceinline__ bf16x8 tr_frag(const LAS unsigned char* img, int row0, int col0, int q, int r16) {
    const LAS unsigned char* p = img + (row0 + 8 * q + (r16 >> 2)) * 272 + (col0 + 4 * (r16 & 3)) * 2;
    const s16x4h t0 = __builtin_amdgcn_ds_read_tr16_b64_v4i16((LAS s16x4h*)p), t1 = __builtin_amdgcn_ds_read_tr16_b64_v4i16((LAS s16x4h*)(p + 4 * 272));
    return (bf16x8){t0[0], t0[1], t0[2], t0[3], t1[0], t1[1], t1[2], t1[3]};
}
__device__ __forceinline__ void hgrn_task(const Args& a, LAS unsigned char* lds, int tid, int seq, int is_sample, int dir, int h, int half) {
    const bf16_t* P = (const bf16_t*)(a.ws + WS_PROJ);
    const bf16_t* QA = (const bf16_t*)(a.ws + (dir ? WS_HQA1 : WS_HQA0)); const bf16_t* KT = (const bf16_t*)(a.ws + (dir ? WS_HKT1 : WS_HKT0));
    const float* SCb = (const float*)(a.ws + WS_HSC) + (size_t)dir * 256 * 3072;
    bf16_t* O = (bf16_t*)(a.ws + (dir ? WS_OB : WS_OF));
    const int T = is_sample ? 2048 : 256, base = is_sample ? 4096 + seq * 2048 : seq * 256, nch = T / 32, gtb0 = base / 32;
    const int cbeg = is_sample ? half * 32 : 0, cend = is_sample ? cbeg + 32 : nch;
    const int lane = tid & 63, w = __builtin_amdgcn_readfirstlane(tid >> 6), q = lane >> 4, r16 = lane & 15;
    LAS unsigned char* St = lds + HG_ST; LAS unsigned char* Pm = lds + HG_PM;
    f32x4 Sacc[8];
    if (is_sample) { const float* s0 = a.in[3] + ((size_t)((seq * 2 + dir) * 8 + h) * 128) * 128;
#pragma unroll
        for (int j = 0; j < 8; ++j)
#pragma unroll
            for (int r = 0; r < 4; ++r) Sacc[j][r] = s0[(size_t)(16 * w + 4 * q + r) * 128 + 16 * j + r16];
    } else {
#pragma unroll
        for (int j = 0; j < 8; ++j) Sacc[j] = (f32x4){0.f, 0.f, 0.f, 0.f};
    }
#define HG_GTB(c) (gtb0 + (dir ? nch - 1 - (c) : (c)))
#define HG_SCAL(dst, c, which) do { const float* sp = SCb + (size_t)HG_GTB(c) * 3072 + (which) * 1024 + h * 128 + 16 * w + 4 * q; const f32x4 v4 = *(const f32x4*)sp; dst[0] = v4.x; dst[1] = v4.y; dst[2] = v4.z; dst[3] = v4.w; } while (0)
#define HG_STORE_ST(scl) do { _Pragma("unroll") for (int j = 0; j < 8; ++j) { u32x2 pk; pk.x = pk2(Sacc[j][0] * scl[0], Sacc[j][1] * scl[1]); pk.y = pk2(Sacc[j][2] * scl[2], Sacc[j][3] * scl[3]); \
        *(LAS u32x2*)(St + (16 * j + r16) * 272 + (16 * w + 4 * q) * 2) = pk; } } while (0)
    const int ps = tid >> 4, pdc = tid & 15;
#define HG_LOADIMG(rq, rk, rv, c) do { const int gb = HG_GTB(c); const size_t o = (size_t)(gb * 32 + ps) * 1024 + h * 128 + pdc * 8; rq = *(const u32x4*)(QA + o); rk = *(const u32x4*)(KT + o); \
        rv = *(const u32x4*)(P + (size_t)(gb * 32 + (dir ? 31 - ps : ps)) * IN_EVEN + 1024 + h * 128 + pdc * 8); } while (0)
#define HG_WRITE(rq, rk, rv, buf) do { LAS unsigned char* ib = lds + HG_IMG + (buf) * 26112 + ps * 272 + pdc * 16; *(LAS u32x4*)ib = rq; *(LAS u32x4*)(ib + 8704) = rk; *(LAS u32x4*)(ib + 17408) = rv; } while (0)
#define HG_BUNDLE(X, c) do { if ((c) < cend) { HG_SCAL(ebe##X, c, 1); HG_SCAL(ecc##X, c, 2); if ((c) + 1 < cend) { HG_SCAL(ebm##X, (c) + 1, 0); HG_LOADIMG(rq##X, rk##X, rv##X, (c) + 1); } } } while (0)
    u32x4 rqA, rkA, rvA, rqB, rkB, rvB; float ebeA[4], eccA[4], ebmA[4], ebeB[4], eccB[4], ebmB[4];
    rqA = rkA = rvA = rqB = rkB = rvB = (u32x4){0u, 0u, 0u, 0u};
#pragma unroll
    for (int r = 0; r < 4; ++r) { ebeA[r] = eccA[r] = ebmA[r] = ebeB[r] = eccB[r] = ebmB[r] = 0.f; }
    if (cbeg > 0) {
#define HG_LOADKV(rk, rv, c) do { const int gb = HG_GTB(c); rk = *(const u32x4*)(KT + (size_t)(gb * 32 + ps) * 1024 + h * 128 + pdc * 8); \
        rv = *(const u32x4*)(P + (size_t)(gb * 32 + (dir ? 31 - ps : ps)) * IN_EVEN + 1024 + h * 128 + pdc * 8); } while (0)
#define HG_WRITEKV(rk, rv, buf) do { LAS unsigned char* ib = lds + HG_IMG + (buf) * 26112 + ps * 272 + pdc * 16; *(LAS u32x4*)(ib + 8704) = rk; *(LAS u32x4*)(ib + 17408) = rv; } while (0)
#define HG_LBUNDLE(X, c) do { if ((c) < cbeg) { HG_SCAL(ebe##X, c, 1); HG_SCAL(ecc##X, c, 2); if ((c) + 1 < cbeg) HG_LOADKV(rk##X, rv##X, (c) + 1); } } while (0)
#define HG_LIGHT(X, c) do { const LAS unsigned char* Ki = lds + HG_IMG + ((c) & 1) * 26112 + 8704; const LAS unsigned char* Vi = Ki + 8704; \
        __syncthreads(); \
        const bf16x8 kta = tr_frag(Ki, 0, 16 * w, q, r16); \
        _Pragma("unroll") for (int j = 0; j < 8; ++j) { const bf16x8 vfj = tr_frag(Vi, 0, 16 * j, q, r16); f32x4 t4 = (f32x4){0.f, 0.f, 0.f, 0.f}; t4 = __builtin_amdgcn_mfma_f32_16x16x32_bf16(kta, vfj, t4, 0, 0, 0); \
            _Pragma("unroll") for (int r = 0; r < 4; ++r) Sacc[j][r] = ebe##X[r] * Sacc[j][r] + ecc##X[r] * t4[r]; } \
        if ((c) + 1 < cbeg) HG_WRITEKV(rk##X, rv##X, ((c) + 1) & 1); \
        HG_LBUNDLE(X, (c) + 2); } while (0)
        { u32x4 k0, v0; HG_LOADKV(k0, v0, 0); HG_WRITEKV(k0, v0, 0); }
        HG_LBUNDLE(A, 0); HG_LBUNDLE(B, 1);
#pragma unroll 1
        for (int c = 0; c < cbeg; c += 2) { HG_LIGHT(A, c); HG_LIGHT(B, c + 1); }
#undef HG_LIGHT
#undef HG_LBUNDLE
#undef HG_WRITEKV
#undef HG_LOADKV
    }
    { float e0[4]; HG_SCAL(e0, cbeg, 0); u32x4 q0, k0, v0; HG_LOADIMG(q0, k0, v0, cbeg); HG_STORE_ST(e0); HG_WRITE(q0, k0, v0, 0); }
    HG_BUNDLE(A, cbeg); HG_BUNDLE(B, cbeg + 1);
#define HG_CHUNK(X, c) do { \
        const LAS unsigned char* Qi = lds + HG_IMG + ((c) & 1) * 26112; const LAS unsigned char* Ki = Qi + 8704; const LAS unsigned char* Vi = Qi + 17408; \
        __syncthreads();                                             \
        if (w < 3) { const int tt = w > 0 ? 1 : 0, ss = w == 2 ? 1 : 0; \
            f32x4 s4 = (f32x4){0.f, 0.f, 0.f, 0.f}; \
            _Pragma("unroll") for (int ks = 0; ks < 4; ++ks) { const bf16x8 af = *(const LAS bf16x8*)(Qi + (16 * tt + r16) * 272 + (32 * ks + 8 * q) * 2); const bf16x8 bf = *(const LAS bf16x8*)(Ki + (16 * ss + r16) * 272 + (32 * ks + 8 * q) * 2); \
                s4 = __builtin_amdgcn_mfma_f32_16x16x32_bf16(af, bf, s4, 0, 0, 0); } \
            _Pragma("unroll") for (int r = 0; r < 4; ++r) { const int trow = 16 * tt + 4 * q + r, scol = 16 * ss + r16; \
                *(LAS unsigned short*)(Pm + trow * 80 + scol * 2) = (unsigned short)((scol <= trow) ? f2bf(s4[r]) : 0u); } \
        } else if (w == 3) { \
            _Pragma("unroll") for (int r = 0; r < 4; ++r) *(LAS unsigned short*)(Pm + (4 * q + r) * 80 + (16 + r16) * 2) = (unsigned short)0; \
        } \
        f32x4 oacc[2]; \
        _Pragma("unroll") for (int tt = 0; tt < 2; ++tt) { oacc[tt] = (f32x4){0.f, 0.f, 0.f, 0.f}; \
            _Pragma("unroll") for (int ks = 0; ks < 4; ++ks) { const bf16x8 af = *(const LAS bf16x8*)(Qi + (16 * tt + r16) * 272 + (32 * ks + 8 * q) * 2); const bf16x8 bf = *(const LAS bf16x8*)(St + (16 * w + r16) * 272 + (32 * ks + 8 * q) * 2); \
                oacc[tt] = __builtin_amdgcn_mfma_f32_16x16x32_bf16(af, bf, oacc[tt], 0, 0, 0); } } \
        bf16x8 vf[8]; \
        _Pragma("unroll") for (int j = 0; j < 8; ++j) vf[j] = tr_frag(Vi, 0, 16 * j, q, r16); \
        const bf16x8 kta = tr_frag(Ki, 0, 16 * w, q, r16); \
        __syncthreads();                                             \
        { const bf16x8 vown = tr_frag(Vi, 0, 16 * w, q, r16);        \
          _Pragma("unroll") for (int tt = 0; tt < 2; ++tt) { const bf16x8 pf_ = *(const LAS bf16x8*)(Pm + (16 * tt + r16) * 80 + q * 16); \
              oacc[tt] = __builtin_amdgcn_mfma_f32_16x16x32_bf16(pf_, vown, oacc[tt], 0, 0, 0); \
              _Pragma("unroll") for (int r = 0; r < 4; ++r) { const int ii = (c) * 32 + 16 * tt + 4 * q + r; const int t = dir ? (T - 1 - ii) : ii; \
                  O[(size_t)(base + t) * 1024 + h * 128 + 16 * w + r16] = (bf16_t)f2bf(oacc[tt][r]); } } } \
        _Pragma("unroll") for (int j = 0; j < 8; ++j) { f32x4 t4 = (f32x4){0.f, 0.f, 0.f, 0.f}; t4 = __builtin_amdgcn_mfma_f32_16x16x32_bf16(kta, vf[j], t4, 0, 0, 0); \
            _Pragma("unroll") for (int r = 0; r < 4; ++r) Sacc[j][r] = ebe##X[r] * Sacc[j][r] + ecc##X[r] * t4[r]; } \
        if ((c) + 1 < cend) { HG_STORE_ST(ebm##X); HG_WRITE(rq##X, rk##X, rv##X, ((c) + 1) & 1); } \
        HG_BUNDLE(X, (c) + 2); \
    } while (0)
    for (int c = cbeg; c < cend; c += 2) { HG_CHUNK(A, c); HG_CHUNK(B, c + 1); }
#undef HG_CHUNK
#undef HG_BUNDLE
#undef HG_LOADIMG
#undef HG_WRITE
#undef HG_SCAL
#undef HG_GTB
#undef HG_STORE_ST
    if (!is_sample) { float* so = a.out + OUT_HGRN + ((size_t)((seq * 2 + dir) * 8 + h) * 128) * 128;
#pragma unroll
        for (int j = 0; j < 8; ++j)
#pragma unroll
            for (int r = 0; r < 4; ++r) so[(size_t)(16 * w + 4 * q + r) * 128 + 16 * j + r16] = Sacc[j][r]; }
    __syncthreads();
}

constexpr int RWS_STAGE = 32768;
template <int nrec>
__device__ __forceinline__ void rwkv_scan_block(const Args& a, LAS unsigned char* lds, int tid, int rid0, int is_sample) {
    const int lane = tid & 63, wave = __builtin_amdgcn_readfirstlane(tid >> 6);
    constexpr int nf = 3 * nrec; const int rsel = nrec == 2 ? wave >> 2 : 0, vt = wave & 3;
    const bool comp = nrec == 2 || wave < 4;
    const int lf0 = nrec == 2 ? vt * 6 : wave * 3;
    const int rid = rid0 + rsel, h = rid & 15, dir = (rid >> 4) & 1, seq = rid >> 5;
    const int T = is_sample ? 2048 : 256, base = is_sample ? 4096 + seq * 2048 : seq * 256;
    const int nblk = T / 32, gtb0 = base / 32;
    const int q = lane >> 4, r16 = lane & 15;
    LAS unsigned char* SA = lds + wave * 4096; LAS unsigned char* UA = SA + 2304;
    LAS unsigned char* stg = lds + RWS_STAGE + rsel * 24576 + lane * 16;
    bf16_t* Y = (bf16_t*)(a.ws + (dir ? WS_YB : WS_YF));
    f32x4 S[4];
    if (is_sample) { const float* sp = a.in[4] + (size_t)((seq * 2 + dir) * 16 + h) * 4096;
#pragma unroll
        for (int kt = 0; kt < 4; ++kt)
#pragma unroll
            for (int r = 0; r < 4; ++r) S[kt][r] = sp[(size_t)(16 * vt + 4 * q + r) * 64 + 16 * kt + r16];
    } else {
#pragma unroll
        for (int kt = 0; kt < 4; ++kt) S[kt] = (f32x4){0.f, 0.f, 0.f, 0.f};
    }
#define RW_REC(c) (a.ws + WS_RWREC + (size_t)(((gtb0 + (dir ? nblk - 1 - (c) : (c))) * 16 + h) * 2 + dir) * RW_RECSZ)
#define RW_FR(rec, f) (*(const bf16x8*)((rec) + (f) * 1024 + lane * 16))
#define RW_LF(buf, f) (*(const LAS bf16x8*)(stg + (buf) * 49152 + (f) * 1024))
#define RW_GLOAD(g, rec) do { _Pragma("unroll") for (int i_ = 0; i_ < 6; ++i_) if (i_ < nf) g[i_] = *(const u32x4*)((rec) + (lf0 + i_) * 1024 + lane * 16); } while (0)
#define RW_GWRITE(g, buf) do { _Pragma("unroll") for (int i_ = 0; i_ < 6; ++i_) if (i_ < nf) *(LAS u32x4*)(stg + (buf) * 49152 + (lf0 + i_) * 1024) = g[i_]; } while (0)
    u32x4 gA[6], gB[6]; bf16x8 VA; float we[4];
#pragma unroll
    for (int i = 0; i < 6; ++i) { gA[i] = (u32x4){0u, 0u, 0u, 0u}; gB[i] = gA[i]; }
    { const unsigned char* rec0 = RW_REC(0); const unsigned char* rec1 = RW_REC(1);
      RW_GLOAD(gB, rec0); RW_GLOAD(gA, rec1);
      VA = RW_FR(rec0, 24 + vt);
#pragma unroll
      for (int x = 0; x < 4; ++x) we[x] = *(const float*)(rec0 + 28672 + (16 * x + r16) * 4);
      RW_GWRITE(gB, 0); }
    __syncthreads();
#define RW_STEP(GX, GY, c) do { \
        const unsigned char* nrec1 = RW_REC((c) + 1 < nblk ? (c) + 1 : nblk - 1); const unsigned char* nrec2 = RW_REC((c) + 2 < nblk ? (c) + 2 : nblk - 1); \
        const bf16x8 VAn = RW_FR(nrec1, 24 + vt); float wen[4]; \
        _Pragma("unroll") for (int x = 0; x < 4; ++x) wen[x] = *(const float*)(nrec1 + 28672 + (16 * x + r16) * 4); \
        RW_GLOAD(GY, nrec2); \
        if (comp) { const int bf_ = (c) & 1; \
            _Pragma("unroll") for (int kt = 0; kt < 4; ++kt) _Pragma("unroll") for (int r = 0; r < 4; ++r) *(LAS unsigned short*)(SA + (4 * q + r) * 144 + (16 * kt + r16) * 2) = (unsigned short)f2bf(S[kt][r]); \
            const bf16x8 sa0 = *(const LAS bf16x8*)(SA + r16 * 144 + (8 * q) * 2), sa1 = *(const LAS bf16x8*)(SA + r16 * 144 + (32 + 8 * q) * 2); \
            f32x4 ut[2], yt[2]; \
            _Pragma("unroll") for (int jt = 0; jt < 2; ++jt) { ut[jt] = (f32x4){0.f, 0.f, 0.f, 0.f}; yt[jt] = ut[jt]; \
                ut[jt] = __builtin_amdgcn_mfma_f32_16x16x32_bf16(sa0, RW_LF(bf_, jt * 2), ut[jt], 0, 0, 0); ut[jt] = __builtin_amdgcn_mfma_f32_16x16x32_bf16(sa1, RW_LF(bf_, jt * 2 + 1), ut[jt], 0, 0, 0); \
                yt[jt] = __builtin_amdgcn_mfma_f32_16x16x32_bf16(sa0, RW_LF(bf_, 4 + jt * 2), yt[jt], 0, 0, 0); yt[jt] = __builtin_amdgcn_mfma_f32_16x16x32_bf16(sa1, RW_LF(bf_, 4 + jt * 2 + 1), yt[jt], 0, 0, 0); } \
            _Pragma("unroll") for (int jt = 0; jt < 2; ++jt) _Pragma("unroll") for (int r = 0; r < 4; ++r) *(LAS unsigned short*)(UA + (4 * q + r) * 80 + (16 * jt + r16) * 2) = (unsigned short)f2bf(ut[jt][r]); \
            const bf16x8 ua0 = *(const LAS bf16x8*)(UA + r16 * 80 + 8 * q * 2); \
            f32x4 u2[2]; \
            _Pragma("unroll") for (int jt = 0; jt < 2; ++jt) { u2[jt] = (f32x4){0.f, 0.f, 0.f, 0.f}; \
                u2[jt] = __builtin_amdgcn_mfma_f32_16x16x32_bf16(ua0, RW_LF(bf_, 8 + jt), u2[jt], 0, 0, 0); u2[jt] = __builtin_amdgcn_mfma_f32_16x16x32_bf16(VA, RW_LF(bf_, 10 + jt), u2[jt], 0, 0, 0); } \
            _Pragma("unroll") for (int jt = 0; jt < 2; ++jt) _Pragma("unroll") for (int r = 0; r < 4; ++r) *(LAS unsigned short*)(UA + (4 * q + r) * 80 + (16 * jt + r16) * 2) = (unsigned short)f2bf(u2[jt][r]); \
            const bf16x8 ua1 = *(const LAS bf16x8*)(UA + r16 * 80 + 8 * q * 2); \
            _Pragma("unroll") for (int jt = 0; jt < 2; ++jt) { yt[jt] = __builtin_amdgcn_mfma_f32_16x16x32_bf16(ua1, RW_LF(bf_, 12 + jt), yt[jt], 0, 0, 0); yt[jt] = __builtin_amdgcn_mfma_f32_16x16x32_bf16(VA, RW_LF(bf_, 14 + jt), yt[jt], 0, 0, 0); } \
            { const int tb = dir ? nblk - 1 - (c) : (c); \
              _Pragma("unroll") for (int jt = 0; jt < 2; ++jt) { const int j = 16 * jt + r16; const int tl = dir ? 31 - j : j; \
                  *(u32x2*)(Y + (size_t)(base + tb * 32 + tl) * 1024 + h * 64 + 16 * vt + 4 * q) = (u32x2){pk2(yt[jt][0], yt[jt][1]), pk2(yt[jt][2], yt[jt][3])}; } } \
            _Pragma("unroll") for (int kt = 0; kt < 4; ++kt) { S[kt] *= we[kt]; \
                S[kt] = __builtin_amdgcn_mfma_f32_16x16x32_bf16(ua1, RW_LF(bf_, 16 + kt), S[kt], 0, 0, 0); S[kt] = __builtin_amdgcn_mfma_f32_16x16x32_bf16(VA, RW_LF(bf_, 20 + kt), S[kt], 0, 0, 0); } \
        } \
        RW_GWRITE(GX, ((c) + 1) & 1); \
        __syncthreads(); \
        VA = VAn; \
        _Pragma("unroll") for (int x = 0; x < 4; ++x) we[x] = wen[x]; \
    } while (0)
    for (int c = 0; c < nblk; c += 2) { RW_STEP(gA, gB, c); RW_STEP(gB, gA, c + 1); }
#undef RW_STEP
#undef RW_GLOAD
#undef RW_GWRITE
#undef RW_LF
#undef RW_REC
#undef RW_FR
    if (!is_sample) { float* so = a.out + OUT_RWKV + (size_t)((seq * 2 + dir) * 16 + h) * 4096;
#pragma unroll
        for (int kt = 0; kt < 4; ++kt)
#pragma unroll
            for (int r = 0; r < 4; ++r) so[(size_t)(16 * vt + 4 * q + r) * 64 + 16 * kt + r16] = S[kt][r]; }
}

__device__ __forceinline__ int queue_pop(unsigned* head, volatile LAS unsigned* slot, int tid) {
    __syncthreads();
    if (tid == 0) slot[0] = __hip_atomic_fetch_add(head, 1u, __ATOMIC_RELAXED, __HIP_MEMORY_SCOPE_AGENT);
    __syncthreads();
    return (int)slot[0];
}

__device__ __forceinline__ void phase_scans_even(const Args& a, LAS unsigned char* lds, int tid, int qoff) {
    unsigned* head = (unsigned*)(a.ws + WS_CTL) + CW_Q0 + qoff;
    volatile LAS unsigned* slot = (volatile LAS unsigned*)(lds + MISC_OFF);
    const int lane = tid & 63, wave = __builtin_amdgcn_readfirstlane(tid >> 6);
    for (;;) {
        int task = queue_pop(head, slot, tid);
        if (task >= 1408) break;
        if (task >= 128 && task < 896) { LAS float* scr = (LAS float*)(lds + wave * 16384); const int r = (task - 128) * 8 + wave;
            if (r < 5120) p0_transpose_item(a.in[27], IN_ODD, 1024, 320, (bf16_t*)(a.ws + WS_WINO), scr, r, lane);
            else p0_transpose_item(a.in[28], 1024, 2048, 32, (bf16_t*)(a.ws + WS_WOUTO), scr, r - 5120, lane);
            continue; }
        const bool is_h = task < 64 || (task >= 896 && task < 1152);
        if (is_h) { const int is_sample = task < 64; const int k = is_sample ? task & 31 : task - 896; hgrn_task(a, lds, tid, k >> 4, is_sample, (k >> 3) & 1, k & 7, 1 - (task >> 5)); }
        else if (task < 128) rwkv_scan_block<1>(a, lds, tid, task - 64, 1);
        else rwkv_scan_block<2>(a, lds, tid, 2 * (task - 1152), 0);
    }
}

__device__ __forceinline__ void phase_combine_even(const Args& a, int lane, int wave, int G) {
    const int gw = blockIdx.x * NWAVES + wave, NGW = G * NWAVES;
    const bf16_t* OF = (const bf16_t*)(a.ws + WS_OF); const bf16_t* OB = (const bf16_t*)(a.ws + WS_OB);
    const bf16_t* YF = (const bf16_t*)(a.ws + WS_YF); const bf16_t* YB = (const bf16_t*)(a.ws + WS_YB);
    const bf16_t* P = (const bf16_t*)(a.ws + WS_PROJ); const bf16_t* V = (const bf16_t*)(a.ws + WS_V); const float* BS = (const float*)(a.ws + WS_BS);
    bf16_t* Yo = (bf16_t*)(a.ws + WS_Y);
    const int c0 = 16 * lane, hh = lane >> 2;
    f32x4 hg4[4], gg4[4], gb4[4];
#pragma unroll
    for (int q = 0; q < 4; ++q) { hg4[q] = *(const f32x4*)(a.in[16] + c0 + 4 * q); gg4[q] = *(const f32x4*)(a.in[25] + c0 + 4 * q); gb4[q] = *(const f32x4*)(a.in[26] + c0 + 4 * q); }
    for (int m = gw; m < NTOK; m += NGW) {
        f32x4 of[4], ob[4], yf[4], yb[4]; u32x4 za[2], zb[2], vv[2], rof[2], rob[2], ryf[2], ryb[2];
#pragma unroll
        for (int x = 0; x < 2; ++x) { rof[x] = *(const u32x4*)(OF + (size_t)m * 1024 + c0 + 8 * x); rob[x] = *(const u32x4*)(OB + (size_t)m * 1024 + c0 + 8 * x);
            ryf[x] = *(const u32x4*)(YF + (size_t)m * 1024 + c0 + 8 * x); ryb[x] = *(const u32x4*)(YB + (size_t)m * 1024 + c0 + 8 * x); }
#pragma unroll
        for (int x = 0; x < 2; ++x) { za[x] = *(const u32x4*)(P + (size_t)m * IN_EVEN + 4096 + c0 + 8 * x); zb[x] = *(const u32x4*)(P + (size_t)m * IN_EVEN + 8448 + c0 + 8 * x); vv[x] = *(const u32x4*)(V + (size_t)m * 1024 + c0 + 8 * x); }
#pragma unroll
        for (int q = 0; q < 4; ++q) { const int x = q >> 1, j = (q & 1) * 2;
            of[q] = (f32x4){bflo(rof[x][j]), bfhi(rof[x][j]), bflo(rof[x][j + 1]), bfhi(rof[x][j + 1])}; ob[q] = (f32x4){bflo(rob[x][j]), bfhi(rob[x][j]), bflo(rob[x][j + 1]), bfhi(rob[x][j + 1])};
            yf[q] = (f32x4){bflo(ryf[x][j]), bfhi(ryf[x][j]), bflo(ryf[x][j + 1]), bfhi(ryf[x][j + 1])}; yb[q] = (f32x4){bflo(ryb[x][j]), bfhi(ryb[x][j]), bflo(ryb[x][j + 1]), bfhi(ryb[x][j + 1])}; }
        const float bon = BS[(size_t)m * 16 + hh] + BS[(size_t)NTOK * 16 + (size_t)m * 16 + hh];
        float ss = 0.f;
#pragma unroll
        for (int q = 0; q < 4; ++q) { of[q] = of[q] + ob[q]; ss += (of[q].x * of[q].x + of[q].y * of[q].y) + (of[q].z * of[q].z + of[q].w * of[q].w); }
        const float rs = rsqrtf(oct_sum(ss) * (1.f / 128.f) + EPS);
        { unsigned w[8];
#pragma unroll
          for (int q = 0; q < 4; ++q) { const unsigned z01 = za[q >> 1][(q & 1) * 2], z23 = za[q >> 1][(q & 1) * 2 + 1]; const f32x4 o = of[q] * rs * hg4[q];
              w[2 * q] = pk2(o.x * silu(bflo(z01)), o.y * silu(bfhi(z01))); w[2 * q + 1] = pk2(o.z * silu(bflo(z23)), o.w * silu(bfhi(z23))); }
          u32x4* dst = (u32x4*)(Yo + (size_t)m * 2048 + c0);
          dst[0] = (u32x4){w[0], w[1], w[2], w[3]}; dst[1] = (u32x4){w[4], w[5], w[6], w[7]}; }
        float sm = 0.f;
#pragma unroll
        for (int q = 0; q < 4; ++q) { yf[q] = yf[q] + yb[q]; sm += (yf[q].x + yf[q].y) + (yf[q].z + yf[q].w); }
        const float mean = quad_sum(sm) * (1.f / 64.f); float sq = 0.f;
#pragma unroll
        for (int q = 0; q < 4; ++q) { yf[q] = yf[q] - mean; sq += (yf[q].x * yf[q].x + yf[q].y * yf[q].y) + (yf[q].z * yf[q].z + yf[q].w * yf[q].w); }
        const float rg = rsqrtf(quad_sum(sq) * (1.f / 64.f) + GN_EPS);
        { unsigned w[8];
#pragma unroll
          for (int q = 0; q < 4; ++q) { const unsigned z01 = zb[q >> 1][(q & 1) * 2], z23 = zb[q >> 1][(q & 1) * 2 + 1], v01 = vv[q >> 1][(q & 1) * 2], v23 = vv[q >> 1][(q & 1) * 2 + 1];
              const f32x4 g = yf[q] * rg * gg4[q] + gb4[q];
              w[2 * q] = pk2((g.x + bon * bflo(v01)) * silu(bflo(z01)), (g.y + bon * bfhi(v01)) * silu(bfhi(z01)));
              w[2 * q + 1] = pk2((g.z + bon * bflo(v23)) * silu(bflo(z23)), (g.w + bon * bfhi(v23)) * silu(bfhi(z23))); }
          u32x4* dst = (u32x4*)(Yo + (size_t)m * 2048 + 1024 + c0);
          dst[0] = (u32x4){w[0], w[1], w[2], w[3]}; dst[1] = (u32x4){w[4], w[5], w[6], w[7]}; }
    }
}

__device__ __forceinline__ void phase_res_modnorm1(const Args& a, int lane, int wave, int G) {
    const int gw = blockIdx.x * NWAVES + wave, NGW = G * NWAVES;
    const float* MOD = (const float*)(a.ws + WS_MOD); const bf16_t* PART = (const bf16_t*)(a.ws + WS_PART); const float* GW = (const float*)(a.ws + WS_GW);
    float* X1 = (float*)(a.ws + WS_X1); bf16_t* XN = (bf16_t*)(a.ws + WS_XN); float* GT = (float*)(a.ws + WS_GT);
    for (int m = gw; m < NTOK; m += NGW) {
        int t, T, cr; tok_info(m, t, T, cr);
        const f32x4* xr = (const f32x4*)x_row(a, m) + lane;
        const u32x2* p0 = (const u32x2*)(PART + (size_t)m * 1024) + lane; const u32x2* p1 = (const u32x2*)(PART + (size_t)NTOK * 1024 + (size_t)m * 1024) + lane;
        const f32x4* gt = (const f32x4*)(MOD + (0 * 3 + cr) * 3072 + 2048) + lane;
        f32x4 v[4], h[4];
#pragma unroll
        for (int j = 0; j < 4; ++j) { { const u32x2 a0 = p0[64 * j], a1 = p1[64 * j]; const f32x4 ps = (f32x4){bflo(a0.x) + bflo(a1.x), bfhi(a0.x) + bfhi(a1.x), bflo(a0.y) + bflo(a1.y), bfhi(a0.y) + bfhi(a1.y)}; v[j] = xr[64 * j] + gt[64 * j] * ps; } ((f32x4*)(X1 + (size_t)m * 1024))[lane + 64 * j] = v[j]; }
        modnorm_store(v, a.in[11] + 1024, MOD + (1 * 3 + cr) * 3072, XN + (size_t)m * DM, lane, h);
        float myg = 0.f;
#pragma unroll
        for (int jg = 0; jg < 16; ++jg) { float d = 0.f;
#pragma unroll
            for (int j = 0; j < 4; ++j) { const f32x4 w4 = *(const f32x4*)(GW + jg * 1024 + 4 * lane + 256 * j); d += (h[j].x * w4.x + h[j].y * w4.y) + (h[j].z * w4.z + h[j].w * w4.w); }
            d = wave_sum(d);
            if (lane == jg) myg = d; }
        if (lane < 16) GT[(size_t)m * 16 + lane] = myg + a.in[31][lane];
    }
}

__device__ __forceinline__ void conv_fma8(float (&acc)[8], const u32x4 x, const f32x4 w0, const f32x4 w1) {
    acc[0] += bflo(x.x) * w0.x; acc[1] += bfhi(x.x) * w0.y; acc[2] += bflo(x.y) * w0.z; acc[3] += bfhi(x.y) * w0.w;
    acc[4] += bflo(x.z) * w1.x; acc[5] += bfhi(x.z) * w1.y; acc[6] += bflo(x.w) * w1.z; acc[7] += bfhi(x.w) * w1.w;
}
__device__ __forceinline__ u32x4 conv_out8(const float (&acc)[8], float sc) {
    u32x4 o; o.x = pk2(silu(acc[0]) * sc, silu(acc[1]) * sc); o.y = pk2(silu(acc[2]) * sc, silu(acc[3]) * sc); o.z = pk2(silu(acc[4]) * sc, silu(acc[5]) * sc); o.w = pk2(silu(acc[6]) * sc, silu(acc[7]) * sc); return o;
}
__device__ __forceinline__ void phase_conv(const Args& a, int tid, int G) {
    const bf16_t* P = (const bf16_t*)(a.ws + WS_PROJ); bf16_t* QKC = (bf16_t*)(a.ws + WS_QKC);
    const float* cw = a.in[29]; const float* cb = a.in[30];
    const int c0 = tid * 8;
    const float sc = c0 >= 2048 ? 0.044194173824159216f : 1.f;
    const f32x4 b0 = *(const f32x4*)(cb + c0), b1 = *(const f32x4*)(cb + c0 + 4);
    const u32x4 zero4 = (u32x4){0u, 0u, 0u, 0u};
    for (int gtb = blockIdx.x; gtb < 256; gtb += G) {
        const int m0 = gtb * 32;
        if (m0 < 4096) {
            f32x4 w0[3], w1[3];
#pragma unroll
            for (int j = 0; j < 3; ++j) { w0[j] = *(const f32x4*)(cw + (size_t)(3 + j) * 4096 + c0); w1[j] = *(const f32x4*)(cw + (size_t)(3 + j) * 4096 + c0 + 4); }
            const int t0 = m0 & 255;
#pragma unroll 1
            for (int s8 = 0; s8 < 4; ++s8) { u32x4 x[10];
#pragma unroll
                for (int i = 0; i < 10; ++i) { const int t = t0 + 8 * s8 + i - 1; x[i] = (t >= 0 && t < 256) ? *(const u32x4*)(P + (size_t)(m0 + 8 * s8 + i - 1) * IN_ODD_MAIN + c0) : zero4; }
                __builtin_amdgcn_sched_barrier(0);
#pragma unroll
                for (int i = 0; i < 8; ++i) { float acc[8] = {b0.x, b0.y, b0.z, b0.w, b1.x, b1.y, b1.z, b1.w};
#pragma unroll
                    for (int j = 0; j < 3; ++j) conv_fma8(acc, x[i + j], w0[j], w1[j]);
                    *(u32x4*)(QKC + (size_t)(m0 + 8 * s8 + i) * 4096 + c0) = conv_out8(acc, sc); } }
        } else {
            f32x4 w0[9], w1[9];
#pragma unroll
            for (int j = 0; j < 9; ++j) { w0[j] = *(const f32x4*)(cw + (size_t)j * 4096 + c0); w1[j] = *(const f32x4*)(cw + (size_t)j * 4096 + c0 + 4); }
            const int tl = (m0 - 4096) & 2047, r = tl >> 6, cw0 = tl & 63;
#pragma unroll 1
            for (int s4 = 0; s4 < 8; ++s4) { u32x4 x[3][6];
#pragma unroll
                for (int i3 = 0; i3 < 3; ++i3)
#pragma unroll
                    for (int i = 0; i < 6; ++i) { const int rr = r + i3 - 1, cc = cw0 + 4 * s4 + i - 1;
                        x[i3][i] = (rr >= 0 && rr < 32 && cc >= 0 && cc < 64) ? *(const u32x4*)(P + (size_t)(m0 + (i3 - 1) * 64 + 4 * s4 + i - 1) * IN_ODD_MAIN + c0) : zero4; }
                __builtin_amdgcn_sched_barrier(0);
#pragma unroll
                for (int i = 0; i < 4; ++i) { float acc[8] = {b0.x, b0.y, b0.z, b0.w, b1.x, b1.y, b1.z, b1.w};
#pragma unroll
                    for (int i3 = 0; i3 < 3; ++i3)
#pragma unroll
                        for (int j = 0; j < 3; ++j) conv_fma8(acc, x[i3][i + j], w0[i3 * 3 + j], w1[i3 * 3 + j]);
                    *(u32x4*)(QKC + (size_t)(m0 + 4 * s4 + i) * 4096 + c0) = conv_out8(acc, sc); } }
        }
    }
}

constexpr int ML_RECSZ = 2560;
__device__ __forceinline__ float logsig(float x) { return fminf(x, 0.f) - log1pf(__expf(-fabsf(x))); }
__device__ __forceinline__ void mlstm_gate_scan(const Args& a, int lane, int rid) {
    const float* GT = (const float*)(a.ws + WS_GT); float* MP = (float*)(a.ws + WS_MP);
    const int is_sample = rid < 16, k = is_sample ? rid : rid - 16, h = k & 3, dir = (k >> 2) & 1, seq = k >> 3;
    const int T = is_sample ? 2048 : 256, base = is_sample ? 4096 + seq * 2048 : seq * 256, nch = T / 32;
    float B = 0.f, Gm = -3.0e38f;
    if (lane < nch) { float gi[32], gf[32];
#pragma unroll
        for (int i = 0; i < 32; ++i) { const int ii = lane * 32 + i; const int t = dir ? (T - 1 - ii) : ii; gi[i] = GT[(size_t)(base + t) * 16 + dir * 4 + h]; gf[i] = GT[(size_t)(base + t) * 16 + (2 + dir) * 4 + h]; }
#pragma unroll
        for (int i = 0; i < 32; ++i) { B += logsig(gf[i]); Gm = fmaxf(Gm, gi[i] - B); } }
    float m = is_sample ? a.in[7][(seq * 2 + dir) * 4 + h] : 0.f;
    for (int c = 0; c < nch; ++c) { const float Bc = __shfl(B, c), Gc = __shfl(Gm, c);
        if (lane == 0) MP[rid * 64 + c] = m;
        m = Bc + fmaxf(m, Gc); }
    if (!is_sample && lane == 0) a.out[OUT_M + (seq * 2 + dir) * 4 + h] = m;
}
__device__ __forceinline__ void mlstm_sp_job(const Args& a, LAS unsigned char* wl, int lane, int gtb, int h) {
    const bf16_t* QKC = (const bf16_t*)(a.ws + WS_QKC); const float* GT = (const float*)(a.ws + WS_GT); const float* MP = (const float*)(a.ws + WS_MP);
    const int m0 = gtb * 32, is_sample = m0 >= 4096;
    const int seq = is_sample ? (m0 - 4096) >> 11 : m0 >> 8, T = is_sample ? 2048 : 256, base = is_sample ? 4096 + seq * 2048 : seq * 256;
    const int tb = (m0 - base) >> 5, nblk = T / 32, q = lane >> 4, r16 = lane & 15;
    LAS unsigned char* PL = wl; LAS float* sc = (LAS float*)(wl + 2560);
    f32x4 S[2][2];
#pragma unroll
    for (int x = 0; x < 2; ++x)
#pragma unroll
        for (int y = 0; y < 2; ++y) S[x][y] = (f32x4){0.f, 0.f, 0.f, 0.f};
#pragma unroll 1
    for (int kg = 0; kg < 4; ++kg) { bf16x8 qf[2][4], kf[2][4];
#pragma unroll
        for (int x = 0; x < 2; ++x)
#pragma unroll
            for (int k4 = 0; k4 < 4; ++k4) { const bf16_t* row = QKC + (size_t)(m0 + 16 * x + r16) * 4096 + h * 512 + 32 * (4 * kg + k4) + 8 * q;
                qf[x][k4] = *(const bf16x8*)row; kf[x][k4] = *(const bf16x8*)(row + 2048); }
        __builtin_amdgcn_sched_barrier(0);
#pragma unroll
        for (int k4 = 0; k4 < 4; ++k4)
#pragma unroll
            for (int x = 0; x < 2; ++x)
#pragma unroll
                for (int y = 0; y < 2; ++y) S[x][y] = __builtin_amdgcn_mfma_f32_16x16x32_bf16(qf[x][k4], kf[y][k4], S[x][y], 0, 0, 0); }
    { unsigned char* fb = a.ws + WS_QKF + (size_t)((gtb * 4 + h) * 64) * 1024 + lane * 16;
#pragma unroll 1
      for (int w8 = 0; w8 < 8; ++w8) { u32x2 lo[4], hi[4]; unsigned kx[4][8];
#pragma unroll
          for (int xs = 0; xs < 4; ++xs) { const bf16_t* p = QKC + (size_t)(m0 + 16 * (xs >> 1) + r16) * 4096 + h * 512 + 64 * w8 + 32 * (xs & 1) + 4 * q; lo[xs] = *(const u32x2*)p; hi[xs] = *(const u32x2*)(p + 16); }
#pragma unroll
          for (int dt = 0; dt < 4; ++dt)
#pragma unroll
              for (int e = 0; e < 8; ++e) kx[dt][e] = *(const unsigned short*)(QKC + (size_t)(m0 + 8 * q + e) * 4096 + 2048 + h * 512 + 64 * w8 + 16 * dt + r16);
          __builtin_amdgcn_sched_barrier(0);
#pragma unroll
          for (int xs = 0; xs < 4; ++xs) *(u32x4*)(fb + (w8 * 4 + xs) * 1024) = (u32x4){lo[xs].x, lo[xs].y, hi[xs].x, hi[xs].y};
#pragma unroll
          for (int dt = 0; dt < 4; ++dt) *(u32x4*)(fb + (32 + w8 * 4 + dt) * 1024) = (u32x4){kx[dt][0] | (kx[dt][1] << 16), kx[dt][2] | (kx[dt][3] << 16), kx[dt][4] | (kx[dt][5] << 16), kx[dt][6] | (kx[dt][7] << 16)}; } }
#pragma unroll
    for (int dir = 0; dir < 2; ++dir) {
        const int rid = is_sample ? (seq * 2 + dir) * 4 + h : 16 + (seq * 2 + dir) * 4 + h, c = dir ? nblk - 1 - tb : tb;
        const float m_prev = MP[rid * 64 + c];
        unsigned char* rec = a.ws + WS_MLREC + (size_t)(rid * 64 + c) * ML_RECSZ;
        { const int i = lane & 31, t = dir ? 31 - i : i;
          const float li = GT[(size_t)(m0 + t) * 16 + dir * 4 + h], lf = logsig(GT[(size_t)(m0 + t) * 16 + (2 + dir) * 4 + h]);
          float b = lf;
#pragma unroll
          for (int o = 1; o < 32; o <<= 1) { const float x = __shfl_up(b, o, 32); if (i >= o) b += x; }
          const float g = li - b; float G = g;
#pragma unroll
          for (int o = 1; o < 32; o <<= 1) { const float x = __shfl_up(G, o, 32); if (i >= o) G = fmaxf(G, x); }
          const float M = fmaxf(m_prev, G), Mend = __shfl(M, 31);
          if (lane < 32) { sc[i] = g; sc[32 + i] = M;
              *(float*)(rec + 2048 + i * 4) = __expf(m_prev - M); *(float*)(rec + 2176 + i * 4) = __expf(g - Mend); *(float*)(rec + 2304 + i * 4) = __expf(-(b + M));
              if (lane == 0) *(float*)(rec + 2432) = __expf(m_prev - Mend); } }
#pragma unroll
        for (int x = 0; x < 2; ++x)
#pragma unroll
            for (int y = 0; y < 2; ++y)
#pragma unroll
                for (int r = 0; r < 4; ++r) { const int t = 16 * x + 4 * q + r, s = 16 * y + r16; const int i = dir ? 31 - t : t, j = dir ? 31 - s : s;
                    const float v = (j <= i) ? S[x][y][r] * __expf(sc[j] - sc[32 + i]) : 0.f;
                    *(LAS unsigned short*)(PL + i * 80 + j * 2) = (unsigned short)f2bf(v); }
#pragma unroll
        for (int x = 0; x < 2; ++x) *(bf16x8*)(rec + x * 1024 + lane * 16) = *(const LAS bf16x8*)(PL + (16 * x + r16) * 80 + 8 * q * 2);
    }
}
__device__ __forceinline__ void phase_mlstm_pre(const Args& a, LAS unsigned char* lds, int lane, int wave, int G) {
    const int gw = blockIdx.x * NWAVES + wave, NGW = G * NWAVES;
    for (int job = gw; job < 256 * 4; job += NGW) mlstm_sp_job(a, lds + wave * 3072, lane, job >> 2, job & 3);
}

constexpr int ML_PITCH = 1040;
#ifndef ML_TR
#define ML_TR 1
#endif
typedef short s16x4 __attribute__((ext_vector_type(4)));
constexpr int M2_QS = 0, M2_KS = 33280, M2_PS = 66560, M2_VT = 132096;
template <bool DEN>
__device__ __forceinline__ void mlstm_scan_task(const Args& a, LAS unsigned char* lds, int tid, int seq, int is_sample, int dir, int h, int sl) {
    constexpr int ne = DEN ? 1 : 4;
    const bf16_t* QKC = (const bf16_t*)(a.ws + WS_QKC); const bf16_t* P = (const bf16_t*)(a.ws + WS_PROJ);
    bf16_t* H = (bf16_t*)(a.ws + (dir ? WS_HB : WS_HF)); float* DN = (float*)(a.ws + WS_DEN) + (size_t)dir * NTOK * 4;
    const int T = is_sample ? 2048 : 256, base = is_sample ? 4096 + seq * 2048 : seq * 256, nch = T / 32;
    const int rid = is_sample ? (seq * 2 + dir) * 4 + h : 16 + (seq * 2 + dir) * 4 + h;
    const unsigned char* rec0 = a.ws + WS_MLREC + (size_t)rid * 64 * ML_RECSZ;
    asm volatile("" : "+v"(tid));
    const int lane = tid & 63, w = __builtin_amdgcn_readfirstlane(tid >> 6), tt = w & 1, et = w >> 1, q = lane >> 4, r16 = lane & 15;
    LAS unsigned char* Qs = lds + M2_QS; LAS unsigned char* Ks = lds + M2_KS; LAS unsigned char* PS = lds + M2_PS; LAS unsigned char* VT = lds + M2_VT;
    const size_t sb = (size_t)((seq * 2 + dir) * 4 + h);
    f32x4 Cacc[4][4];
    if (is_sample && !DEN) { const float* src = a.in[5] + (sb * 512) * 512 + sl * 64;
        for (int i = tid; i < 512 * 16; i += NT) { const int d = i >> 4, c4 = i & 15; *(LAS f32x4*)(lds + d * 272 + c4 * 16) = *(const f32x4*)(src + (size_t)d * 512 + 4 * c4); }
        __syncthreads(); }
#pragma unroll
    for (int dt = 0; dt < 4; ++dt)
#pragma unroll
        for (int e = 0; e < 4; ++e)
#pragma unroll
            for (int r = 0; r < 4; ++r) { float v = 0.f;
                if (is_sample) { if (DEN) { if (e == 0) v = (r16 == 0) ? a.in[6][sb * 512 + 64 * w + 16 * dt + 4 * q + r] : 0.f; }
                                 else v = *(const LAS float*)(lds + (64 * w + 16 * dt + 4 * q + r) * 272 + (16 * e + r16) * 4); }
                Cacc[dt][e][r] = v; }
    __syncthreads();
    if (DEN) { for (int i = tid; i < 5120; i += NT) ((LAS unsigned*)VT)[i] = 0u;
        __syncthreads();
        if (tid < 80) *(LAS unsigned short*)(VT + (tid >= 40 ? 10240 : 0) + (tid % 40) * 2) = (unsigned short)0x3F80; }
    u32x4 Qf[4], Kf[4]; u32x4 pv = (u32x4){0u, 0u, 0u, 0u}; float pws = 0.f;
    const unsigned char* fbase = a.ws + WS_QKF + (size_t)h * 65536;
    const int gtb0 = base >> 5;
    const int qlane = dir ? (q * 16 + 15 - r16) : lane, klane = dir ? ((3 - q) * 16 + r16) : lane;
#define M2_FB(c) (fbase + (size_t)(gtb0 + (dir ? nch - 1 - (c) : (c))) * 262144)
#define M2_LOADQ(c) do { const unsigned char* fb_ = M2_FB(c) + (w * 4) * 1024 + qlane * 16; \
        _Pragma("unroll") for (int xs = 0; xs < 4; ++xs) Qf[xs] = *(const u32x4*)(fb_ + (dir ? (xs ^ 2) : xs) * 1024); } while (0)
#define M2_LOADK(c) do { const unsigned char* fb_ = M2_FB(c) + (32 + w * 4) * 1024 + klane * 16; \
        _Pragma("unroll") for (int dt = 0; dt < 4; ++dt) Kf[dt] = *(const u32x4*)(fb_ + dt * 1024); } while (0)
#define M2_LOADV(c) do { const unsigned char* rc_ = rec0 + (size_t)(c) * ML_RECSZ; \
        if (!DEN && tid < 256) { const int j = tid & 31, c16 = tid >> 5; const int ii = (c) * 32 + j; const int t = dir ? (T - 1 - ii) : ii; \
            pv = *(const u32x4*)(P + (size_t)(base + t) * IN_ODD_MAIN + 4096 + h * 512 + sl * 64 + c16 * 8); pws = *(const float*)(rc_ + 2176 + j * 4); } \
        if (DEN && tid < 32) pws = *(const float*)(rc_ + 2176 + tid * 4); } while (0)
#define M2_STOREV(buf) do { LAS unsigned char* vb = VT + (buf) * 10240; \
        if (!DEN && tid < 256) { const int j = tid & 31, c16 = tid >> 5; const unsigned vv[4] = {pv.x, pv.y, pv.z, pv.w}; \
            _Pragma("unroll") for (int i = 0; i < 4; ++i) { const int e0 = c16 * 8 + 2 * i; \
                *(LAS unsigned short*)(vb + e0 * 80 + j * 2) = (unsigned short)(vv[i] & 0xffffu); *(LAS unsigned short*)(vb + (e0 + 1) * 80 + j * 2) = (unsigned short)(vv[i] >> 16); \
                *(LAS unsigned short*)(vb + 5120 + e0 * 80 + j * 2) = (unsigned short)f2bf(bflo(vv[i]) * pws); *(LAS unsigned short*)(vb + 5120 + (e0 + 1) * 80 + j * 2) = (unsigned short)f2bf(bfhi(vv[i]) * pws); } } \
        if (DEN && tid < 32) *(LAS unsigned short*)(vb + 5120 + tid * 2) = (unsigned short)f2bf(pws); } while (0)
    LAS float* wold_s = (LAS float*)(lds + 152576);
    if (tid < nch) wold_s[tid] = *(const float*)(rec0 + (size_t)tid * ML_RECSZ + 2432);
    M2_LOADV(0);
    M2_LOADQ(0); M2_LOADK(0);
    M2_STOREV(0);
    M2_LOADV(1);
    __syncthreads();
    for (int c = 0; c < nch; ++c) {
        const unsigned char* rc = rec0 + (size_t)c * ML_RECSZ;
        const int buf = c & 1, cn = c + 1 < nch ? c + 1 : c;
        LAS unsigned char* PSc = PS + buf * 32768;
        bf16x8 pfrag = (bf16x8){0, 0, 0, 0, 0, 0, 0, 0}; float wp[4] = {0.f, 0.f, 0.f, 0.f}, cl[4] = {0.f, 0.f, 0.f, 0.f};
        if (!DEN || et < ne) { pfrag = *(const bf16x8*)(rc + tt * 1024 + lane * 16);
#pragma unroll
            for (int r = 0; r < 4; ++r) { wp[r] = *(const float*)(rc + 2048 + (16 * tt + 4 * q + r) * 4); if constexpr (DEN) cl[r] = *(const float*)(rc + 2304 + (16 * tt + 4 * q + r) * 4); } }
        const float w_old = wold_s[c];
#pragma unroll
        for (int x = 0; x < 2; ++x) { f32x4 part[4];
#pragma unroll
          for (int e = 0; e < 4; ++e) part[e] = (f32x4){0.f, 0.f, 0.f, 0.f};
#pragma unroll
          for (int s = 0; s < 2; ++s) {
              const u32x4 af = Qf[x * 2 + s];
#pragma unroll
              for (int e = 0; e < 4; ++e) if (e < ne) { u32x4 bfr; bfr.x = pk2(Cacc[2 * s][e][0], Cacc[2 * s][e][1]); bfr.y = pk2(Cacc[2 * s][e][2], Cacc[2 * s][e][3]);
                  bfr.z = pk2(Cacc[2 * s + 1][e][0], Cacc[2 * s + 1][e][1]); bfr.w = pk2(Cacc[2 * s + 1][e][2], Cacc[2 * s + 1][e][3]);
                  part[e] = __builtin_amdgcn_mfma_f32_16x16x32_bf16(__builtin_bit_cast(bf16x8, af), __builtin_bit_cast(bf16x8, bfr), part[e], 0, 0, 0); } }
#pragma unroll
          for (int e = 0; e < 4; ++e) if (e < ne) *(LAS u32x2*)(PSc + ((w * 2 + x) * 4 + e) * 512 + lane * 8) = (u32x2){pk2(part[e][0], part[e][1]), pk2(part[e][2], part[e][3])};
          __builtin_amdgcn_sched_barrier(0); }
        M2_LOADQ(cn);
#pragma unroll
        for (int dt = 0; dt < 4; ++dt)
#pragma unroll
            for (int e = 0; e < 4; ++e) Cacc[dt][e] *= w_old;
        bf16x8 vf = (bf16x8){0, 0, 0, 0, 0, 0, 0, 0};
        if (!DEN || et < ne) vf = *(const LAS bf16x8*)(VT + buf * 10240 + (16 * et + r16) * 80 + q * 16);
        { bf16x8 bfr[4];
#pragma unroll
          for (int e = 0; e < 4; ++e) if (e < ne) bfr[e] = *(const LAS bf16x8*)(VT + buf * 10240 + 5120 + (16 * e + r16) * 80 + q * 16);
#pragma unroll
          for (int dt = 0; dt < 4; ++dt) {
              u32x4 af = Kf[dt];
              if (dir) af = (u32x4){__builtin_amdgcn_alignbit(af.w, af.w, 16), __builtin_amdgcn_alignbit(af.z, af.z, 16), __builtin_amdgcn_alignbit(af.y, af.y, 16), __builtin_amdgcn_alignbit(af.x, af.x, 16)};
#pragma unroll
              for (int e = 0; e < 4; ++e) if (e < ne) Cacc[dt][e] = __builtin_amdgcn_mfma_f32_16x16x32_bf16(__builtin_bit_cast(bf16x8, af), bfr[e], Cacc[dt][e], 0, 0, 0);
              __builtin_amdgcn_sched_barrier(0); } }
        M2_LOADK(cn);
        if (c + 1 < nch) M2_STOREV(buf ^ 1);
        __syncthreads();
        if (!DEN || et < ne) { f32x4 n4 = (f32x4){0.f, 0.f, 0.f, 0.f};
#pragma unroll
            for (int ww = 0; ww < 8; ++ww) { const u32x2 pp = *(const LAS u32x2*)(PSc + ((ww * 2 + tt) * 4 + et) * 512 + lane * 8); n4 += (f32x4){bflo(pp.x), bfhi(pp.x), bflo(pp.y), bfhi(pp.y)}; }
#pragma unroll
            for (int r = 0; r < 4; ++r) n4[r] *= wp[r];
            n4 = __builtin_amdgcn_mfma_f32_16x16x32_bf16(pfrag, vf, n4, 0, 0, 0);
#pragma unroll
            for (int r = 0; r < 4; ++r) { const int ii = c * 32 + 16 * tt + 4 * q + r; const int t = dir ? (T - 1 - ii) : ii;
                if (DEN) { if (r16 == 0) DN[(size_t)(base + t) * 4 + h] = fmaxf(fabsf(n4[r]), cl[r]); }
                else H[(size_t)(base + t) * 2048 + h * 512 + sl * 64 + 16 * et + r16] = (bf16_t)f2bf(n4[r]); } }
        if (c + 2 < nch) M2_LOADV(c + 2);
    }
    __syncthreads();
#undef M2_FB
#undef M2_LOADQ
#undef M2_LOADK
#undef M2_LOADV
#undef M2_STOREV
    if (!is_sample) {
        if (DEN) {
#pragma unroll
            for (int dt = 0; dt < 4; ++dt)
#pragma unroll
                for (int r = 0; r < 4; ++r) if (r16 == 0) a.out[OUT_N + sb * 512 + 64 * w + 16 * dt + 4 * q + r] = Cacc[dt][0][r];
        } else {
#pragma unroll
            for (int dt = 0; dt < 4; ++dt)
#pragma unroll
                for (int e = 0; e < 4; ++e)
#pragma unroll
                    for (int r = 0; r < 4; ++r) *(LAS float*)(lds + (64 * w + 16 * dt + 4 * q + r) * 272 + (16 * e + r16) * 4) = Cacc[dt][e][r];
            __syncthreads();
            float* dst = a.out + OUT_C + (sb * 512) * 512 + sl * 64;
            for (int i = tid; i < 512 * 16; i += NT) { const int d = i >> 4, c4 = i & 15; *(f32x4*)(dst + (size_t)d * 512 + 4 * c4) = *(const LAS f32x4*)(lds + d * 272 + c4 * 16); }
        }
    }
    __syncthreads();
}

__device__ __forceinline__ void phase_scans_odd(const Args& a, LAS unsigned char* lds, int tid, int qoff) {
    const int xg = blockIdx.x & 7;
    unsigned* head = (unsigned*)(a.ws + WS_CTL) + CW_Q1 + qoff + 64 * xg;
    volatile LAS unsigned* slot = (volatile LAS unsigned*)(lds + MISC_OFF);
    for (;;) {
        const int task = queue_pop(head, slot, tid);
        if (task >= 162) break;
        const int rl = task / 9, k9 = task - rl * 9;
        const int is_sample = rl < 2; const int rec = is_sample ? xg * 2 + rl : xg * 16 + (rl - 2);
        const int h = rec & 3, dir = (rec >> 2) & 1, seq = rec >> 3;
        if (k9 == 8) mlstm_scan_task<true>(a, lds, tid, seq, is_sample, dir, h, 0); else mlstm_scan_task<false>(a, lds, tid, seq, is_sample, dir, h, k9);
    }
}

__device__ __forceinline__ void phase_combine_odd(const Args& a, int lane, int wave, int G) {
    const int gw = blockIdx.x * NWAVES + wave, NGW = G * NWAVES;
    const bf16_t* HF = (const bf16_t*)(a.ws + WS_HF); const bf16_t* HB = (const bf16_t*)(a.ws + WS_HB);
    const bf16_t* P = (const bf16_t*)(a.ws + WS_PROJ); bf16_t* Yo = (bf16_t*)(a.ws + WS_Y); const float* DNp = (const float*)(a.ws + WS_DEN);
    const float* ng = a.in[32];
    const int c0 = 32 * lane;
    for (int m = gw; m < NTOK; m += NGW) {
        f32x4 hf[8], hb[8]; u32x4 ov[4], zv[4], rhf[4], rhb[4];
#pragma unroll
        for (int x = 0; x < 4; ++x) { rhf[x] = *(const u32x4*)(HF + (size_t)m * 2048 + c0 + 8 * x); rhb[x] = *(const u32x4*)(HB + (size_t)m * 2048 + c0 + 8 * x); }
#pragma unroll
        for (int x = 0; x < 4; ++x) { ov[x] = *(const u32x4*)(P + (size_t)m * IN_ODD_MAIN + 6144 + c0 + 8 * x); zv[x] = *(const u32x4*)(P + (size_t)m * IN_ODD_MAIN + 8192 + c0 + 8 * x); }
#pragma unroll
        for (int q = 0; q < 8; ++q) { const int x = q >> 1, j = (q & 1) * 2;
            hf[q] = (f32x4){bflo(rhf[x][j]), bfhi(rhf[x][j]), bflo(rhf[x][j + 1]), bfhi(rhf[x][j + 1])}; hb[q] = (f32x4){bflo(rhb[x][j]), bfhi(rhb[x][j]), bflo(rhb[x][j + 1]), bfhi(rhb[x][j + 1])}; }
        const float idf = 1.f / DNp[(size_t)m * 4 + (lane >> 4)], idb = 1.f / DNp[(size_t)NTOK * 4 + (size_t)m * 4 + (lane >> 4)];
        float ss = 0.f;
#pragma unroll
        for (int q = 0; q < 8; ++q) { const unsigned o01 = ov[q >> 1][(q & 1) * 2], o23 = ov[q >> 1][(q & 1) * 2 + 1];
            f32x4 y = hf[q] * idf + hb[q] * idb;
            y.x *= sigm(bflo(o01)); y.y *= sigm(bfhi(o01)); y.z *= sigm(bflo(o23)); y.w *= sigm(bfhi(o23));
            hf[q] = y; ss += (y.x * y.x + y.y * y.y) + (y.z * y.z + y.w * y.w); }
        const float rs = rsqrtf(row16_sum(ss) * (1.f / 512.f) + EPS);
        unsigned w[16];
#pragma unroll
        for (int q = 0; q < 8; ++q) { const unsigned z01 = zv[q >> 1][(q & 1) * 2], z23 = zv[q >> 1][(q & 1) * 2 + 1]; const f32x4 g4 = *(const f32x4*)(ng + c0 + 4 * q); const f32x4 y = hf[q] * rs * g4;
            w[2 * q] = pk2(y.x * silu(bflo(z01)), y.y * silu(bfhi(z01))); w[2 * q + 1] = pk2(y.z * silu(bflo(z23)), y.w * silu(bfhi(z23))); }
        u32x4* dst = (u32x4*)(Yo + (size_t)m * 2048 + c0);
#pragma unroll
        for (int q = 0; q < 4; ++q) dst[q] = (u32x4){w[4 * q], w[4 * q + 1], w[4 * q + 2], w[4 * q + 3]};
    }
}

__device__ __forceinline__ void phase_final(const Args& a, int lane, int wave, int G) {
    const int gw = blockIdx.x * NWAVES + wave, NGW = G * NWAVES;
    const float* MOD = (const float*)(a.ws + WS_MOD); const bf16_t* PART = (const bf16_t*)(a.ws + WS_PART); const float* X1 = (const float*)(a.ws + WS_X1);
    const float* fg = a.in[12];
    for (int m = gw; m < NTOK; m += NGW) {
        int t, T, cr; tok_info(m, t, T, cr);
        const f32x4* xr = (const f32x4*)(X1 + (size_t)m * 1024) + lane;
        const u32x2* p0 = (const u32x2*)(PART + (size_t)m * 1024) + lane; const u32x2* p1 = (const u32x2*)(PART + (size_t)NTOK * 1024 + (size_t)m * 1024) + lane;
        const f32x4* gt = (const f32x4*)(MOD + (1 * 3 + cr) * 3072 + 2048) + lane;
        f32x4 v[4]; float s = 0.f;
#pragma unroll
        for (int j = 0; j < 4; ++j) { { const u32x2 a0 = p0[64 * j], a1 = p1[64 * j]; const f32x4 ps = (f32x4){bflo(a0.x) + bflo(a1.x), bfhi(a0.x) + bfhi(a1.x), bflo(a0.y) + bflo(a1.y), bfhi(a0.y) + bfhi(a1.y)}; v[j] = xr[64 * j] + gt[64 * j] * ps; } s += (v[j].x * v[j].x + v[j].y * v[j].y) + (v[j].z * v[j].z + v[j].w * v[j].w); }
        const float rstd = rsqrtf(wave_sum(s) * (1.f / 1024.f) + EPS);
#pragma unroll
        for (int j = 0; j < 4; ++j) { const f32x4 g4 = *(const f32x4*)(fg + 4 * lane + 256 * j); ((f32x4*)(a.out + OUT_Y + (size_t)m * 1024))[lane + 64 * j] = v[j] * rstd * g4; }
    }
}


#define XB_TMO      128
#define XB_XCNT(j)  (256  + 64 * (j))
#define XB_XSUB(j)  (1280 + 64 * (j))
#define XB_XGEN(j)  (2304 + 64 * (j))
#define XB_TOP      3328
#define XB_TOPGEN   3392
#define XCD_BAR_WORDS 3456
#define XB_SPIN_CAP (1u << 18)
__device__ __forceinline__ unsigned xb_ld(unsigned* p)              { return __hip_atomic_load(p, __ATOMIC_RELAXED, __HIP_MEMORY_SCOPE_AGENT); }
__device__ __forceinline__ unsigned xb_add(unsigned* p, unsigned v) { return __hip_atomic_fetch_add(p, v, __ATOMIC_RELAXED, __HIP_MEMORY_SCOPE_AGENT); }
__device__ __forceinline__ unsigned xb_xcc_id() { return (unsigned)__builtin_amdgcn_s_getreg((3 << 11) | 20) & 0xFu; }
#define XB_SPIN(cond, bar) do { unsigned _sp = 0; while (cond) { __builtin_amdgcn_s_sleep(1); \
    if ((++_sp & 255u) == 0u) { if (xb_ld(&(bar)[XB_TMO])) break; if (_sp > XB_SPIN_CAP) { atomicAdd(&(bar)[XB_TMO], 1u); break; } } } } while (0)
struct XcdBarrier { unsigned* bar; unsigned x; volatile LAS unsigned* st; };
__device__ __forceinline__ XcdBarrier xcd_barrier_post(unsigned* bar, volatile LAS unsigned* st) {
    XcdBarrier b; b.bar = bar; b.x = xb_xcc_id(); b.st = st;
    if (threadIdx.x == 0) (void)xb_add(&bar[XB_XCNT(b.x)], 1u);
    return b;
}
__device__ __forceinline__ void xcd_barrier_complete(unsigned* bar, unsigned x, unsigned& nloc, unsigned& nx) {
    const unsigned G = gridDim.x * gridDim.y * gridDim.z;
    unsigned sum, cnt, mine, sp = 0u;
    for (;;) {
        sum = 0u; cnt = 0u; mine = 0u;
#pragma unroll
        for (unsigned j = 0; j < 16; ++j) { const unsigned c = xb_ld(&bar[XB_XCNT(j)]); sum += c; cnt += (c > 0u) ? 1u : 0u; mine = (j == x) ? c : mine; }
        if (sum == G) break;
        __builtin_amdgcn_s_sleep(1);
        if ((++sp & 255u) == 0u) { if (xb_ld(&bar[XB_TMO])) break; if (sp > XB_SPIN_CAP) { atomicAdd(&bar[XB_TMO], 1u); break; } }
    }
    nloc = mine > 0u ? mine : 1u; nx = cnt > 0u ? cnt : 1u;
}
__device__ __forceinline__ void xcd_barrier(const XcdBarrier& b) {
    asm volatile("s_waitcnt vmcnt(0)" ::: "memory");
    __syncthreads();
    if (threadIdx.x == 0) {
        unsigned* bar = b.bar;
        __builtin_amdgcn_s_waitcnt(0);
        unsigned nloc = b.st[0], nx = b.st[1];
        if (nloc == 0u) { xcd_barrier_complete(bar, b.x, nloc, nx); b.st[0] = nloc; b.st[1] = nx; }
        const unsigned old = xb_add(&bar[XB_XSUB(b.x)], 1u);
        const unsigned gen = old / nloc;
        if (old + 1u == (gen + 1u) * nloc) {
            __builtin_amdgcn_fence(__ATOMIC_RELEASE, "agent");
            asm volatile("s_waitcnt vmcnt(0)" ::: "memory");
            const unsigned og = xb_add(&bar[XB_TOP], 1u);
            const unsigned tg = og / nx;
            if (og + 1u == (tg + 1u) * nx) xb_add(&bar[XB_TOPGEN], 1u);
            else XB_SPIN(xb_ld(&bar[XB_TOPGEN]) == tg, bar);
            __builtin_amdgcn_fence(__ATOMIC_ACQUIRE, "agent");
            xb_add(&bar[XB_XGEN(b.x)], 1u);
            asm volatile("s_waitcnt vmcnt(0)" ::: "memory");
        } else {
            XB_SPIN(xb_ld(&bar[XB_XGEN(b.x)]) == gen, bar);
            __builtin_amdgcn_fence(__ATOMIC_ACQUIRE, "agent");
            asm volatile("s_waitcnt vmcnt(0)" ::: "memory");
        }
    }
    __syncthreads();
}

constexpr int N_PHASES = 17;
#ifndef PROBE_MASK
#define PROBE_MASK 0u
#endif
template <int K>
__device__ __forceinline__ void run_phase(const Args& a, LAS unsigned char* lds, int tid_, int G, int rep) {
    int tid = tid_; asm volatile("" : "+v"(tid)); const int lane = tid & 63, wave = __builtin_amdgcn_readfirstlane(tid >> 6);
    if constexpr (K == 0) phase_prologue(a, lds, tid, lane, wave, G);
    else if constexpr (K == 1) phase_modnorm0(a, lane, wave, G);
    else if constexpr (K == 2) { pg8::Gemm g{(const bf16_t*)(a.ws + WS_XN), (const bf16_t*)(a.ws + WS_WINE), NTOK, IN_EVEN, 1024, 1024}; pg8::StaticOrder S; S.init(NTOK, IN_EVEN, G, (int)blockIdx.x);
        pg8::EpiBf16 E{(bf16_t*)(a.ws + WS_PROJ), IN_EVEN};
        pg8::gemm_phase<pg8::EpiBf16, pg8::StaticOrder, true, true>(lds, g, S, E); }
    else if constexpr (K == 3) phase_rwkv_lr(a, tid, G);
    else if constexpr (K == 4) { pg8::Gemm g{(const bf16_t*)(a.ws + WS_LR), (const bf16_t*)(a.ws + WS_W2B), NTOK, 4096, 128, 256}; pg8::LowRankOrder S; S.S.init(NTOK, 4096, G, (int)blockIdx.x);
        pg8::EpiBf16 E{(bf16_t*)(a.ws + WS_U4), 4096};
        pg8::gemm_phase<pg8::EpiBf16, pg8::LowRankOrder, true, true>(lds, g, S, E); }
    else if constexpr (K == 5) {
        unsigned* head = (unsigned*)(a.ws + WS_CTL) + CW_Q2 + rep * 2048; volatile LAS unsigned* slot = (volatile LAS unsigned*)(lds + MISC_OFF);
        for (;;) { const int task = queue_pop(head, slot, tid); if (task >= 768) break;
            const int grp = task / 3, sub = task - grp * 3;
            if (sub < 2) { const int job = (grp * 2 + sub) * 8 + wave; rwkv_chunk_job(a, lds + wave * RW_WL, lane, job >> 4, job & 15); }
            else hgrn_pre_bundle(a, lds, tid, grp * 16); } }
    else if constexpr (K == 6) phase_scans_even(a, lds, tid, rep * 2048);
    else if constexpr (K == 7) phase_combine_even(a, lane, wave, G);
    else if constexpr (K == 8) { pg8::Gemm g{(const bf16_t*)(a.ws + WS_Y), (const bf16_t*)(a.ws + WS_WOUTE), NTOK, 1024, 1024, 2048}; pg8::SplitKOrder S{G, (int)blockIdx.x};
        pg8::EpiBf16Part E{(bf16_t*)(a.ws + WS_PART), 1024, (size_t)NTOK * 1024};
        pg8::gemm_phase<pg8::EpiBf16Part, pg8::SplitKOrder, false, true>(lds, g, S, E); }
    else if constexpr (K == 9) phase_res_modnorm1(a, lane, wave, G);
    else if constexpr (K == 10) { pg8::Gemm g{(const bf16_t*)(a.ws + WS_XN), (const bf16_t*)(a.ws + WS_WINO), NTOK, IN_ODD_MAIN, 1024, 1024}; pg8::StaticOrder S; S.init(NTOK, IN_ODD_MAIN, G, (int)blockIdx.x);
        pg8::EpiBf16 E{(bf16_t*)(a.ws + WS_PROJ), IN_ODD_MAIN};
        pg8::gemm_phase<pg8::EpiBf16, pg8::StaticOrder, true, true>(lds, g, S, E); }
    else if constexpr (K == 11) { { const int gw = blockIdx.x * NWAVES + wave; if (gw < 144) mlstm_gate_scan(a, lane, gw); } phase_conv(a, tid, G); }
    else if constexpr (K == 12) phase_mlstm_pre(a, lds, lane, wave, G);
    else if constexpr (K == 13) phase_scans_odd(a, lds, tid, rep * 2048);
    else if constexpr (K == 14) phase_combine_odd(a, lane, wave, G);
    else if constexpr (K == 15) { pg8::Gemm g{(const bf16_t*)(a.ws + WS_Y), (const bf16_t*)(a.ws + WS_WOUTO), NTOK, 1024, 1024, 2048}; pg8::SplitKOrder S{G, (int)blockIdx.x};
        pg8::EpiBf16Part E{(bf16_t*)(a.ws + WS_PART), 1024, (size_t)NTOK * 1024};
        pg8::gemm_phase<pg8::EpiBf16Part, pg8::SplitKOrder, false, true>(lds, g, S, E); }
    else if constexpr (K == 16) phase_final(a, lane, wave, G);
}
__global__ void __launch_bounds__(NT, 2) fwd_kernel(Args a) {
    extern __shared__ __attribute__((aligned(16))) unsigned char lds_raw[];
    LAS unsigned char* lds = (LAS unsigned char*)lds_raw;
    const int tid = threadIdx.x, G = gridDim.x;
    const int lo = a.ph_lo, hi = a.ph_hi;
    if (tid < 16) ((volatile LAS unsigned*)(lds + MISC_OFF))[tid] = 0u;
    __syncthreads();
    const XcdBarrier bar = xcd_barrier_post((unsigned*)(a.ws + WS_CTL) + CW_BAR, (volatile LAS unsigned*)(lds + MISC_OFF) + 8);
#define IN(k) (lo <= (k) && (k) < hi)
#define PHASE(k) do { if (IN(k)) { run_phase<k>(a, lds, tid, G, 0); if ((PROBE_MASK >> (k)) & 1u) { xcd_barrier(bar); run_phase<k>(a, lds, tid, G, 1); } } \
        if (IN(k) && IN((k) + 1)) xcd_barrier(bar); } while (0)
    PHASE(0); PHASE(1); PHASE(2); PHASE(3); PHASE(4); PHASE(5); PHASE(6); PHASE(7); PHASE(8); PHASE(9); PHASE(10); PHASE(11); PHASE(12); PHASE(13); PHASE(14); PHASE(15); PHASE(16);
#undef IN
#undef PHASE
}

extern "C" void kernel_launch(void* const* d_in, const int* in_sizes, int n_in,
                              void* d_out, int out_size, void* d_ws, size_t ws_size,
                              hipStream_t stream) {
    static int grid_blocks = 0;
    if (!grid_blocks) {
        int dev = 0, cus = 0, per_cu = 0;
        (void)hipGetDevice(&dev);
        (void)hipDeviceGetAttribute(&cus, hipDeviceAttributeMultiprocessorCount, dev);
        (void)hipFuncSetAttribute((const void*)fwd_kernel, hipFuncAttributeMaxDynamicSharedMemorySize, LDS_BYTES);
        (void)hipOccupancyMaxActiveBlocksPerMultiprocessor(&per_cu, (const void*)fwd_kernel, NT, LDS_BYTES);
        (void)hipGetLastError();
        grid_blocks = cus > 0 ? cus : 256;
        fprintf(stderr, "kernel_launch: cus=%d per_cu=%d grid=%d ws=%zu\n", cus, per_cu, grid_blocks, ws_size);
        if (n_in != 33 || ws_size < WS_END) { fprintf(stderr, "kernel_launch: unexpected n_in %d / ws %zu\n", n_in, ws_size); }
    }
    (void)hipMemsetAsync((char*)d_ws + WS_CTL, 0, CTL_ZERO_BYTES, stream);
    Args a{};
    for (int i = 0; i < 33; ++i) a.in[i] = (const float*)d_in[i];
    a.out = (float*)d_out; a.ws = (unsigned char*)d_ws; a.ph_lo = 0; a.ph_hi = N_PHASES;
    void* args[] = {&a};
    hipError_t e = hipLaunchCooperativeKernel((const void*)fwd_kernel, dim3(grid_blocks), dim3(NT), args, LDS_BYTES, stream);
    if (e != hipSuccess) fprintf(stderr, "cooperative launch failed: %s (grid %d)\n", hipGetErrorString(e), grid_blocks);
}
```

```cpp
#include <hip/hip_runtime.h>
#include <cstdio>
#include <cstdint>

#define LAS __attribute__((address_space(3)))
#define GAS __attribute__((address_space(1)))
typedef unsigned short bf16_t;
typedef short bf16x8 __attribute__((ext_vector_type(8)));
typedef float f32x4 __attribute__((ext_vector_type(4)));
typedef float f32x2 __attribute__((ext_vector_type(2)));
typedef unsigned u32x4 __attribute__((ext_vector_type(4)));
typedef unsigned u32x2 __attribute__((ext_vector_type(2)));

namespace pg8 {
#define PG8_LAS __attribute__((address_space(3)))
constexpr int BM = 256, BK = 64, HALF = 128, HTB = HALF * BK * 2, STAGE_BYTES = 8 * HTB, NXCD = 8, WGM = 8;

__host__ __device__ __forceinline__ int lds_byte(int r, int c) { const int st = (r >> 4) * 2 + (c >> 5), rr = r & 15, cc = c & 31, ob = rr * 64 + cc * 2; return st * 1024 + (ob ^ (((ob >> 9) & 1) << 5)); }
__host__ __device__ __forceinline__ void stage_rc(int b, int& R, int& C) { const int st = b / 1024, sb = b % 1024, swz = sb ^ (((sb >> 9) & 1) << 5); R = (st >> 1) * 16 + swz / 64; C = (st & 1) * 32 + (swz % 64) / 2; }
__host__ __device__ __forceinline__ int perm32(int rho) { const int n = rho >> 4, i = rho & 15; return 8 * (i >> 2) + 4 * n + (i & 3); }

struct Unit { int pm, pn, ks; };
struct Gemm { const bf16_t* A; const bf16_t* Bt; int M, N, K, ld; };

struct StaticOrder {
    int nM, nN, nwg, G, c;
    __host__ __device__ void init(int M, int N, int G_, int c_) { nM = M / BM; nN = N / BM; nwg = nM * nN; G = G_; c = c_; }
    __host__ __device__ bool next(int i, Unit& u) const {
        const long L = (long)i * G + c; if (L >= nwg) return false;
        int wgid = (int)L; { const int q = nwg / NXCD, r = nwg % NXCD, xcd = wgid % NXCD, off = wgid / NXCD; wgid = (xcd < r ? xcd * (q + 1) : r * (q + 1) + (xcd - r) * q) + off; }
        const int nig = WGM * nN, gid = wgid / nig, fm = gid * WGM, gsz = (nM - fm) < WGM ? (nM - fm) : WGM;
        u.pm = fm + ((wgid % nig) % gsz); u.pn = (wgid % nig) / gsz; u.ks = 0; return true;
    }
    __device__ __forceinline__ void a_ready(const Unit&) const {}
    __device__ __forceinline__ void done(const Unit&) const {}
};
struct LowRankOrder { StaticOrder S;
    __host__ __device__ bool next(int i, Unit& u) const { if (!S.next(i, u)) return false; u.ks = u.pn >> 3; return true; }
    __device__ __forceinline__ void a_ready(const Unit&) const {}
    __device__ __forceinline__ void done(const Unit&) const {}
};
struct SplitKOrder {
    int G, c;
    __host__ __device__ bool next(int i, Unit& u) const {
        const long L = (long)i * G + c; if (L >= 256) return false;
        u.pm = (int)(L >> 3); u.pn = (int)((L >> 1) & 3); u.ks = (int)(L & 1); return true;
    }
    __device__ __forceinline__ void a_ready(const Unit&) const {}
    __device__ __forceinline__ void done(const Unit&) const {}
};

__device__ __forceinline__ unsigned cvt_pk_bf16(float lo, float hi) { unsigned r; asm volatile("v_cvt_pk_bf16_f32 %0, %1, %2" : "=v"(r) : "v"(lo), "v"(hi)); return r; }

struct EpiBf16 {
    static constexpr bool PERM = true, AFTER_DRAIN = false;
    bf16_t* O; int ldc;
    __device__ __forceinline__ void operator()(const f32x4 (&acc)[2][2][4][2], const Unit& u, int wr, int wc, int fr, int fq) const {
        const int row0 = u.pm * BM + wr * 64 + fr; const int col0 = u.pn * BM + wc * 32 + 8 * fq;
#pragma unroll
        for (int ai = 0; ai < 2; ++ai)
#pragma unroll
            for (int m = 0; m < 4; ++m) { bf16_t* rowp = O + (size_t)(row0 + ai * HALF + m * 16) * ldc + col0;
#pragma unroll
                for (int bj = 0; bj < 2; ++bj) { const f32x4 v0 = acc[ai][bj][m][0], v1 = acc[ai][bj][m][1];
                    u32x4 w; w.x = cvt_pk_bf16(v0[0], v0[1]); w.y = cvt_pk_bf16(v0[2], v0[3]); w.z = cvt_pk_bf16(v1[0], v1[1]); w.w = cvt_pk_bf16(v1[2], v1[3]);
                    *(u32x4*)(rowp + bj * HALF) = w; } }
    }
};
struct EpiBf16Part {
    static constexpr bool PERM = true, AFTER_DRAIN = false;
    bf16_t* O; int ldc; size_t part_stride;
    __device__ __forceinline__ void operator()(const f32x4 (&acc)[2][2][4][2], const Unit& u, int wr, int wc, int fr, int fq) const {
        const int row0 = u.pm * BM + wr * 64 + fr; const int col0 = u.pn * BM + wc * 32 + 8 * fq;
        bf16_t* base = O + (size_t)u.ks * part_stride;
#pragma unroll
        for (int ai = 0; ai < 2; ++ai)
#pragma unroll
            for (int m = 0; m < 4; ++m) { bf16_t* rowp = base + (size_t)(row0 + ai * HALF + m * 16) * ldc + col0;
#pragma unroll
                for (int bj = 0; bj < 2; ++bj) { const f32x4 v0 = acc[ai][bj][m][0], v1 = acc[ai][bj][m][1];
                    u32x4 w; w.x = cvt_pk_bf16(v0[0], v0[1]); w.y = cvt_pk_bf16(v0[2], v0[3]); w.z = cvt_pk_bf16(v1[0], v1[1]); w.w = cvt_pk_bf16(v1[2], v1[3]);
                    *(u32x4*)(rowp + bj * HALF) = w; } }
    }
};
struct EpiF32Part {
    static constexpr bool PERM = false, AFTER_DRAIN = false;
    float* P; int ldc; size_t part_stride;
    __device__ __forceinline__ void operator()(const f32x4 (&acc)[2][2][4][2], const Unit& u, int wr, int wc, int fr, int fq) const {
        const int row0 = u.pm * BM + wr * 64 + fr; const int col0 = u.pn * BM + wc * 32 + 4 * fq;
        float* base = P + (size_t)u.ks * part_stride;
#pragma unroll
        for (int ai = 0; ai < 2; ++ai)
#pragma unroll
            for (int m = 0; m < 4; ++m) { float* rowp = base + (size_t)(row0 + ai * HALF + m * 16) * ldc + col0;
#pragma unroll
                for (int bj = 0; bj < 2; ++bj)
#pragma unroll
                    for (int n = 0; n < 2; ++n) *(f32x4*)(rowp + bj * HALF + n * 16) = acc[ai][bj][m][n]; }
    }
};

template <class Epi, class Sched, bool ALIGN_EPI = false, bool SP2 = false>
__device__ __forceinline__ void gemm_phase(PG8_LAS unsigned char* lds, const Gemm g, const Sched& S, const Epi& E) {
    const int tid = threadIdx.x, wid = __builtin_amdgcn_readfirstlane(tid >> 6), lane = tid & 63, wr = wid >> 2, wc = wid & 3, fr = lane & 15, fq = lane >> 4;
    const int K = g.K, nt = K / BK, LD = g.ld;
    unsigned voffA[2], voffB[2];
#pragma unroll
    for (int i = 0; i < 2; ++i) { int R, C; stage_rc(tid * 16 + i * 8192, R, C); const int Rb = Epi::PERM ? ((R & ~31) + perm32(R & 31)) : R;
        voffA[i] = (unsigned)(R * LD + C) * 2u; voffB[i] = (unsigned)(Rb * LD + C) * 2u; }
    const size_t kstep = (size_t)(BK * 2);
    const size_t hstep = (size_t)HALF * LD * 2;
    const size_t tstep = 2 * hstep;
    const size_t sstep = (size_t)K * 2;
    const unsigned ldsw = (unsigned)wid * 1024u;
    const int aoff = lds_byte(wr * 64 + fr, fq * 8), boff = lds_byte(wc * 32 + fr, fq * 8);
#define PG8_SA(b, h) (((b) * 2 + (h)) * HTB)
#define PG8_SB(b, h) ((4 + (b) * 2 + (h)) * HTB)
#define PG8_STAGE(bufoff, gbase, voff) do { _Pragma("unroll") for (int _i = 0; _i < 2; ++_i) \
        __builtin_amdgcn_global_load_lds((const unsigned*)((const char*)(gbase) + (voff)[_i]), (PG8_LAS unsigned*)(lds + (bufoff) + ldsw + _i * 8192), 16, 0, 0); } while (0)
#define PG8_LDA(dst, b, h) do { _Pragma("unroll") for (int m = 0; m < 4; ++m) _Pragma("unroll") for (int k = 0; k < 2; ++k) dst[m][k] = *(const PG8_LAS bf16x8*)(lds + PG8_SA(b, h) + aoff + m * 2048 + k * 1024); } while (0)
#define PG8_LDB(dst, b, h) do { _Pragma("unroll") for (int n = 0; n < 2; ++n) _Pragma("unroll") for (int k = 0; k < 2; ++k) dst[n][k] = *(const PG8_LAS bf16x8*)(lds + PG8_SB(b, h) + boff + n * 2048 + k * 1024); } while (0)
#define PG8_MMA(ai, bj, At, Bt) do { __builtin_amdgcn_s_setprio(1); _Pragma("unroll") for (int m = 0; m < 4; ++m) _Pragma("unroll") for (int n = 0; n < 2; ++n) _Pragma("unroll") for (int k = 0; k < 2; ++k) \
        acc[ai][bj][m][n] = __builtin_amdgcn_mfma_f32_16x16x32_bf16(Bt[n][k], At[m][k], acc[ai][bj][m][n], 0, 0, 0); __builtin_amdgcn_s_setprio(0); } while (0)
#define PG8_WAIT_V(n) asm volatile("s_waitcnt vmcnt(" #n ")" ::: "memory")
#define PG8_WAIT_L(n) asm volatile("s_waitcnt lgkmcnt(" #n ")" ::: "memory")
#define PG8_BAR __builtin_amdgcn_s_barrier()
#define PG8_SCHED __builtin_amdgcn_sched_barrier(0)
    Unit cur, nxt; int ui = 0;
    if (!S.next(0, cur)) return;
    f32x4 acc[2][2][4][2];
#pragma unroll
    for (int a = 0; a < 2; ++a)
#pragma unroll
        for (int b = 0; b < 2; ++b)
#pragma unroll
            for (int m = 0; m < 4; ++m)
#pragma unroll
                for (int n = 0; n < 2; ++n) acc[a][b][m][n] = (f32x4){0.f, 0.f, 0.f, 0.f};
    bf16x8 At[4][2], B0[2][2], B1[2][2];
    const char* cA = (const char*)g.A + (size_t)cur.pm * tstep + (size_t)cur.ks * sstep; const char* cB = (const char*)g.Bt + (size_t)cur.pn * tstep + (size_t)cur.ks * sstep;
    S.a_ready(cur);
    if constexpr (SP2) {
        PG8_STAGE(PG8_SB(0, 0), cB, voffB); PG8_STAGE(PG8_SB(0, 1), cB + hstep, voffB); PG8_STAGE(PG8_SA(0, 0), cA, voffA); PG8_STAGE(PG8_SA(0, 1), cA + hstep, voffA);
        if (wr == 1) PG8_BAR;
        PG8_WAIT_V(2); PG8_BAR;
        PG8_STAGE(PG8_SB(1, 0), cB + kstep, voffB); PG8_STAGE(PG8_SA(1, 0), cA + kstep, voffA); PG8_STAGE(PG8_SB(1, 1), cB + hstep + kstep, voffB);
        PG8_WAIT_V(6); PG8_BAR;
    } else {
        PG8_STAGE(PG8_SB(0, 0), cB, voffB); PG8_STAGE(PG8_SA(0, 0), cA, voffA); PG8_STAGE(PG8_SB(0, 1), cB + hstep, voffB); PG8_STAGE(PG8_SA(0, 1), cA + hstep, voffA);
        if (wr == 1) PG8_BAR;
        PG8_WAIT_V(4); PG8_BAR;
        PG8_STAGE(PG8_SB(1, 0), cB + kstep, voffB); PG8_STAGE(PG8_SA(1, 0), cA + kstep, voffA); PG8_STAGE(PG8_SB(1, 1), cB + hstep + kstep, voffB);
        PG8_WAIT_V(6); PG8_BAR;
    }
    for (;;) {
        const bool has_next = S.next(ui + 1, nxt);
        const char* nA = has_next ? (const char*)g.A + (size_t)nxt.pm * tstep + (size_t)nxt.ks * sstep : cA; const char* nB = has_next ? (const char*)g.Bt + (size_t)nxt.pn * tstep + (size_t)nxt.ks * sstep : cB;
        for (int t = 0; t < nt; t += 2) {
            const bool last = (t == nt - 2);
            const char* a1 = cA + (size_t)(t + 1) * kstep;
            const char* a2 = last ? nA : cA + (size_t)(t + 2) * kstep; const char* b2 = last ? nB : cB + (size_t)(t + 2) * kstep;
            const char* a3 = a2 + kstep; const char* b3 = b2 + kstep;
            if (last && has_next) S.a_ready(nxt);
            if constexpr (SP2) {
            PG8_LDB(B0, 0, 0); PG8_LDB(B1, 0, 1); PG8_SCHED; PG8_LDA(At, 0, 0); PG8_STAGE(PG8_SA(1, 1), a1 + hstep, voffA);
            PG8_WAIT_V(8); PG8_WAIT_L(0); PG8_BAR; PG8_MMA(0, 0, At, B0); PG8_MMA(0, 1, At, B1); PG8_BAR; PG8_SCHED;
            PG8_LDA(At, 0, 1); PG8_STAGE(PG8_SB(0, 0), b2, voffB); PG8_STAGE(PG8_SB(0, 1), b2 + hstep, voffB); PG8_STAGE(PG8_SA(0, 0), a2, voffA);
            PG8_WAIT_V(8); PG8_WAIT_L(0); PG8_BAR; PG8_MMA(1, 0, At, B0); PG8_MMA(1, 1, At, B1); PG8_BAR; PG8_SCHED;
            PG8_LDB(B0, 1, 0); PG8_LDB(B1, 1, 1); PG8_SCHED; PG8_LDA(At, 1, 0); PG8_STAGE(PG8_SA(0, 1), a2 + hstep, voffA);
            PG8_WAIT_V(8); PG8_WAIT_L(0); PG8_BAR; PG8_MMA(0, 0, At, B0); PG8_MMA(0, 1, At, B1); PG8_BAR; PG8_SCHED;
            PG8_LDA(At, 1, 1); PG8_STAGE(PG8_SB(1, 0), b3, voffB); PG8_STAGE(PG8_SB(1, 1), b3 + hstep, voffB); PG8_STAGE(PG8_SA(1, 0), a3, voffA);
            PG8_WAIT_V(8); PG8_WAIT_L(0); PG8_BAR; PG8_MMA(1, 0, At, B0); PG8_MMA(1, 1, At, B1); PG8_BAR; PG8_SCHED;
            } else {
            PG8_LDB(B0, 0, 0); PG8_SCHED; PG8_LDA(At, 0, 0); PG8_STAGE(PG8_SA(1, 1), a1 + hstep, voffA);
            PG8_WAIT_L(8); PG8_BAR; PG8_WAIT_L(0); PG8_MMA(0, 0, At, B0); PG8_BAR; PG8_SCHED;
            PG8_LDB(B1, 0, 1); PG8_STAGE(PG8_SB(0, 0), b2, voffB);
            PG8_BAR; PG8_WAIT_L(0); PG8_MMA(0, 1, At, B1); PG8_BAR;
            PG8_LDA(At, 0, 1); PG8_STAGE(PG8_SA(0, 0), a2, voffA);
            PG8_BAR; PG8_WAIT_L(0); PG8_MMA(1, 0, At, B0); PG8_BAR; PG8_SCHED;
            PG8_STAGE(PG8_SB(0, 1), b2 + hstep, voffB);
            PG8_WAIT_V(6); PG8_BAR; PG8_MMA(1, 1, At, B1); PG8_BAR;
            PG8_LDB(B0, 1, 0); PG8_SCHED; PG8_LDA(At, 1, 0); PG8_STAGE(PG8_SA(0, 1), a2 + hstep, voffA);
            PG8_WAIT_L(8); PG8_BAR; PG8_WAIT_L(0); PG8_MMA(0, 0, At, B0); PG8_BAR; PG8_SCHED;
            PG8_LDB(B1, 1, 1); PG8_STAGE(PG8_SB(1, 0), b3, voffB);
            PG8_BAR; PG8_WAIT_L(0); PG8_MMA(0, 1, At, B1); PG8_BAR;
            PG8_LDA(At, 1, 1); PG8_STAGE(PG8_SA(1, 0), a3, voffA);
            PG8_BAR; PG8_WAIT_L(0); PG8_MMA(1, 0, At, B0); PG8_BAR; PG8_SCHED;
            PG8_STAGE(PG8_SB(1, 1), b3 + hstep, voffB);
            PG8_WAIT_V(6); PG8_BAR; PG8_MMA(1, 1, At, B1); PG8_BAR;
            }
        }
        if constexpr (ALIGN_EPI) { if (wr == 0) PG8_BAR; }
        if constexpr (!Epi::AFTER_DRAIN) { E(acc, cur, wr, wc, fr, fq); S.done(cur); }
        if (!has_next) break;
#pragma unroll
        for (int a = 0; a < 2; ++a)
#pragma unroll
            for (int b = 0; b < 2; ++b)
#pragma unroll
                for (int m = 0; m < 4; ++m)
#pragma unroll
                    for (int n = 0; n < 2; ++n) acc[a][b][m][n] = (f32x4){0.f, 0.f, 0.f, 0.f};
        cur = nxt; cA = nA; cB = nB; ++ui;
        if constexpr (ALIGN_EPI) { if (wr == 1) PG8_BAR; }
    }
    PG8_WAIT_V(0);
    if constexpr (!ALIGN_EPI) { if (wr == 0) PG8_BAR; }
    PG8_BAR;
#undef PG8_SA
#undef PG8_SB
#undef PG8_STAGE
#undef PG8_LDA
#undef PG8_LDB
#undef PG8_MMA
#undef PG8_WAIT_V
#undef PG8_WAIT_L
#undef PG8_BAR
#undef PG8_SCHED
}
}

constexpr int NT = 512, NWAVES = 8;
constexpr int LDS_BYTES = 159744;
constexpr int MISC_OFF = 155648;
constexpr int NTOK = 8192, DM = 1024;
constexpr int IN_EVEN = 9472, IN_ODD = 10256, IN_ODD_MAIN = 10240;
constexpr float EPS = 1e-6f, GN_EPS = 64e-5f;
constexpr size_t OUT_Y = 0, OUT_HGRN = 8388608, OUT_RWKV = 12582912, OUT_C = 14680064, OUT_N = 48234496, OUT_M = 48300032;
constexpr size_t MiB = 1u << 20;
constexpr size_t WS_CTL = 0, CTL_ZERO_BYTES = 64 * 1024;
constexpr size_t WS_MOD = 1 * MiB;
constexpr size_t WS_GW = 1 * MiB + 512 * 1024;
constexpr size_t WS_GATES = 1 * MiB + 768 * 1024;
constexpr size_t WS_WINE = 4 * MiB;
constexpr size_t WS_WOUTE = 24 * MiB;
constexpr size_t WS_WINO = 28 * MiB;
constexpr size_t WS_WOUTO = 48 * MiB;
constexpr size_t WS_XN = 52 * MiB;
constexpr size_t WS_X1 = 68 * MiB;
constexpr size_t WS_PROJ = 100 * MiB;
constexpr size_t WS_OF = 260 * MiB, WS_OB = 292 * MiB;
constexpr size_t WS_QKC = 260 * MiB;
constexpr size_t WS_YF = 324 * MiB, WS_YB = 356 * MiB;
constexpr size_t WS_HF = 324 * MiB, WS_HB = 388 * MiB;
constexpr size_t WS_U4 = 260 * MiB;
constexpr size_t WS_RS = 324 * MiB, WS_KS = 340 * MiB, WS_KKS = 356 * MiB;
constexpr size_t WS_RWREC = 388 * MiB;
constexpr size_t WS_Y = 564 * MiB;
constexpr size_t WS_PART = 596 * MiB;
constexpr size_t WS_BS = 660 * MiB;
constexpr size_t WS_GT = 662 * MiB;
constexpr size_t WS_DEN = 662 * MiB + 512 * 1024;
constexpr size_t WS_V = 664 * MiB;
constexpr size_t WS_LR = 680 * MiB;
constexpr size_t WS_W2B = 684 * MiB;
constexpr size_t WS_HQA0 = 52 * MiB, WS_HKT0 = 68 * MiB, WS_HQA1 = 84 * MiB, WS_HKT1 = 616 * MiB;
constexpr size_t WS_HSC = 632 * MiB;
constexpr size_t WS_MP = 686 * MiB;
constexpr size_t WS_MLREC = 596 * MiB;
constexpr size_t WS_QKF = 420 * MiB;
constexpr size_t WS_END = 687 * MiB;
constexpr int CW_Q0 = 64, CW_Q2 = 192, CW_Q1 = 1024, CW_BAR = 4096;

struct Args { const float* in[33]; float* out; unsigned char* ws; int ph_lo, ph_hi; };

__device__ __forceinline__ float bf2f(unsigned short u) { return __uint_as_float((unsigned)u << 16); }
typedef __bf16 bf16x2_t __attribute__((ext_vector_type(2)));
__device__ __forceinline__ unsigned pk2(float lo, float hi) { const f32x2 v = {lo, hi}; const bf16x2_t b = __builtin_convertvector(v, bf16x2_t); return __builtin_bit_cast(unsigned, b); }
__device__ __forceinline__ unsigned f2bf(float f) { return (unsigned)__builtin_bit_cast(unsigned short, (__bf16)f); }
__device__ __forceinline__ float sigm(float x) { return 1.f / (1.f + __expf(-x)); }
__device__ __forceinline__ float silu(float x) { return x / (1.f + __expf(-x)); }
__device__ __forceinline__ void tok_info(int m, int& t, int& T, int& cr) {
    if (m < 4096) { t = m & 255; T = 256; cr = 0; } else { const int mm = m - 4096; t = mm & 2047; T = 2048; cr = 1 + (mm >> 11); }
}
__device__ __forceinline__ const float* x_row(const Args& a, int m) { return m < 4096 ? a.in[0] + (size_t)m * DM : a.in[1] + (size_t)(m - 4096) * DM; }
template <int CTRL> __device__ __forceinline__ float dpp_mov(float v) { return __uint_as_float((unsigned)__builtin_amdgcn_update_dpp(0, (int)__float_as_uint(v), CTRL, 0xF, 0xF, false)); }
__device__ __forceinline__ float row16_sum(float v) {
    v += dpp_mov<0xB1>(v);
    v += dpp_mov<0x4E>(v);
    v += dpp_mov<0x141>(v);
    v += dpp_mov<0x140>(v);
    return v;
}
__device__ __forceinline__ float bflo(unsigned u) { return __uint_as_float(u << 16); }
__device__ __forceinline__ float bfhi(unsigned u) { return __uint_as_float(u & 0xffff0000u); }
__device__ __forceinline__ float quad_sum(float v) { v += dpp_mov<0xB1>(v); v += dpp_mov<0x4E>(v); return v; }
__device__ __forceinline__ float oct_sum(float v) { v = quad_sum(v); v += dpp_mov<0x141>(v); return v; }
__device__ __forceinline__ float wave_sum(float v) {
    v = row16_sum(v);
    const int vi = (int)__float_as_uint(v);
    const float s0 = __uint_as_float((unsigned)__builtin_amdgcn_readlane(vi, 0)), s1 = __uint_as_float((unsigned)__builtin_amdgcn_readlane(vi, 16));
    const float s2 = __uint_as_float((unsigned)__builtin_amdgcn_readlane(vi, 32)), s3 = __uint_as_float((unsigned)__builtin_amdgcn_readlane(vi, 48));
    return (s0 + s1) + (s2 + s3);
}

__device__ __forceinline__ void p0_transpose_item(const float* W, int ldw, int K, int nblk, bf16_t* WT, LAS float* scr, int item, int lane) {
    const int kb = item / nblk, nb = item % nblk, k0 = 64 * kb, n0 = 32 * nb;
    f32x4 v[8];
#pragma unroll
    for (int i = 0; i < 8; ++i) v[i] = *(const f32x4*)(W + (size_t)(k0 + 8 * i + (lane >> 3)) * ldw + n0 + 4 * (lane & 7));
    __builtin_amdgcn_sched_barrier(0);
#pragma unroll
    for (int i = 0; i < 8; ++i) { LAS float* d = scr + (8 * i + (lane >> 3)) * 33 + 4 * (lane & 7); d[0] = v[i].x; d[1] = v[i].y; d[2] = v[i].z; d[3] = v[i].w; }
    asm volatile("s_waitcnt lgkmcnt(0)" ::: "memory");
    const int c = lane & 7;
#pragma unroll
    for (int j = 0; j < 4; ++j) { const int n = (lane >> 3) + 8 * j; const LAS float* s = scr + (8 * c) * 33 + n;
        u32x4 o; o.x = pk2(s[0 * 33], s[1 * 33]); o.y = pk2(s[2 * 33], s[3 * 33]); o.z = pk2(s[4 * 33], s[5 * 33]); o.w = pk2(s[6 * 33], s[7 * 33]);
        *(u32x4*)(WT + (size_t)(n0 + n) * K + k0 + 8 * c) = o; }
    asm volatile("s_waitcnt lgkmcnt(0)" ::: "memory");
}

__device__ __forceinline__ void phase_prologue(const Args& a, LAS unsigned char* lds, int tid, int lane, int wave, int G) {
    unsigned char* ws = a.ws;
    if ((int)blockIdx.x < 96) {
        const int item = blockIdx.x, layer = item / 48, g = item % 48, col = g * 64 + lane;
        const float* wm = a.in[9] + (size_t)layer * 1024 * 3072;
        const float* cctx = a.in[8]; const float* cc = a.in[2];
        float a0 = 0.f, a1 = 0.f, a2 = 0.f;
        const int k0 = wave * 128;
#pragma unroll 8
        for (int k = k0; k < k0 + 128; ++k) {
            const float wv = wm[(size_t)k * 3072 + col];
            a0 += silu(cctx[k]) * wv; a1 += silu(cc[k]) * wv; a2 += silu(cc[1024 + k]) * wv;
        }
        LAS float* red = (LAS float*)lds;
        red[(wave * 3 + 0) * 64 + lane] = a0; red[(wave * 3 + 1) * 64 + lane] = a1; red[(wave * 3 + 2) * 64 + lane] = a2;
        __syncthreads();
        if (tid < 192) { const int r = tid >> 6, l = tid & 63; float s = 0.f;
#pragma unroll
            for (int w = 0; w < 8; ++w) s += red[(w * 3 + r) * 64 + l];
            ((float*)(ws + WS_MOD))[(layer * 3 + r) * 3072 + g * 64 + l] = s + a.in[10][layer * 3072 + g * 64 + l]; }
        __syncthreads();
    }
    for (int idx = blockIdx.x * NT + tid; idx < 16384; idx += G * NT) { const int k = idx >> 4, j = idx & 15; ((float*)(ws + WS_GW))[j * 1024 + k] = a.in[27][(size_t)k * IN_ODD + IN_ODD_MAIN + j]; }
    for (int idx = blockIdx.x * NT + tid; idx < 4096 * 256; idx += G * NT) { const int n = idx >> 8, k = idx & 255, qn = n >> 10, c = n & 1023, qk = k >> 6, j = k & 63;
        float wv = 0.f; if (qn == qk) wv = (qn < 2 ? a.in[19] : a.in[21])[(size_t)((qn & 1) * 64 + j) * 1024 + c];
        ((bf16_t*)(ws + WS_W2B))[idx] = (bf16_t)f2bf(wv); }
    LAS float* scr = (LAS float*)(lds + wave * 16384);
    const int gw = blockIdx.x * NWAVES + wave, NGW = G * NWAVES;
    constexpr int I_E = 16 * 296, I_OE = 32 * 32, NITEMS = I_E + I_OE;
    for (int it = gw; it < NITEMS; it += NGW) {
        int r = it;
        if (r < I_E) { p0_transpose_item(a.in[13], IN_EVEN, 1024, 296, (bf16_t*)(ws + WS_WINE), scr, r, lane); continue; } r -= I_E;
        p0_transpose_item(a.in[14], 1024, 2048, 32, (bf16_t*)(ws + WS_WOUTE), scr, r, lane);
    }
}

__device__ __forceinline__ void modnorm_store(const f32x4 (&v)[4], const float* ng, const float* mod, bf16_t* orow, int lane, f32x4 (&h)[4]) {
    float s = 0.f;
#pragma unroll
    for (int j = 0; j < 4; ++j) s += (v[j].x * v[j].x + v[j].y * v[j].y) + (v[j].z * v[j].z + v[j].w * v[j].w);
    const float rstd = rsqrtf(wave_sum(s) * (1.f / 1024.f) + EPS);
#pragma unroll
    for (int j = 0; j < 4; ++j) { const int col = 4 * lane + 256 * j;
        const f32x4 g4 = *(const f32x4*)(ng + col), sh = *(const f32x4*)(mod + col), sc = *(const f32x4*)(mod + 1024 + col);
        h[j] = v[j] * rstd * g4 * (sc + 1.f) + sh;
        u32x2 o; o.x = pk2(h[j].x, h[j].y); o.y = pk2(h[j].z, h[j].w);
        *(u32x2*)(orow + col) = o; }
}

__device__ __forceinline__ void phase_modnorm0(const Args& a, int lane, int wave, int G) {
    const int gw = blockIdx.x * NWAVES + wave, NGW = G * NWAVES;
    const float* MOD = (const float*)(a.ws + WS_MOD);
    bf16_t* XN = (bf16_t*)(a.ws + WS_XN);
    for (int m = gw; m < NTOK; m += NGW) {
        int t, T, cr; tok_info(m, t, T, cr);
        const f32x4* xr = (const f32x4*)x_row(a, m) + lane;
        f32x4 v[4], h[4];
#pragma unroll
        for (int j = 0; j < 4; ++j) v[j] = xr[64 * j];
        modnorm_store(v, a.in[11], MOD + (0 * 3 + cr) * 3072, XN + (size_t)m * DM, lane, h);
    }
}

__device__ __forceinline__ float shiftv(const bf16_t* P, const float* mu, int m, int t, int T, int cc) {
    const bf16_t* p = P + (size_t)m * IN_EVEN + 5120 + cc;
    const float cur = bf2f(p[0]);
    const float prev = t > 0 ? bf2f(p[-IN_EVEN]) : 0.f;
    const float nxt = t < T - 1 ? bf2f(p[IN_EVEN]) : 0.f;
    return cur + mu[cc] * (prev - cur) + mu[3328 + cc] * (nxt - cur);
}
__device__ __forceinline__ void phase_rwkv_lr(const Args& a, int tid, int G) {
    const bf16_t* P = (const bf16_t*)(a.ws + WS_PROJ); bf16_t* LR = (bf16_t*)(a.ws + WS_LR); const float* mu = a.in[17];
    for (int idx = blockIdx.x * NT + tid; idx < NTOK * 256; idx += G * NT) { const int m = idx >> 8, jj = idx & 255;
        int t, T, cr; tok_info(m, t, T, cr);
        float val = shiftv(P, mu, m, t, T, 3072 + jj);
        if (jj < 128) val = 1.f - 2.f * __builtin_amdgcn_rcpf(1.f + __expf(2.f * val));
        LR[idx] = (bf16_t)f2bf(val); }
    bf16_t* RS = (bf16_t*)(a.ws + WS_RS); bf16_t* KS = (bf16_t*)(a.ws + WS_KS); bf16_t* KKS = (bf16_t*)(a.ws + WS_KKS); bf16_t* oV = (bf16_t*)(a.ws + WS_V);
    const int lane = tid & 63, gw = blockIdx.x * NWAVES + (tid >> 6), NGW = G * NWAVES;
    const int hc = (gw & 15) * 64 + lane;
    float m0c[3], m1c[3];
#pragma unroll
    for (int arr = 0; arr < 3; ++arr) { m0c[arr] = mu[arr * 1024 + hc]; m1c[arr] = mu[3328 + arr * 1024 + hc]; }
    const float kkw = a.in[22][hc];
    for (int item = gw; item < NTOK * 16; item += 2 * NGW) {
        unsigned raw[2][3][3]; float pm[2], nm[2]; int mm[2];
#pragma unroll
        for (int u = 0; u < 2; ++u) { const int it2 = item + u * NGW; const int m = it2 < NTOK * 16 ? (it2 >> 4) : (item >> 4); mm[u] = m;
            int t, T, cr; tok_info(m, t, T, cr);
            const int mp = t > 0 ? m - 1 : m, mn = t < T - 1 ? m + 1 : m; pm[u] = t > 0 ? 1.f : 0.f; nm[u] = t < T - 1 ? 1.f : 0.f;
#pragma unroll
            for (int arr = 0; arr < 3; ++arr) { const int col = 5120 + arr * 1024 + hc;
                raw[u][arr][0] = P[(size_t)mp * IN_EVEN + col]; raw[u][arr][1] = P[(size_t)m * IN_EVEN + col]; raw[u][arr][2] = P[(size_t)mn * IN_EVEN + col]; } }
        __builtin_amdgcn_sched_barrier(0);
#pragma unroll
        for (int u = 0; u < 2; ++u) { float x[3];
#pragma unroll
            for (int arr = 0; arr < 3; ++arr) { const float prev = bflo(raw[u][arr][0]) * pm[u], cur = bflo(raw[u][arr][1]), nxt = bflo(raw[u][arr][2]) * nm[u];
                x[arr] = cur + m0c[arr] * (prev - cur) + m1c[arr] * (nxt - cur); }
            const float kkr = x[1] * kkw; const float nrm = wave_sum(kkr * kkr);
            if (item + u * NGW < NTOK * 16) { const size_t o = (size_t)mm[u] * 1024 + hc;
                RS[o] = (bf16_t)f2bf(x[0]); KS[o] = (bf16_t)f2bf(x[1]); KKS[o] = (bf16_t)f2bf(kkr / fmaxf(sqrtf(nrm), 1e-12f)); oV[o] = (bf16_t)f2bf(x[2]); } }
    }
}

typedef short s16x4g __attribute__((ext_vector_type(4)));
template <int PITCH>
__device__ __forceinline__ bf16x8 tr_frag_p(const LAS unsigned char* img, int rowb, int col0, int r16) {
    const LAS unsigned char* p = img + (rowb + (r16 >> 2)) * PITCH + (col0 + 4 * (r16 & 3)) * 2;
    const s16x4g t0 = __builtin_amdgcn_ds_read_tr16_b64_v4i16((LAS s16x4g*)p), t1 = __builtin_amdgcn_ds_read_tr16_b64_v4i16((LAS s16x4g*)(p + 4 * PITCH));
    return (bf16x8){t0[0], t0[1], t0[2], t0[3], t1[0], t1[1], t1[2], t1[3]};
}
constexpr int RW_RECSZ = 29184, RW_WL = 18432;
__device__ __forceinline__ void rwkv_chunk_job(const Args& a, LAS unsigned char* wl, int lane, int gtb, int h) {
    const bf16_t* U4 = (const bf16_t*)(a.ws + WS_U4);
    const bf16_t* RS = (const bf16_t*)(a.ws + WS_RS); const bf16_t* KS = (const bf16_t*)(a.ws + WS_KS); const bf16_t* KKS = (const bf16_t*)(a.ws + WS_KKS); const bf16_t* Vs = (const bf16_t*)(a.ws + WS_V);
    float* oBS = (float*)(a.ws + WS_BS);
    const int m0 = gtb * 32;
    const int hc = h * 64 + lane, q = lane >> 4, r16 = lane & 15;
    LAS unsigned char* X0 = wl; LAS unsigned char* X1 = wl + 4608; LAS unsigned char* X2 = wl + 9216; LAS unsigned char* X3 = wl + 13824;
    const float ka = a.in[23][hc], rk = a.in[24][hc];
    { u32x4 vp[4];
#pragma unroll
      for (int i = 0; i < 4; ++i) { const int p = lane + 64 * i; vp[i] = *(const u32x4*)(Vs + (size_t)(m0 + (p >> 3)) * 1024 + h * 64 + (p & 7) * 8); }
#pragma unroll
      for (int i = 0; i < 4; ++i) { const int p = lane + 64 * i; *(LAS u32x4*)(X0 + (p >> 3) * 144 + (p & 7) * 16) = vp[i]; }
#pragma unroll
      for (int vt = 0; vt < 4; ++vt) { const bf16x8 ff = tr_frag_p<144>(X0, 8 * q, 16 * vt, r16), fr = tr_frag_p<144>(X0, 24 - 8 * q, 16 * vt, r16);
          *(bf16x8*)(a.ws + WS_RWREC + (size_t)((gtb * 16 + h) * 2 + 0) * RW_RECSZ + (24 + vt) * 1024 + lane * 16) = ff;
          *(bf16x8*)(a.ws + WS_RWREC + (size_t)((gtb * 16 + h) * 2 + 1) * RW_RECSZ + (24 + vt) * 1024 + lane * 16) = (bf16x8){fr[7], fr[6], fr[5], fr[4], fr[3], fr[2], fr[1], fr[0]}; } }
#pragma unroll
    for (int dir = 0; dir < 2; ++dir) {
        unsigned char* rec = a.ws + WS_RWREC + (size_t)((gtb * 16 + h) * 2 + dir) * RW_RECSZ;
        const float w0c = a.in[18][dir * 1024 + hc], a0c = a.in[20][dir * 1024 + hc];
        float cum = 0.f;
        unsigned nlw[8], nav[8], nr[8], nk[8], nkk[8];
#define RW_JLOAD(jo_) do { _Pragma("unroll") for (int ji = 0; ji < 8; ++ji) { const int j = 8 * (jo_) + ji; const int t = dir ? 31 - j : j; \
            const bf16_t* up = U4 + (size_t)(m0 + t) * 4096 + dir * 1024 + hc; const size_t o = (size_t)(m0 + t) * 1024 + hc; \
            nlw[ji] = up[0]; nav[ji] = up[2048]; nr[ji] = RS[o]; nk[ji] = KS[o]; nkk[ji] = KKS[o]; } } while (0)
        RW_JLOAD(0);
#pragma unroll 1
        for (int jo = 0; jo < 4; ++jo) {
            float lw8[8], av8[8], r8[8], k8[8], kk8[8], bs8[8];
#pragma unroll
            for (int ji = 0; ji < 8; ++ji) { lw8[ji] = __uint_as_float(nlw[ji] << 16); av8[ji] = __uint_as_float(nav[ji] << 16); r8[ji] = __uint_as_float(nr[ji] << 16); k8[ji] = __uint_as_float(nk[ji] << 16); kk8[ji] = __uint_as_float(nkk[ji] << 16); }
            if (jo < 3) RW_JLOAD(jo + 1);
            __builtin_amdgcn_sched_barrier(0);
#pragma unroll
            for (int ji = 0; ji < 8; ++ji) { const int j = 8 * jo + ji;
                const float lw = -0.60653066f * sigm(w0c + lw8[ji]), av = sigm(a0c + av8[ji]);
                const float cprev = cum; cum += lw;
                const float kka = kk8[ji] * av, kd = k8[ji] * (1.f + (av - 1.f) * ka);
                bs8[ji] = r8[ji] * kd * rk;
                const float ei = __expf(-cum);
                *(LAS unsigned short*)(X0 + j * 144 + lane * 2) = (unsigned short)f2bf(__expf(cprev) * kk8[ji]);
                *(LAS unsigned short*)(X3 + j * 144 + lane * 2) = (unsigned short)f2bf(__expf(cum) * r8[ji]);
                *(LAS unsigned short*)(X1 + j * 144 + lane * 2) = (unsigned short)f2bf(-kka * ei);
                *(LAS unsigned short*)(X2 + j * 144 + lane * 2) = (unsigned short)f2bf(kd * ei); }
#pragma unroll
            for (int ji = 0; ji < 8; ++ji) { const int j = 8 * jo + ji; const int t = dir ? 31 - j : j; const float bs = wave_sum(bs8[ji]);
                if (lane == 0) oBS[(size_t)dir * NTOK * 16 + (size_t)(m0 + t) * 16 + h] = bs; }
        }
#undef RW_JLOAD
        const float wend = __expf(cum);
        *(float*)(rec + 28672 + lane * 4) = wend;
#define RWF(X, rt, ks) (*(const LAS bf16x8*)((X) + (16 * (rt) + r16) * 144 + (32 * (ks) + 8 * q) * 2))
        f32x4 A1[3], A2T[3], B1[3], B2[3];
#pragma unroll
        for (int tl = 0; tl < 3; ++tl) { const int jt = tl > 0 ? 1 : 0, it = tl == 2 ? 1 : 0;
            f32x4 c1 = (f32x4){0.f, 0.f, 0.f, 0.f}, c2 = c1, c3 = c1, c4 = c1;
#pragma unroll
            for (int ks = 0; ks < 2; ++ks) { const bf16x8 kbj = RWF(X0, jt, ks), rbj = RWF(X3, jt, ks), aci = RWF(X1, it, ks), bci = RWF(X2, it, ks);
                c1 = __builtin_amdgcn_mfma_f32_16x16x32_bf16(kbj, aci, c1, 0, 0, 0);
                c2 = __builtin_amdgcn_mfma_f32_16x16x32_bf16(bci, kbj, c2, 0, 0, 0);
                c3 = __builtin_amdgcn_mfma_f32_16x16x32_bf16(rbj, aci, c3, 0, 0, 0);
                c4 = __builtin_amdgcn_mfma_f32_16x16x32_bf16(rbj, bci, c4, 0, 0, 0); }
#pragma unroll
            for (int rr = 0; rr < 4; ++rr) { const int jrow = 16 * jt + 4 * q + rr, icol = 16 * it + r16;
                c1[rr] = (icol < jrow) ? c1[rr] : 0.f; c3[rr] = (icol <= jrow) ? c3[rr] : 0.f; c4[rr] = (icol <= jrow) ? c4[rr] : 0.f;
                const int irow = 16 * it + 4 * q + rr, jcol = 16 * jt + r16;
                c2[rr] = (irow < jcol) ? c2[rr] : 0.f; }
            A1[tl] = c1; A2T[tl] = c2; B1[tl] = c3; B2[tl] = c4; }
#pragma unroll
        for (int jt = 0; jt < 2; ++jt)
#pragma unroll
            for (int ks = 0; ks < 2; ++ks) { *(bf16x8*)(rec + (jt * 2 + ks) * 1024 + lane * 16) = RWF(X0, jt, ks); *(bf16x8*)(rec + (4 + jt * 2 + ks) * 1024 + lane * 16) = RWF(X3, jt, ks); }
#pragma unroll
        for (int kt = 0; kt < 4; ++kt) { const float we = __shfl(wend, 16 * kt + r16);
            const u32x4 ra = __builtin_bit_cast(u32x4, tr_frag_p<144>(X1, 8 * q, 16 * kt, r16)), rb = __builtin_bit_cast(u32x4, tr_frag_p<144>(X2, 8 * q, 16 * kt, r16));
            u32x4 wa, wb;
#pragma unroll
            for (int x = 0; x < 4; ++x) { wa[x] = pk2(bflo(ra[x]) * we, bfhi(ra[x]) * we); wb[x] = pk2(bflo(rb[x]) * we, bfhi(rb[x]) * we); }
            *(u32x4*)(rec + (16 + kt) * 1024 + lane * 16) = wa;
            *(u32x4*)(rec + (20 + kt) * 1024 + lane * 16) = wb; }
#undef RWF
        LAS float* AS = (LAS float*)X0;
#pragma unroll
        for (int tl = 0; tl < 3; ++tl) { const int jt = tl > 0 ? 1 : 0, it = tl == 2 ? 1 : 0;
#pragma unroll
            for (int rr = 0; rr < 4; ++rr) AS[(16 * jt + 4 * q + rr) * 33 + 16 * it + r16] = A1[tl][rr]; }
#pragma unroll
        for (int rr = 0; rr < 4; ++rr) AS[(4 * q + rr) * 33 + 16 + r16] = 0.f;
        { const int col = lane & 31; float Tr[32];
#pragma unroll
          for (int j = 0; j < 32; ++j) { const float rowv = AS[j * 33 + col]; float acc = (col == j) ? 1.f : 0.f;
#pragma unroll
              for (int i = 0; i < j; ++i) acc += __uint_as_float((unsigned)__builtin_amdgcn_readlane((int)__float_as_uint(rowv), i)) * Tr[i];
              Tr[j] = acc;
              if (lane < 32) *(LAS unsigned short*)(X1 + j * 80 + col * 2) = (unsigned short)f2bf(acc); } }
#pragma unroll
        for (int tl = 0; tl < 3; ++tl) { const int it = tl == 2 ? 1 : 0, jt = tl > 0 ? 1 : 0;
#pragma unroll
            for (int rr = 0; rr < 4; ++rr) *(LAS unsigned short*)(X2 + (16 * it + 4 * q + rr) * 80 + (16 * jt + r16) * 2) = (unsigned short)f2bf(A2T[tl][rr]); }
#pragma unroll
        for (int rr = 0; rr < 4; ++rr) *(LAS unsigned short*)(X2 + (16 + 4 * q + rr) * 80 + r16 * 2) = (unsigned short)0;
        { bf16x8 tf[2], af[2];
#pragma unroll
          for (int x = 0; x < 2; ++x) { tf[x] = *(const LAS bf16x8*)(X1 + (16 * x + r16) * 80 + 8 * q * 2); af[x] = *(const LAS bf16x8*)(X2 + (16 * x + r16) * 80 + 8 * q * 2);
              *(bf16x8*)(rec + (8 + x) * 1024 + lane * 16) = tf[x]; }
#pragma unroll
          for (int jt = 0; jt < 2; ++jt)
#pragma unroll
              for (int it = 0; it < 2; ++it) { f32x4 c = (f32x4){0.f, 0.f, 0.f, 0.f}; c = __builtin_amdgcn_mfma_f32_16x16x32_bf16(tf[jt], af[it], c, 0, 0, 0);
#pragma unroll
                  for (int rr = 0; rr < 4; ++rr) *(LAS unsigned short*)(X3 + (16 * jt + 4 * q + rr) * 80 + (16 * it + r16) * 2) = (unsigned short)f2bf(c[rr]); } }
#pragma unroll
        for (int x = 0; x < 2; ++x) *(bf16x8*)(rec + (10 + x) * 1024 + lane * 16) = *(const LAS bf16x8*)(X3 + (16 * x + r16) * 80 + 8 * q * 2);
#pragma unroll
        for (int which = 0; which < 2; ++which) {
#pragma unroll
            for (int tl = 0; tl < 3; ++tl) { const int jt = tl > 0 ? 1 : 0, it = tl == 2 ? 1 : 0;
#pragma unroll
                for (int rr = 0; rr < 4; ++rr) *(LAS unsigned short*)(X3 + (16 * jt + 4 * q + rr) * 80 + (16 * it + r16) * 2) = (unsigned short)f2bf(which ? B2[tl][rr] : B1[tl][rr]); }
#pragma unroll
            for (int rr = 0; rr < 4; ++rr) *(LAS unsigned short*)(X3 + (4 * q + rr) * 80 + (16 + r16) * 2) = (unsigned short)0;
#pragma unroll
            for (int x = 0; x < 2; ++x) *(bf16x8*)(rec + (12 + 2 * which + x) * 1024 + lane * 16) = *(const LAS bf16x8*)(X3 + (16 * x + r16) * 80 + 8 * q * 2);
        }
    }
}
__device__ __forceinline__ void phase_rwkv_chunks(const Args& a, LAS unsigned char* lds, int lane, int wave, int G) {
    const int gw = blockIdx.x * NWAVES + wave, NGW = G * NWAVES;
    for (int job = gw; job < 256 * 16; job += NGW) rwkv_chunk_job(a, lds + wave * RW_WL, lane, job >> 4, job & 15);
}

constexpr int HP_QA = 0, HP_KT = 8704, HP_TOT = 17408;
__device__ __forceinline__ void hgrn_pre_load(const Args& a, int tid, int gtb, int h, int dir, unsigned (&pq)[8], unsigned (&pf)[8]) {
    const bf16_t* P = (const bf16_t*)(a.ws + WS_PROJ);
    const int m0 = gtb * 32, ch = tid & 127, tq = tid >> 7; const int fcol = (dir ? 3072 : 2048) + h * 128 + ch;
#pragma unroll
    for (int i = 0; i < 8; ++i) { const int ii = 8 * tq + i; const int t = dir ? 31 - ii : ii; const bf16_t* row = P + (size_t)(m0 + t) * IN_EVEN; pq[i] = row[h * 128 + ch]; pf[i] = row[fcol]; }
}
__device__ __forceinline__ void hgrn_pre_job(const Args& a, LAS unsigned char* lds, int tid, int gtb, int h, int dir, const unsigned (&pq)[8], const unsigned (&pf)[8]) {
    bf16_t* QA = (bf16_t*)(a.ws + (dir ? WS_HQA1 : WS_HQA0)); bf16_t* KT = (bf16_t*)(a.ws + (dir ? WS_HKT1 : WS_HKT0));
    float* SC = (float*)(a.ws + WS_HSC) + (size_t)(dir * 256 + gtb) * 3072;
    const int m0 = gtb * 32, ch = tid & 127, tq = tid >> 7;
    LAS unsigned char* Qi = lds + HP_QA; LAS unsigned char* Ki = lds + HP_KT; LAS float* tot = (LAS float*)(lds + HP_TOT);
    const float l0 = a.in[15][h * 128 + ch], l1 = a.in[15][1024 + h * 128 + ch];
    const float lb = 1.f / (1.f + __expf(l1 - l0));
    float bl[8], kv[8]; float run = 0.f;
#pragma unroll
    for (int i = 0; i < 8; ++i) { const float f = lb + (1.f - lb) * sigm(bflo(pf[i])); run += __logf(f); bl[i] = run; kv[i] = 1.f - f; }
    tot[tq * 128 + ch] = run;
    __syncthreads();
    { const float t0 = tot[ch], t1 = tot[128 + ch], t2 = tot[256 + ch], t3 = tot[384 + ch];
      const float off = tq == 0 ? 0.f : (tq == 1 ? t0 : (tq == 2 ? t0 + t1 : t0 + t1 + t2));
      const float bmid = t0 + t1, bend = (t0 + t1) + (t2 + t3);
#pragma unroll
      for (int i = 0; i < 8; ++i) { const float b = off + bl[i]; const int s = 8 * tq + i;
          const float ek = __expf(bmid - b), ea = __builtin_amdgcn_rcpf(ek);
          *(LAS unsigned short*)(Qi + s * 272 + ch * 2) = (unsigned short)f2bf(bflo(pq[i]) * ea);
          *(LAS unsigned short*)(Ki + s * 272 + ch * 2) = (unsigned short)f2bf(kv[i] * ek); }
      if (tq == 0) { SC[h * 128 + ch] = __expf(bmid); SC[1024 + h * 128 + ch] = __expf(bend); SC[2048 + h * 128 + ch] = __expf(bend - bmid); } }
    __syncthreads();
    { const int s = tid >> 4, dc = tid & 15; const size_t o = (size_t)(m0 + s) * 1024 + h * 128 + dc * 8;
      *(u32x4*)(QA + o) = *(const LAS u32x4*)(Qi + s * 272 + dc * 16); *(u32x4*)(KT + o) = *(const LAS u32x4*)(Ki + s * 272 + dc * 16); }
    __syncthreads();
}
__device__ __forceinline__ void hgrn_pre_bundle(const Args& a, LAS unsigned char* lds, int tid, int job0) {
    unsigned qA[8], fA[8], qB[8], fB[8];
#define HP_DEC(j) ((j) >> 4), (((j) >> 1) & 7), ((j) & 1)
    hgrn_pre_load(a, tid, HP_DEC(job0), qA, fA);
#pragma unroll 1
    for (int i = 0; i < 16; i += 2) {
        hgrn_pre_load(a, tid, HP_DEC(job0 + i + 1), qB, fB);
        hgrn_pre_job(a, lds, tid, HP_DEC(job0 + i), qA, fA);
        if (i + 2 < 16) hgrn_pre_load(a, tid, HP_DEC(job0 + i + 2), qA, fA);
        hgrn_pre_job(a, lds, tid, HP_DEC(job0 + i + 1), qB, fB);
    }
#undef HP_DEC
}

constexpr int HG_IMG = 0  , HG_ST = 52224, HG_PM = 87040;
typedef short s16x4h __attribute__((ext_vector_type(4)));
__device__ __forceinline__ bf16x8 tr_frag(const LAS unsigned char* img, int row0, int col0, int q, int r16) {
    const LAS unsigned char* p = img + (row0 + 8 * q + (r16 >> 2)) * 272 + (col0 + 4 * (r16 & 3)) * 2;
    const s16x4h t0 = __builtin_amdgcn_ds_read_tr16_b64_v4i16((LAS s16x4h*)p), t1 = __builtin_amdgcn_ds_read_tr16_b64_v4i16((LAS s16x4h*)(p + 4 * 272));
    return (bf16x8){t0[0], t0[1], t0[2], t0[3], t1[0], t1[1], t1[2], t1[3]};
}
__device__ __forceinline__ void hgrn_task(const Args& a, LAS unsigned char* lds, int tid, int seq, int is_sample, int dir, int h, int half) {
    const bf16_t* P = (const bf16_t*)(a.ws + WS_PROJ);
    const bf16_t* QA = (const bf16_t*)(a.ws + (dir ? WS_HQA1 : WS_HQA0)); const bf16_t* KT = (const bf16_t*)(a.ws + (dir ? WS_HKT1 : WS_HKT0));
    const float* SCb = (const float*)(a.ws + WS_HSC) + (size_t)dir * 256 * 3072;
    bf16_t* O = (bf16_t*)(a.ws + (dir ? WS_OB : WS_OF));
    const int T = is_sample ? 2048 : 256, base = is_sample ? 4096 + seq * 2048 : seq * 256, nch = T / 32, gtb0 = base / 32;
    const int cbeg = is_sample ? half * 32 : 0, cend = is_sample ? cbeg + 32 : nch;
    const int lane = tid & 63, w = __builtin_amdgcn_readfirstlane(tid >> 6), q = lane >> 4, r16 = lane & 15;
    LAS unsigned char* St = lds + HG_ST; LAS unsigned char* Pm = lds + HG_PM;
    f32x4 Sacc[8];
    if (is_sample) { const float* s0 = a.in[3] + ((size_t)((seq * 2 + dir) * 8 + h) * 128) * 128;
#pragma unroll
        for (int j = 0; j < 8; ++j)
#pragma unroll
            for (int r = 0; r < 4; ++r) Sacc[j][r] = s0[(size_t)(16 * w + 4 * q + r) * 128 + 16 * j + r16];
    } else {
#pragma unroll
        for (int j = 0; j < 8; ++j) Sacc[j] = (f32x4){0.f, 0.f, 0.f, 0.f};
    }
#define HG_GTB(c) (gtb0 + (dir ? nch - 1 - (c) : (c)))
#define HG_SCAL(dst, c, which) do { const float* sp = SCb + (size_t)HG_GTB(c) * 3072 + (which) * 1024 + h * 128 + 16 * w + 4 * q; const f32x4 v4 = *(const f32x4*)sp; dst[0] = v4.x; dst[1] = v4.y; dst[2] = v4.z; dst[3] = v4.w; } while (0)
#define HG_STORE_ST(scl) do { _Pragma("unroll") for (int j = 0; j < 8; ++j) { u32x2 pk; pk.x = pk2(Sacc[j][0] * scl[0], Sacc[j][1] * scl[1]); pk.y = pk2(Sacc[j][2] * scl[2], Sacc[j][3] * scl[3]); \
        *(LAS u32x2*)(St + (16 * j + r16) * 272 + (16 * w + 4 * q) * 2) = pk; } } while (0)
    const int ps = tid >> 4, pdc = tid & 15;
#define HG_LOADIMG(rq, rk, rv, c) do { const int gb = HG_GTB(c); const size_t o = (size_t)(gb * 32 + ps) * 1024 + h * 128 + pdc * 8; rq = *(const u32x4*)(QA + o); rk = *(const u32x4*)(KT + o); \
        rv = *(const u32x4*)(P + (size_t)(gb * 32 + (dir ? 31 - ps : ps)) * IN_EVEN + 1024 + h * 128 + pdc * 8); } while (0)
#define HG_WRITE(rq, rk, rv, buf) do { LAS unsigned char* ib = lds + HG_IMG + (buf) * 26112 + ps * 272 + pdc * 16; *(LAS u32x4*)ib = rq; *(LAS u32x4*)(ib + 8704) = rk; *(LAS u32x4*)(ib + 17408) = rv; } while (0)
#define HG_BUNDLE(X, c) do { if ((c) < cend) { HG_SCAL(ebe##X, c, 1); HG_SCAL(ecc##X, c, 2); if ((c) + 1 < cend) { HG_SCAL(ebm##X, (c) + 1, 0); HG_LOADIMG(rq##X, rk##X, rv##X, (c) + 1); } } } while (0)
    u32x4 rqA, rkA, rvA, rqB, rkB, rvB; float ebeA[4], eccA[4], ebmA[4], ebeB[4], eccB[4], ebmB[4];
    rqA = rkA = rvA = rqB = rkB = rvB = (u32x4){0u, 0u, 0u, 0u};
#pragma unroll
    for (int r = 0; r < 4; ++r) { ebeA[r] = eccA[r] = ebmA[r] = ebeB[r] = eccB[r] = ebmB[r] = 0.f; }
    if (cbeg > 0) {
#define HG_LOADKV(rk, rv, c) do { const int gb = HG_GTB(c); rk = *(const u32x4*)(KT + (size_t)(gb * 32 + ps) * 1024 + h * 128 + pdc * 8); \
        rv = *(const u32x4*)(P + (size_t)(gb * 32 + (dir ? 31 - ps : ps)) * IN_EVEN + 1024 + h * 128 + pdc * 8); } while (0)
#define HG_WRITEKV(rk, rv, buf) do { LAS unsigned char* ib = lds + HG_IMG + (buf) * 26112 + ps * 272 + pdc * 16; *(LAS u32x4*)(ib + 8704) = rk; *(LAS u32x4*)(ib + 17408) = rv; } while (0)
#define HG_LBUNDLE(X, c) do { if ((c) < cbeg) { HG_SCAL(ebe##X, c, 1); HG_SCAL(ecc##X, c, 2); if ((c) + 1 < cbeg) HG_LOADKV(rk##X, rv##X, (c) + 1); } } while (0)
#define HG_LIGHT(X, c) do { const LAS unsigned char* Ki = lds + HG_IMG + ((c) & 1) * 26112 + 8704; const LAS unsigned char* Vi = Ki + 8704; \
        __syncthreads(); \
        const bf16x8 kta = tr_frag(Ki, 0, 16 * w, q, r16); \
        _Pragma("unroll") for (int j = 0; j < 8; ++j) { const bf16x8 vfj = tr_frag(Vi, 0, 16 * j, q, r16); f32x4 t4 = (f32x4){0.f, 0.f, 0.f, 0.f}; t4 = __builtin_amdgcn_mfma_f32_16x16x32_bf16(kta, vfj, t4, 0, 0, 0); \
            _Pragma("unroll") for (int r = 0; r < 4; ++r) Sacc[j][r] = ebe##X[r] * Sacc[j][r] + ecc##X[r] * t4[r]; } \
        if ((c) + 1 < cbeg) HG_WRITEKV(rk##X, rv##X, ((c) + 1) & 1); \
        HG_LBUNDLE(X, (c) + 2); } while (0)
        { u32x4 k0, v0; HG_LOADKV(k0, v0, 0); HG_WRITEKV(k0, v0, 0); }
        HG_LBUNDLE(A, 0); HG_LBUNDLE(B, 1);
#pragma unroll 1
        for (int c = 0; c < cbeg; c += 2) { HG_LIGHT(A, c); HG_LIGHT(B, c + 1); }
#undef HG_LIGHT
#undef HG_LBUNDLE
#undef HG_WRITEKV
#undef HG_LOADKV
    }
    { float e0[4]; HG_SCAL(e0, cbeg, 0); u32x4 q0, k0, v0; HG_LOADIMG(q0, k0, v0, cbeg); HG_STORE_ST(e0); HG_WRITE(q0, k0, v0, 0); }
    HG_BUNDLE(A, cbeg); HG_BUNDLE(B, cbeg + 1);
#define HG_CHUNK(X, c) do { \
        const LAS unsigned char* Qi = lds + HG_IMG + ((c) & 1) * 26112; const LAS unsigned char* Ki = Qi + 8704; const LAS unsigned char* Vi = Qi + 17408; \
        __syncthreads();                                             \
        if (w < 3) { const int tt = w > 0 ? 1 : 0, ss = w == 2 ? 1 : 0; \
            f32x4 s4 = (f32x4){0.f, 0.f, 0.f, 0.f}; \
            _Pragma("unroll") for (int ks = 0; ks < 4; ++ks) { const bf16x8 af = *(const LAS bf16x8*)(Qi + (16 * tt + r16) * 272 + (32 * ks + 8 * q) * 2); const bf16x8 bf = *(const LAS bf16x8*)(Ki + (16 * ss + r16) * 272 + (32 * ks + 8 * q) * 2); \
                s4 = __builtin_amdgcn_mfma_f32_16x16x32_bf16(af, bf, s4, 0, 0, 0); } \
            _Pragma("unroll") for (int r = 0; r < 4; ++r) { const int trow = 16 * tt + 4 * q + r, scol = 16 * ss + r16; \
                *(LAS unsigned short*)(Pm + trow * 80 + scol * 2) = (unsigned short)((scol <= trow) ? f2bf(s4[r]) : 0u); } \
        } else if (w == 3) { \
            _Pragma("unroll") for (int r = 0; r < 4; ++r) *(LAS unsigned short*)(Pm + (4 * q + r) * 80 + (16 + r16) * 2) = (unsigned short)0; \
        } \
        f32x4 oacc[2]; \
        _Pragma("unroll") for (int tt = 0; tt < 2; ++tt) { oacc[tt] = (f32x4){0.f, 0.f, 0.f, 0.f}; \
            _Pragma("unroll") for (int ks = 0; ks < 4; ++ks) { const bf16x8 af = *(const LAS bf16x8*)(Qi + (16 * tt + r16) * 272 + (32 * ks + 8 * q) * 2); const bf16x8 bf = *(const LAS bf16x8*)(St + (16 * w + r16) * 272 + (32 * ks + 8 * q) * 2); \
                oacc[tt] = __builtin_amdgcn_mfma_f32_16x16x32_bf16(af, bf, oacc[tt], 0, 0, 0); } } \
        bf16x8 vf[8]; \
        _Pragma("unroll") for (int j = 0; j < 8; ++j) vf[j] = tr_frag(Vi, 0, 16 * j, q, r16); \
        const bf16x8 kta = tr_frag(Ki, 0, 16 * w, q, r16); \
        __syncthreads();                                             \
        { const bf16x8 vown = tr_frag(Vi, 0, 16 * w, q, r16);        \
          _Pragma("unroll") for (int tt = 0; tt < 2; ++tt) { const bf16x8 pf_ = *(const LAS bf16x8*)(Pm + (16 * tt + r16) * 80 + q * 16); \
              oacc[tt] = __builtin_amdgcn_mfma_f32_16x16x32_bf16(pf_, vown, oacc[tt], 0, 0, 0); \
              _Pragma("unroll") for (int r = 0; r < 4; ++r) { const int ii = (c) * 32 + 16 * tt + 4 * q + r; const int t = dir ? (T - 1 - ii) : ii; \
                  O[(size_t)(base + t) * 1024 + h * 128 + 16 * w + r16] = (bf16_t)f2bf(oacc[tt][r]); } } } \
        _Pragma("unroll") for (int j = 0; j < 8; ++j) { f32x4 t4 = (f32x4){0.f, 0.f, 0.f, 0.f}; t4 = __builtin_amdgcn_mfma_f32_16x16x32_bf16(kta, vf[j], t4, 0, 0, 0); \
            _Pragma("unroll") for (int r = 0; r < 4; ++r) Sacc[j][r] = ebe##X[r] * Sacc[j][r] + ecc##X[r] * t4[r]; } \
        if ((c) + 1 < cend) { HG_STORE_ST(ebm##X); HG_WRITE(rq##X, rk##X, rv##X, ((c) + 1) & 1); } \
        HG_BUNDLE(X, (c) + 2); \
    } while (0)
    for (int c = cbeg; c < cend; c += 2) { HG_CHUNK(A, c); HG_CHUNK(B, c + 1); }
#undef HG_CHUNK
#undef HG_BUNDLE
#undef HG_LOADIMG
#undef HG_WRITE
#undef HG_SCAL
#undef HG_GTB
#undef HG_STORE_ST
    if (!is_sample) { float* so = a.out + OUT_HGRN + ((size_t)((seq * 2 + dir) * 8 + h) * 128) * 128;
#pragma unroll
        for (int j = 0; j < 8; ++j)
#pragma unroll
            for (int r = 0; r < 4; ++r) so[(size_t)(16 * w + 4 * q + r) * 128 + 16 * j + r16] = Sacc[j][r]; }
    __syncthreads();
}

constexpr int RWS_STAGE = 32768;
template <int nrec>
__device__ __forceinline__ void rwkv_scan_block(const Args& a, LAS unsigned char* lds, int tid, int rid0, int is_sample) {
    const int lane = tid & 63, wave = __builtin_amdgcn_readfirstlane(tid >> 6);
    constexpr int nf = 3 * nrec; const int rsel = nrec == 2 ? wave >> 2 : 0, vt = wave & 3;
    const bool comp = nrec == 2 || wave < 4;
    const int lf0 = nrec == 2 ? vt * 6 : wave * 3;
    const int rid = rid0 + rsel, h = rid & 15, dir = (rid >> 4) & 1, seq = rid >> 5;
    const int T = is_sample ? 2048 : 256, base = is_sample ? 4096 + seq * 2048 : seq * 256;
    const int nblk = T / 32, gtb0 = base / 32;
    const int q = lane >> 4, r16 = lane & 15;
    LAS unsigned char* SA = lds + wave * 4096; LAS unsigned char* UA = SA + 2304;
    LAS unsigned char* stg = lds + RWS_STAGE + rsel * 24576 + lane * 16;
    bf16_t* Y = (bf16_t*)(a.ws + (dir ? WS_YB : WS_YF));
    f32x4 S[4];
    if (is_sample) { const float* sp = a.in[4] + (size_t)((seq * 2 + dir) * 16 + h) * 4096;
#pragma unroll
        for (int kt = 0; kt < 4; ++kt)
#pragma unroll
            for (int r = 0; r < 4; ++r) S[kt][r] = sp[(size_t)(16 * vt + 4 * q + r) * 64 + 16 * kt + r16];
    } else {
#pragma unroll
        for (int kt = 0; kt < 4; ++kt) S[kt] = (f32x4){0.f, 0.f, 0.f, 0.f};
    }
#define RW_REC(c) (a.ws + WS_RWREC + (size_t)(((gtb0 + (dir ? nblk - 1 - (c) : (c))) * 16 + h) * 2 + dir) * RW_RECSZ)
#define RW_FR(rec, f) (*(const bf16x8*)((rec) + (f) * 1024 + lane * 16))
#define RW_LF(buf, f) (*(const LAS bf16x8*)(stg + (buf) * 49152 + (f) * 1024))
#define RW_GLOAD(g, rec) do { _Pragma("unroll") for (int i_ = 0; i_ < 6; ++i_) if (i_ < nf) g[i_] = *(const u32x4*)((rec) + (lf0 + i_) * 1024 + lane * 16); } while (0)
#define RW_GWRITE(g, buf) do { _Pragma("unroll") for (int i_ = 0; i_ < 6; ++i_) if (i_ < nf) *(LAS u32x4*)(stg + (buf) * 49152 + (lf0 + i_) * 1024) = g[i_]; } while (0)
    u32x4 gA[6], gB[6]; bf16x8 VA; float we[4];
#pragma unroll
    for (int i = 0; i < 6; ++i) { gA[i] = (u32x4){0u, 0u, 0u, 0u}; gB[i] = gA[i]; }
    { const unsigned char* rec0 = RW_REC(0); const unsigned char* rec1 = RW_REC(1);
      RW_GLOAD(gB, rec0); RW_GLOAD(gA, rec1);
      VA = RW_FR(rec0, 24 + vt);
#pragma unroll
      for (int x = 0; x < 4; ++x) we[x] = *(const float*)(rec0 + 28672 + (16 * x + r16) * 4);
      RW_GWRITE(gB, 0); }
    __syncthreads();
#define RW_STEP(GX, GY, c) do { \
        const unsigned char* nrec1 = RW_REC((c) + 1 < nblk ? (c) + 1 : nblk - 1); const unsigned char* nrec2 = RW_REC((c) + 2 < nblk ? (c) + 2 : nblk - 1); \
        const bf16x8 VAn = RW_FR(nrec1, 24 + vt); float wen[4]; \
        _Pragma("unroll") for (int x = 0; x < 4; ++x) wen[x] = *(const float*)(nrec1 + 28672 + (16 * x + r16) * 4); \
        RW_GLOAD(GY, nrec2); \
        if (comp) { const int bf_ = (c) & 1; \
            _Pragma("unroll") for (int kt = 0; kt < 4; ++kt) _Pragma("unroll") for (int r = 0; r < 4; ++r) *(LAS unsigned short*)(SA + (4 * q + r) * 144 + (16 * kt + r16) * 2) = (unsigned short)f2bf(S[kt][r]); \
            const bf16x8 sa0 = *(const LAS bf16x8*)(SA + r16 * 144 + (8 * q) * 2), sa1 = *(const LAS bf16x8*)(SA + r16 * 144 + (32 + 8 * q) * 2); \
            f32x4 ut[2], yt[2]; \
            _Pragma("unroll") for (int jt = 0; jt < 2; ++jt) { ut[jt] = (f32x4){0.f, 0.f, 0.f, 0.f}; yt[jt] = ut[jt]; \
                ut[jt] = __builtin_amdgcn_mfma_f32_16x16x32_bf16(sa0, RW_LF(bf_, jt * 2), ut[jt], 0, 0, 0); ut[jt] = __builtin_amdgcn_mfma_f32_16x16x32_bf16(sa1, RW_LF(bf_, jt * 2 + 1), ut[jt], 0, 0, 0); \
                yt[jt] = __builtin_amdgcn_mfma_f32_16x16x32_bf16(sa0, RW_LF(bf_, 4 + jt * 2), yt[jt], 0, 0, 0); yt[jt] = __builtin_amdgcn_mfma_f32_16x16x32_bf16(sa1, RW_LF(bf_, 4 + jt * 2 + 1), yt[jt], 0, 0, 0); } \
            _Pragma("unroll") for (int jt = 0; jt < 2; ++jt) _Pragma("unroll") for (int r = 0; r < 4; ++r) *(LAS unsigned short*)(UA + (4 * q + r) * 80 + (16 * jt + r16) * 2) = (unsigned short)f2bf(ut[jt][r]); \
            const bf16x8 ua0 = *(const LAS bf16x8*)(UA + r16 * 80 + 8 * q * 2); \
            f32x4 u2[2]; \
            _Pragma("unroll") for (int jt = 0; jt < 2; ++jt) { u2[jt] = (f32x4){0.f, 0.f, 0.f, 0.f}; \
                u2[jt] = __builtin_amdgcn_mfma_f32_16x16x32_bf16(ua0, RW_LF(bf_, 8 + jt), u2[jt], 0, 0, 0); u2[jt] = __builtin_amdgcn_mfma_f32_16x16x32_bf16(VA, RW_LF(bf_, 10 + jt), u2[jt], 0, 0, 0); } \
            _Pragma("unroll") for (int jt = 0; jt < 2; ++jt) _Pragma("unroll") for (int r = 0; r < 4; ++r) *(LAS unsigned short*)(UA + (4 * q + r) * 80 + (16 * jt + r16) * 2) = (unsigned short)f2bf(u2[jt][r]); \
            const bf16x8 ua1 = *(const LAS bf16x8*)(UA + r16 * 80 + 8 * q * 2); \
            _Pragma("unroll") for (int jt = 0; jt < 2; ++jt) { yt[jt] = __builtin_amdgcn_mfma_f32_16x16x32_bf16(ua1, RW_LF(bf_, 12 + jt), yt[jt], 0, 0, 0); yt[jt] = __builtin_amdgcn_mfma_f32_16x16x32_bf16(VA, RW_LF(bf_, 14 + jt), yt[jt], 0, 0, 0); } \
            { const int tb = dir ? nblk - 1 - (c) : (c); \
              _Pragma("unroll") for (int jt = 0; jt < 2; ++jt) { const int j = 16 * jt + r16; const int tl = dir ? 31 - j : j; \
                  *(u32x2*)(Y + (size_t)(base + tb * 32 + tl) * 1024 + h * 64 + 16 * vt + 4 * q) = (u32x2){pk2(yt[jt][0], yt[jt][1]), pk2(yt[jt][2], yt[jt][3])}; } } \
            _Pragma("unroll") for (int kt = 0; kt < 4; ++kt) { S[kt] *= we[kt]; \
                S[kt] = __builtin_amdgcn_mfma_f32_16x16x32_bf16(ua1, RW_LF(bf_, 16 + kt), S[kt], 0, 0, 0); S[kt] = __builtin_amdgcn_mfma_f32_16x16x32_bf16(VA, RW_LF(bf_, 20 + kt), S[kt], 0, 0, 0); } \
        } \
        RW_GWRITE(GX, ((c) + 1) & 1); \
        __syncthreads(); \
        VA = VAn; \
        _Pragma("unroll") for (int x = 0; x < 4; ++x) we[x] = wen[x]; \
    } while (0)
    for (int c = 0; c < nblk; c += 2) { RW_STEP(gA, gB, c); RW_STEP(gB, gA, c + 1); }
#undef RW_STEP
#undef RW_GLOAD
#undef RW_GWRITE
#undef RW_LF
#undef RW_REC
#undef RW_FR
    if (!is_sample) { float* so = a.out + OUT_RWKV + (size_t)((seq * 2 + dir) * 16 + h) * 4096;
#pragma unroll
        for (int kt = 0; kt < 4; ++kt)
#pragma unroll
            for (int r = 0; r < 4; ++r) so[(size_t)(16 * vt + 4 * q + r) * 64 + 16 * kt + r16] = S[kt][r]; }
}

__device__ __forceinline__ int queue_pop(unsigned* head, volatile LAS unsigned* slot, int tid) {
    __syncthreads();
    if (tid == 0) slot[0] = __hip_atomic_fetch_add(head, 1u, __ATOMIC_RELAXED, __HIP_MEMORY_SCOPE_AGENT);
    __syncthreads();
    return (int)slot[0];
}

__device__ __forceinline__ void phase_scans_even(const Args& a, LAS unsigned char* lds, int tid, int qoff) {
    unsigned* head = (unsigned*)(a.ws + WS_CTL) + CW_Q0 + qoff;
    volatile LAS unsigned* slot = (volatile LAS unsigned*)(lds + MISC_OFF);
    const int lane = tid & 63, wave = __builtin_amdgcn_readfirstlane(tid >> 6);
    for (;;) {
        int task = queue_pop(head, slot, tid);
        if (task >= 1408) break;
        if (task >= 128 && task < 896) { LAS float* scr = (LAS float*)(lds + wave * 16384); const int r = (task - 128) * 8 + wave;
            if (r < 5120) p0_transpose_item(a.in[27], IN_ODD, 1024, 320, (bf16_t*)(a.ws + WS_WINO), scr, r, lane);
            else p0_transpose_item(a.in[28], 1024, 2048, 32, (bf16_t*)(a.ws + WS_WOUTO), scr, r - 5120, lane);
            continue; }
        const bool is_h = task < 64 || (task >= 896 && task < 1152);
        if (is_h) { const int is_sample = task < 64; const int k = is_sample ? task & 31 : task - 896; hgrn_task(a, lds, tid, k >> 4, is_sample, (k >> 3) & 1, k & 7, 1 - (task >> 5)); }
        else if (task < 128) rwkv_scan_block<1>(a, lds, tid, task - 64, 1);
        else rwkv_scan_block<2>(a, lds, tid, 2 * (task - 1152), 0);
    }
}

__device__ __forceinline__ void phase_combine_even(const Args& a, int lane, int wave, int G) {
    const int gw = blockIdx.x * NWAVES + wave, NGW = G * NWAVES;
    const bf16_t* OF = (const bf16_t*)(a.ws + WS_OF); const bf16_t* OB = (const bf16_t*)(a.ws + WS_OB);
    const bf16_t* YF = (const bf16_t*)(a.ws + WS_YF); const bf16_t* YB = (const bf16_t*)(a.ws + WS_YB);
    const bf16_t* P = (const bf16_t*)(a.ws + WS_PROJ); const bf16_t* V = (const bf16_t*)(a.ws + WS_V); const float* BS = (const float*)(a.ws + WS_BS);
    bf16_t* Yo = (bf16_t*)(a.ws + WS_Y);
    const int c0 = 16 * lane, hh = lane >> 2;
    f32x4 hg4[4], gg4[4], gb4[4];
#pragma unroll
    for (int q = 0; q < 4; ++q) { hg4[q] = *(const f32x4*)(a.in[16] + c0 + 4 * q); gg4[q] = *(const f32x4*)(a.in[25] + c0 + 4 * q); gb4[q] = *(const f32x4*)(a.in[26] + c0 + 4 * q); }
    for (int m = gw; m < NTOK; m += NGW) {
        f32x4 of[4], ob[4], yf[4], yb[4]; u32x4 za[2], zb[2], vv[2], rof[2], rob[2], ryf[2], ryb[2];
#pragma unroll
        for (int x = 0; x < 2; ++x) { rof[x] = *(const u32x4*)(OF + (size_t)m * 1024 + c0 + 8 * x); rob[x] = *(const u32x4*)(OB + (size_t)m * 1024 + c0 + 8 * x);
            ryf[x] = *(const u32x4*)(YF + (size_t)m * 1024 + c0 + 8 * x); ryb[x] = *(const u32x4*)(YB + (size_t)m * 1024 + c0 + 8 * x); }
#pragma unroll
        for (int x = 0; x < 2; ++x) { za[x] = *(const u32x4*)(P + (size_t)m * IN_EVEN + 4096 + c0 + 8 * x); zb[x] = *(const u32x4*)(P + (size_t)m * IN_EVEN + 8448 + c0 + 8 * x); vv[x] = *(const u32x4*)(V + (size_t)m * 1024 + c0 + 8 * x); }
#pragma unroll
        for (int q = 0; q < 4; ++q) { const int x = q >> 1, j = (q & 1) * 2;
            of[q] = (f32x4){bflo(rof[x][j]), bfhi(rof[x][j]), bflo(rof[x][j + 1]), bfhi(rof[x][j + 1])}; ob[q] = (f32x4){bflo(rob[x][j]), bfhi(rob[x][j]), bflo(rob[x][j + 1]), bfhi(rob[x][j + 1])};
            yf[q] = (f32x4){bflo(ryf[x][j]), bfhi(ryf[x][j]), bflo(ryf[x][j + 1]), bfhi(ryf[x][j + 1])}; yb[q] = (f32x4){bflo(ryb[x][j]), bfhi(ryb[x][j]), bflo(ryb[x][j + 1]), bfhi(ryb[x][j + 1])}; }
        const float bon = BS[(size_t)m * 16 + hh] + BS[(size_t)NTOK * 16 + (size_t)m * 16 + hh];
        float ss = 0.f;
#pragma unroll
        for (int q = 0; q < 4; ++q) { of[q] = of[q] + ob[q]; ss += (of[q].x * of[q].x + of[q].y * of[q].y) + (of[q].z * of[q].z + of[q].w * of[q].w); }
        const float rs = rsqrtf(oct_sum(ss) * (1.f / 128.f) + EPS);
        { unsigned w[8];
#pragma unroll
          for (int q = 0; q < 4; ++q) { const unsigned z01 = za[q >> 1][(q & 1) * 2], z23 = za[q >> 1][(q & 1) * 2 + 1]; const f32x4 o = of[q] * rs * hg4[q];
              w[2 * q] = pk2(o.x * silu(bflo(z01)), o.y * silu(bfhi(z01))); w[2 * q + 1] = pk2(o.z * silu(bflo(z23)), o.w * silu(bfhi(z23))); }
          u32x4* dst = (u32x4*)(Yo + (size_t)m * 2048 + c0);
          dst[0] = (u32x4){w[0], w[1], w[2], w[3]}; dst[1] = (u32x4){w[4], w[5], w[6], w[7]}; }
        float sm = 0.f;
#pragma unroll
        for (int q = 0; q < 4; ++q) { yf[q] = yf[q] + yb[q]; sm += (yf[q].x + yf[q].y) + (yf[q].z + yf[q].w); }
        const float mean = quad_sum(sm) * (1.f / 64.f); float sq = 0.f;
#pragma unroll
        for (int q = 0; q < 4; ++q) { yf[q] = yf[q] - mean; sq += (yf[q].x * yf[q].x + yf[q].y * yf[q].y) + (yf[q].z * yf[q].z + yf[q].w * yf[q].w); }
        const float rg = rsqrtf(quad_sum(sq) * (1.f / 64.f) + GN_EPS);
        { unsigned w[8];
#pragma unroll
          for (int q = 0; q < 4; ++q) { const unsigned z01 = zb[q >> 1][(q & 1) * 2], z23 = zb[q >> 1][(q & 1) * 2 + 1], v01 = vv[q >> 1][(q & 1) * 2], v23 = vv[q >> 1][(q & 1) * 2 + 1];
              const f32x4 g = yf[q] * rg * gg4[q] + gb4[q];
              w[2 * q] = pk2((g.x + bon * bflo(v01)) * silu(bflo(z01)), (g.y + bon * bfhi(v01)) * silu(bfhi(z01)));
              w[2 * q + 1] = pk2((g.z + bon * bflo(v23)) * silu(bflo(z23)), (g.w + bon * bfhi(v23)) * silu(bfhi(z23))); }
          u32x4* dst = (u32x4*)(Yo + (size_t)m * 2048 + 1024 + c0);
          dst[0] = (u32x4){w[0], w[1], w[2], w[3]}; dst[1] = (u32x4){w[4], w[5], w[6], w[7]}; }
    }
}

__device__ __forceinline__ void phase_res_modnorm1(const Args& a, int lane, int wave, int G) {
    const int gw = blockIdx.x * NWAVES + wave, NGW = G * NWAVES;
    const float* MOD = (const float*)(a.ws + WS_MOD); const bf16_t* PART = (const bf16_t*)(a.ws + WS_PART); const float* GW = (const float*)(a.ws + WS_GW);
    float* X1 = (float*)(a.ws + WS_X1); bf16_t* XN = (bf16_t*)(a.ws + WS_XN); float* GT = (float*)(a.ws + WS_GT);
    for (int m = gw; m < NTOK; m += NGW) {
        int t, T, cr; tok_info(m, t, T, cr);
        const f32x4* xr = (const f32x4*)x_row(a, m) + lane;
        const u32x2* p0 = (const u32x2*)(PART + (size_t)m * 1024) + lane; const u32x2* p1 = (const u32x2*)(PART + (size_t)NTOK * 1024 + (size_t)m * 1024) + lane;
        const f32x4* gt = (const f32x4*)(MOD + (0 * 3 + cr) * 3072 + 2048) + lane;
        f32x4 v[4], h[4];
#pragma unroll
        for (int j = 0; j < 4; ++j) { { const u32x2 a0 = p0[64 * j], a1 = p1[64 * j]; const f32x4 ps = (f32x4){bflo(a0.x) + bflo(a1.x), bfhi(a0.x) + bfhi(a1.x), bflo(a0.y) + bflo(a1.y), bfhi(a0.y) + bfhi(a1.y)}; v[j] = xr[64 * j] + gt[64 * j] * ps; } ((f32x4*)(X1 + (size_t)m * 1024))[lane + 64 * j] = v[j]; }
        modnorm_store(v, a.in[11] + 1024, MOD + (1 * 3 + cr) * 3072, XN + (size_t)m * DM, lane, h);
        float myg = 0.f;
#pragma unroll
        for (int jg = 0; jg < 16; ++jg) { float d = 0.f;
#pragma unroll
            for (int j = 0; j < 4; ++j) { const f32x4 w4 = *(const f32x4*)(GW + jg * 1024 + 4 * lane + 256 * j); d += (h[j].x * w4.x + h[j].y * w4.y) + (h[j].z * w4.z + h[j].w * w4.w); }
            d = wave_sum(d);
            if (lane == jg) myg = d; }
        if (lane < 16) GT[(size_t)m * 16 + lane] = myg + a.in[31][lane];
    }
}

__device__ __forceinline__ void conv_fma8(float (&acc)[8], const u32x4 x, const f32x4 w0, const f32x4 w1) {
    acc[0] += bflo(x.x) * w0.x; acc[1] += bfhi(x.x) * w0.y; acc[2] += bflo(x.y) * w0.z; acc[3] += bfhi(x.y) * w0.w;
    acc[4] += bflo(x.z) * w1.x; acc[5] += bfhi(x.z) * w1.y; acc[6] += bflo(x.w) * w1.z; acc[7] += bfhi(x.w) * w1.w;
}
__device__ __forceinline__ u32x4 conv_out8(const float (&acc)[8], float sc) {
    u32x4 o; o.x = pk2(silu(acc[0]) * sc, silu(acc[1]) * sc); o.y = pk2(silu(acc[2]) * sc, silu(acc[3]) * sc); o.z = pk2(silu(acc[4]) * sc, silu(acc[5]) * sc); o.w = pk2(silu(acc[6]) * sc, silu(acc[7]) * sc); return o;
}
__device__ __forceinline__ void phase_conv(const Args& a, int tid, int G) {
    const bf16_t* P = (const bf16_t*)(a.ws + WS_PROJ); bf16_t* QKC = (bf16_t*)(a.ws + WS_QKC);
    const float* cw = a.in[29]; const float* cb = a.in[30];
    const int c0 = tid * 8;
    const float sc = c0 >= 2048 ? 0.044194173824159216f : 1.f;
    const f32x4 b0 = *(const f32x4*)(cb + c0), b1 = *(const f32x4*)(cb + c0 + 4);
    const u32x4 zero4 = (u32x4){0u, 0u, 0u, 0u};
    for (int gtb = blockIdx.x; gtb < 256; gtb += G) {
        const int m0 = gtb * 32;
        if (m0 < 4096) {
            f32x4 w0[3], w1[3];
#pragma unroll
            for (int j = 0; j < 3; ++j) { w0[j] = *(const f32x4*)(cw + (size_t)(3 + j) * 4096 + c0); w1[j] = *(const f32x4*)(cw + (size_t)(3 + j) * 4096 + c0 + 4); }
            const int t0 = m0 & 255;
#pragma unroll 1
            for (int s8 = 0; s8 < 4; ++s8) { u32x4 x[10];
#pragma unroll
                for (int i = 0; i < 10; ++i) { const int t = t0 + 8 * s8 + i - 1; x[i] = (t >= 0 && t < 256) ? *(const u32x4*)(P + (size_t)(m0 + 8 * s8 + i - 1) * IN_ODD_MAIN + c0) : zero4; }
                __builtin_amdgcn_sched_barrier(0);
#pragma unroll
                for (int i = 0; i < 8; ++i) { float acc[8] = {b0.x, b0.y, b0.z, b0.w, b1.x, b1.y, b1.z, b1.w};
#pragma unroll
                    for (int j = 0; j < 3; ++j) conv_fma8(acc, x[i + j], w0[j], w1[j]);
                    *(u32x4*)(QKC + (size_t)(m0 + 8 * s8 + i) * 4096 + c0) = conv_out8(acc, sc); } }
        } else {
            f32x4 w0[9], w1[9];
#pragma unroll
            for (int j = 0; j < 9; ++j) { w0[j] = *(const f32x4*)(cw + (size_t)j * 4096 + c0); w1[j] = *(const f32x4*)(cw + (size_t)j * 4096 + c0 + 4); }
            const int tl = (m0 - 4096) & 2047, r = tl >> 6, cw0 = tl & 63;
#pragma unroll 1
            for (int s4 = 0; s4 < 8; ++s4) { u32x4 x[3][6];
#pragma unroll
                for (int i3 = 0; i3 < 3; ++i3)
#pragma unroll
                    for (int i = 0; i < 6; ++i) { const int rr = r + i3 - 1, cc = cw0 + 4 * s4 + i - 1;
                        x[i3][i] = (rr >= 0 && rr < 32 && cc >= 0 && cc < 64) ? *(const u32x4*)(P + (size_t)(m0 + (i3 - 1) * 64 + 4 * s4 + i - 1) * IN_ODD_MAIN + c0) : zero4; }
                __builtin_amdgcn_sched_barrier(0);
#pragma unroll
                for (int i = 0; i < 4; ++i) { float acc[8] = {b0.x, b0.y, b0.z, b0.w, b1.x, b1.y, b1.z, b1.w};
#pragma unroll
                    for (int i3 = 0; i3 < 3; ++i3)
#pragma unroll
                        for (int j = 0; j < 3; ++j) conv_fma8(acc, x[i3][i + j], w0[i3 * 3 + j], w1[i3 * 3 + j]);
                    *(u32x4*)(QKC + (size_t)(m0 + 4 * s4 + i) * 4096 + c0) = conv_out8(acc, sc); } }
        }
    }
}

constexpr int ML_RECSZ = 2560, ML_IMG_OFF = 3072;
__device__ __forceinline__ float logsig(float x) { return fminf(x, 0.f) - log1pf(__expf(-fabsf(x))); }
__device__ __forceinline__ void mlstm_gate_scan(const Args& a, int lane, int rid) {
    const float* GT = (const float*)(a.ws + WS_GT); float* MP = (float*)(a.ws + WS_MP);
    const int is_sample = rid < 16, k = is_sample ? rid : rid - 16, h = k & 3, dir = (k >> 2) & 1, seq = k >> 3;
    const int T = is_sample ? 2048 : 256, base = is_sample ? 4096 + seq * 2048 : seq * 256, nch = T / 32;
    float B = 0.f, Gm = -3.0e38f;
    if (lane < nch) { float gi[32], gf[32];
#pragma unroll
        for (int i = 0; i < 32; ++i) { const int ii = lane * 32 + i; const int t = dir ? (T - 1 - ii) : ii; gi[i] = GT[(size_t)(base + t) * 16 + dir * 4 + h]; gf[i] = GT[(size_t)(base + t) * 16 + (2 + dir) * 4 + h]; }
#pragma unroll
        for (int i = 0; i < 32; ++i) { B += logsig(gf[i]); Gm = fmaxf(Gm, gi[i] - B); } }
    float m = is_sample ? a.in[7][(seq * 2 + dir) * 4 + h] : 0.f;
    for (int c = 0; c < nch; ++c) { const float Bc = __shfl(B, c), Gc = __shfl(Gm, c);
        if (lane == 0) MP[rid * 64 + c] = m;
        m = Bc + fmaxf(m, Gc); }
    if (!is_sample && lane == 0) a.out[OUT_M + (seq * 2 + dir) * 4 + h] = m;
}
__device__ __forceinline__ void mlstm_sp_job(const Args& a, LAS unsigned char* wl, int lane, int gtb, int h) {
    const bf16_t* QKC = (const bf16_t*)(a.ws + WS_QKC); const float* GT = (const float*)(a.ws + WS_GT); const float* MP = (const float*)(a.ws + WS_MP);
    const int m0 = gtb * 32, is_sample = m0 >= 4096;
    const int seq = is_sample ? (m0 - 4096) >> 11 : m0 >> 8, T = is_sample ? 2048 : 256, base = is_sample ? 4096 + seq * 2048 : seq * 256;
    const int tb = (m0 - base) >> 5, nblk = T / 32, q = lane >> 4, r16 = lane & 15;
    LAS unsigned char* PL = wl; LAS float* sc = (LAS float*)(wl + 2560);
    f32x4 S[2][2];
#pragma unroll
    for (int x = 0; x < 2; ++x)
#pragma unroll
        for (int y = 0; y < 2; ++y) S[x][y] = (f32x4){0.f, 0.f, 0.f, 0.f};
#pragma unroll 1
    for (int kg = 0; kg < 4; ++kg) { bf16x8 qf[2][4], kf[2][4];
#pragma unroll
        for (int x = 0; x < 2; ++x)
#pragma unroll
            for (int k4 = 0; k4 < 4; ++k4) { const bf16_t* row = QKC + (size_t)(m0 + 16 * x + r16) * 4096 + h * 512 + 32 * (4 * kg + k4) + 8 * q;
                qf[x][k4] = *(const bf16x8*)row; kf[x][k4] = *(const bf16x8*)(row + 2048); }
        __builtin_amdgcn_sched_barrier(0);
#pragma unroll
        for (int k4 = 0; k4 < 4; ++k4)
#pragma unroll
            for (int x = 0; x < 2; ++x)
#pragma unroll
                for (int y = 0; y < 2; ++y) S[x][y] = __builtin_amdgcn_mfma_f32_16x16x32_bf16(qf[x][k4], kf[y][k4], S[x][y], 0, 0, 0); }
    { unsigned char* fb = a.ws + WS_QKF + (size_t)((gtb * 4 + h) * 64) * 1024 + lane * 16;
      LAS unsigned char* img = wl + ML_IMG_OFF; const int lr = lane >> 3, lp = lane & 7;
      u32x4 rq[4], rk[4], nq[4], nk[4];
#pragma unroll
      for (int i = 0; i < 4; ++i) { const bf16_t* p = QKC + (size_t)(m0 + lr + 8 * i) * 4096 + h * 512 + 8 * lp; rq[i] = *(const u32x4*)p; rk[i] = *(const u32x4*)(p + 2048); }
#pragma unroll 1
      for (int w8 = 0; w8 < 8; ++w8) { const int wn = w8 < 7 ? w8 + 1 : 7;
#pragma unroll
          for (int i = 0; i < 4; ++i) { const bf16_t* p = QKC + (size_t)(m0 + lr + 8 * i) * 4096 + h * 512 + 64 * wn + 8 * lp; nq[i] = *(const u32x4*)p; nk[i] = *(const u32x4*)(p + 2048); }
#pragma unroll
          for (int i = 0; i < 4; ++i) *(LAS u32x4*)(img + (lr + 8 * i) * 272 + lp * 16) = rq[i];
#pragma unroll
          for (int xs = 0; xs < 4; ++xs) { const LAS unsigned char* qp = img + (16 * (xs >> 1) + r16) * 272 + (32 * (xs & 1) + 4 * q) * 2; const u32x2 lo = *(const LAS u32x2*)qp, hi = *(const LAS u32x2*)(qp + 32);
              *(u32x4*)(fb + (w8 * 4 + xs) * 1024) = (u32x4){lo.x, lo.y, hi.x, hi.y}; }
#pragma unroll
          for (int i = 0; i < 4; ++i) *(LAS u32x4*)(img + (lr + 8 * i) * 272 + lp * 16) = rk[i];
#pragma unroll
          for (int dt = 0; dt < 4; ++dt) *(bf16x8*)(fb + (32 + w8 * 4 + dt) * 1024) = tr_frag(img, 0, 16 * dt, q, r16);
#pragma unroll
          for (int i = 0; i < 4; ++i) { rq[i] = nq[i]; rk[i] = nk[i]; } } }
#pragma unroll
    for (int dir = 0; dir < 2; ++dir) {
        const int rid = is_sample ? (seq * 2 + dir) * 4 + h : 16 + (seq * 2 + dir) * 4 + h, c = dir ? nblk - 1 - tb : tb;
        const float m_prev = MP[rid * 64 + c];
        unsigned char* rec = a.ws + WS_MLREC + (size_t)(rid * 64 + c) * ML_RECSZ;
        { const int i = lane & 31, t = dir ? 31 - i : i;
          const float li = GT[(size_t)(m0 + t) * 16 + dir * 4 + h], lf = logsig(GT[(size_t)(m0 + t) * 16 + (2 + dir) * 4 + h]);
          float b = lf;
#pragma unroll
          for (int o = 1; o < 32; o <<= 1) { const float x = __shfl_up(b, o, 32); if (i >= o) b += x; }
          const float g = li - b; float G = g;
#pragma unroll
          for (int o = 1; o < 32; o <<= 1) { const float x = __shfl_up(G, o, 32); if (i >= o) G = fmaxf(G, x); }
          const float M = fmaxf(m_prev, G), Mend = __shfl(M, 31);
          if (lane < 32) { sc[i] = g; sc[32 + i] = M;
              *(float*)(rec + 2048 + i * 4) = __expf(m_prev - M); *(float*)(rec + 2176 + i * 4) = __expf(g - Mend); *(float*)(rec + 2304 + i * 4) = __expf(-(b + M));
              if (lane == 0) *(float*)(rec + 2432) = __expf(m_prev - Mend); } }
#pragma unroll
        for (int x = 0; x < 2; ++x)
#pragma unroll
            for (int y = 0; y < 2; ++y)
#pragma unroll
                for (int r = 0; r < 4; ++r) { const int t = 16 * x + 4 * q + r, s = 16 * y + r16; const int i = dir ? 31 - t : t, j = dir ? 31 - s : s;
                    const float v = (j <= i) ? S[x][y][r] * __expf(sc[j] - sc[32 + i]) : 0.f;
                    *(LAS unsigned short*)(PL + i * 80 + j * 2) = (unsigned short)f2bf(v); }
#pragma unroll
        for (int x = 0; x < 2; ++x) *(bf16x8*)(rec + x * 1024 + lane * 16) = *(const LAS bf16x8*)(PL + (16 * x + r16) * 80 + 8 * q * 2);
    }
}
__device__ __forceinline__ void phase_mlstm_pre(const Args& a, LAS unsigned char* lds, int lane, int wave, int G) {
    const int gw = blockIdx.x * NWAVES + wave, NGW = G * NWAVES;
    for (int job = gw; job < 256 * 4; job += NGW) mlstm_sp_job(a, lds + wave * 12288, lane, job >> 2, job & 3);
}

constexpr int ML_PITCH = 1040;
#ifndef ML_TR
#define ML_TR 1
#endif
typedef short s16x4 __attribute__((ext_vector_type(4)));
constexpr int M2_QS = 0, M2_KS = 33280, M2_PS = 66560, M2_VT = 132096;
template <bool DEN>
__device__ __forceinline__ void mlstm_scan_task(const Args& a, LAS unsigned char* lds, int tid, int seq, int is_sample, int dir, int h, int sl) {
    constexpr int ne = DEN ? 1 : 4;
    const bf16_t* QKC = (const bf16_t*)(a.ws + WS_QKC); const bf16_t* P = (const bf16_t*)(a.ws + WS_PROJ);
    bf16_t* H = (bf16_t*)(a.ws + (dir ? WS_HB : WS_HF)); float* DN = (float*)(a.ws + WS_DEN) + (size_t)dir * NTOK * 4;
    const int T = is_sample ? 2048 : 256, base = is_sample ? 4096 + seq * 2048 : seq * 256, nch = T / 32;
    const int rid = is_sample ? (seq * 2 + dir) * 4 + h : 16 + (seq * 2 + dir) * 4 + h;
    const unsigned char* rec0 = a.ws + WS_MLREC + (size_t)rid * 64 * ML_RECSZ;
    asm volatile("" : "+v"(tid));
    const int lane = tid & 63, w = __builtin_amdgcn_readfirstlane(tid >> 6), tt = w & 1, et = w >> 1, q = lane >> 4, r16 = lane & 15;
    LAS unsigned char* Qs = lds + M2_QS; LAS unsigned char* Ks = lds + M2_KS; LAS unsigned char* PS = lds + M2_PS; LAS unsigned char* VT = lds + M2_VT;
    const size_t sb = (size_t)((seq * 2 + dir) * 4 + h);
    f32x4 Cacc[4][4];
    if (is_sample && !DEN) { const float* src = a.in[5] + (sb * 512) * 512 + sl * 64;
        for (int i = tid; i < 512 * 16; i += NT) { const int d = i >> 4, c4 = i & 15; *(LAS f32x4*)(lds + d * 272 + c4 * 16) = *(const f32x4*)(src + (size_t)d * 512 + 4 * c4); }
        __syncthreads(); }
#pragma unroll
    for (int dt = 0; dt < 4; ++dt)
#pragma unroll
        for (int e = 0; e < 4; ++e)
#pragma unroll
            for (int r = 0; r < 4; ++r) { float v = 0.f;
                if (is_sample) { if (DEN) { if (e == 0) v = (r16 == 0) ? a.in[6][sb * 512 + 64 * w + 16 * dt + 4 * q + r] : 0.f; }
                                 else v = *(const LAS float*)(lds + (64 * w + 16 * dt + 4 * q + r) * 272 + (16 * e + r16) * 4); }
                Cacc[dt][e][r] = v; }
    __syncthreads();
    if (DEN) { for (int i = tid; i < 5120; i += NT) ((LAS unsigned*)VT)[i] = 0u;
        __syncthreads();
        if (tid < 80) *(LAS unsigned short*)(VT + (tid >= 40 ? 10240 : 0) + (tid % 40) * 2) = (unsigned short)0x3F80; }
    u32x4 Qf[4], Kf[4]; u32x4 pv = (u32x4){0u, 0u, 0u, 0u}; float pws = 0.f;
    const unsigned char* fbase = a.ws + WS_QKF + (size_t)h * 65536;
    const int gtb0 = base >> 5;
    const int qlane = dir ? (q * 16 + 15 - r16) : lane, klane = dir ? ((3 - q) * 16 + r16) : lane;
#define M2_FB(c) (fbase + (size_t)(gtb0 + (dir ? nch - 1 - (c) : (c))) * 262144)
#define M2_LOADQ(c) do { const unsigned char* fb_ = M2_FB(c) + (w * 4) * 1024 + qlane * 16; \
        _Pragma("unroll") for (int xs = 0; xs < 4; ++xs) Qf[xs] = *(const u32x4*)(fb_ + (dir ? (xs ^ 2) : xs) * 1024); } while (0)
#define M2_LOADK(c) do { const unsigned char* fb_ = M2_FB(c) + (32 + w * 4) * 1024 + klane * 16; \
        _Pragma("unroll") for (int dt = 0; dt < 4; ++dt) Kf[dt] = *(const u32x4*)(fb_ + dt * 1024); } while (0)
#define M2_LOADV(c) do { const unsigned char* rc_ = rec0 + (size_t)(c) * ML_RECSZ; \
        if (!DEN && tid < 256) { const int j = tid & 31, c16 = tid >> 5; const int ii = (c) * 32 + j; const int t = dir ? (T - 1 - ii) : ii; \
            pv = *(const u32x4*)(P + (size_t)(base + t) * IN_ODD_MAIN + 4096 + h * 512 + sl * 64 + c16 * 8); pws = *(const float*)(rc_ + 2176 + j * 4); } \
        if (DEN && tid < 32) pws = *(const float*)(rc_ + 2176 + tid * 4); } while (0)
#define M2_STOREV(buf) do { LAS unsigned char* vb = VT + (buf) * 10240; \
        if (!DEN && tid < 256) { const int j = tid & 31, c16 = tid >> 5; const unsigned vv[4] = {pv.x, pv.y, pv.z, pv.w}; \
            _Pragma("unroll") for (int i = 0; i < 4; ++i) { const int e0 = c16 * 8 + 2 * i; \
                *(LAS unsigned short*)(vb + e0 * 80 + j * 2) = (unsigned short)(vv[i] & 0xffffu); *(LAS unsigned short*)(vb + (e0 + 1) * 80 + j * 2) = (unsigned short)(vv[i] >> 16); \
                *(LAS unsigned short*)(vb + 5120 + e0 * 80 + j * 2) = (unsigned short)f2bf(bflo(vv[i]) * pws); *(LAS unsigned short*)(vb + 5120 + (e0 + 1) * 80 + j * 2) = (unsigned short)f2bf(bfhi(vv[i]) * pws); } } \
        if (DEN && tid < 32) *(LAS unsigned short*)(vb + 5120 + tid * 2) = (unsigned short)f2bf(pws); } while (0)
    LAS float* wold_s = (LAS float*)(lds + 152576);
    if (tid < nch) wold_s[tid] = *(const float*)(rec0 + (size_t)tid * ML_RECSZ + 2432);
    M2_LOADV(0);
    M2_LOADQ(0); M2_LOADK(0);
    M2_STOREV(0);
    M2_LOADV(1);
    __syncthreads();
    for (int c = 0; c < nch; ++c) {
        const unsigned char* rc = rec0 + (size_t)c * ML_RECSZ;
        const int buf = c & 1, cn = c + 1 < nch ? c + 1 : c;
        LAS unsigned char* PSc = PS + buf * 32768;
        bf16x8 pfrag = (bf16x8){0, 0, 0, 0, 0, 0, 0, 0}; float wp[4] = {0.f, 0.f, 0.f, 0.f}, cl[4] = {0.f, 0.f, 0.f, 0.f};
        if (!DEN || et < ne) { pfrag = *(const bf16x8*)(rc + tt * 1024 + lane * 16);
#pragma unroll
            for (int r = 0; r < 4; ++r) { wp[r] = *(const float*)(rc + 2048 + (16 * tt + 4 * q + r) * 4); if constexpr (DEN) cl[r] = *(const float*)(rc + 2304 + (16 * tt + 4 * q + r) * 4); } }
        const float w_old = wold_s[c];
#pragma unroll
        for (int x = 0; x < 2; ++x) { f32x4 part[4];
#pragma unroll
          for (int e = 0; e < 4; ++e) part[e] = (f32x4){0.f, 0.f, 0.f, 0.f};
#pragma unroll
          for (int s = 0; s < 2; ++s) {
              const u32x4 af = Qf[x * 2 + s];
#pragma unroll
              for (int e = 0; e < 4; ++e) if (e < ne) { u32x4 bfr; bfr.x = pk2(Cacc[2 * s][e][0], Cacc[2 * s][e][1]); bfr.y = pk2(Cacc[2 * s][e][2], Cacc[2 * s][e][3]);
                  bfr.z = pk2(Cacc[2 * s + 1][e][0], Cacc[2 * s + 1][e][1]); bfr.w = pk2(Cacc[2 * s + 1][e][2], Cacc[2 * s + 1][e][3]);
                  part[e] = __builtin_amdgcn_mfma_f32_16x16x32_bf16(__builtin_bit_cast(bf16x8, af), __builtin_bit_cast(bf16x8, bfr), part[e], 0, 0, 0); } }
#pragma unroll
          for (int e = 0; e < 4; ++e) if (e < ne) *(LAS u32x2*)(PSc + ((w * 2 + x) * 4 + e) * 512 + lane * 8) = (u32x2){pk2(part[e][0], part[e][1]), pk2(part[e][2], part[e][3])};
          __builtin_amdgcn_sched_barrier(0); }
        M2_LOADQ(cn);
#pragma unroll
        for (int dt = 0; dt < 4; ++dt)
#pragma unroll
            for (int e = 0; e < 4; ++e) Cacc[dt][e] *= w_old;
        bf16x8 vf = (bf16x8){0, 0, 0, 0, 0, 0, 0, 0};
        if (!DEN || et < ne) vf = *(const LAS bf16x8*)(VT + buf * 10240 + (16 * et + r16) * 80 + q * 16);
        { bf16x8 bfr[4];
#pragma unroll
          for (int e = 0; e < 4; ++e) if (e < ne) bfr[e] = *(const LAS bf16x8*)(VT + buf * 10240 + 5120 + (16 * e + r16) * 80 + q * 16);
#pragma unroll
          for (int dt = 0; dt < 4; ++dt) {
              u32x4 af = Kf[dt];
              if (dir) af = (u32x4){__builtin_amdgcn_alignbit(af.w, af.w, 16), __builtin_amdgcn_alignbit(af.z, af.z, 16), __builtin_amdgcn_alignbit(af.y, af.y, 16), __builtin_amdgcn_alignbit(af.x, af.x, 16)};
#pragma unroll
              for (int e = 0; e < 4; ++e) if (e < ne) Cacc[dt][e] = __builtin_amdgcn_mfma_f32_16x16x32_bf16(__builtin_bit_cast(bf16x8, af), bfr[e], Cacc[dt][e], 0, 0, 0);
              __builtin_amdgcn_sched_barrier(0); } }
        M2_LOADK(cn);
        if (c + 1 < nch) M2_STOREV(buf ^ 1);
        __syncthreads();
        if (!DEN || et < ne) { f32x4 n4 = (f32x4){0.f, 0.f, 0.f, 0.f};
#pragma unroll
            for (int ww = 0; ww < 8; ++ww) { const u32x2 pp = *(const LAS u32x2*)(PSc + ((ww * 2 + tt) * 4 + et) * 512 + lane * 8); n4 += (f32x4){bflo(pp.x), bfhi(pp.x), bflo(pp.y), bfhi(pp.y)}; }
#pragma unroll
            for (int r = 0; r < 4; ++r) n4[r] *= wp[r];
            n4 = __builtin_amdgcn_mfma_f32_16x16x32_bf16(pfrag, vf, n4, 0, 0, 0);
#pragma unroll
            for (int r = 0; r < 4; ++r) { const int ii = c * 32 + 16 * tt + 4 * q + r; const int t = dir ? (T - 1 - ii) : ii;
                if (DEN) { if (r16 == 0) DN[(size_t)(base + t) * 4 + h] = fmaxf(fabsf(n4[r]), cl[r]); }
                else H[(size_t)(base + t) * 2048 + h * 512 + sl * 64 + 16 * et + r16] = (bf16_t)f2bf(n4[r]); } }
        if (c + 2 < nch) M2_LOADV(c + 2);
    }
    __syncthreads();
#undef M2_FB
#undef M2_LOADQ
#undef M2_LOADK
#undef M2_LOADV
#undef M2_STOREV
    if (!is_sample) {
        if (DEN) {
#pragma unroll
            for (int dt = 0; dt < 4; ++dt)
#pragma unroll
                for (int r = 0; r < 4; ++r) if (r16 == 0) a.out[OUT_N + sb * 512 + 64 * w + 16 * dt + 4 * q + r] = Cacc[dt][0][r];
        } else {
#pragma unroll
            for (int dt = 0; dt < 4; ++dt)
#pragma unroll
                for (int e = 0; e < 4; ++e)
#pragma unroll
                    for (int r = 0; r < 4; ++r) *(LAS float*)(lds + (64 * w + 16 * dt + 4 * q + r) * 272 + (16 * e + r16) * 4) = Cacc[dt][e][r];
            __syncthreads();
            float* dst = a.out + OUT_C + (sb * 512) * 512 + sl * 64;
            for (int i = tid; i < 512 * 16; i += NT) { const int d = i >> 4, c4 = i & 15; *(f32x4*)(dst + (size_t)d * 512 + 4 * c4) = *(const LAS f32x4*)(lds + d * 272 + c4 * 16); }
        }
    }
    __syncthreads();
}

__device__ __forceinline__ void phase_scans_odd(const Args& a, LAS unsigned char* lds, int tid, int qoff) {
    const int xg = blockIdx.x & 7;
    unsigned* head = (unsigned*)(a.ws + WS_CTL) + CW_Q1 + qoff + 64 * xg;
    volatile LAS unsigned* slot = (volatile LAS unsigned*)(lds + MISC_OFF);
    for (;;) {
        const int task = queue_pop(head, slot, tid);
        if (task >= 162) break;
        const int rl = task / 9, k9 = task - rl * 9;
        const int is_sample = rl < 2; const int rec = is_sample ? xg * 2 + rl : xg * 16 + (rl - 2);
        const int h = rec & 3, dir = (rec >> 2) & 1, seq = rec >> 3;
        if (k9 == 8) mlstm_scan_task<true>(a, lds, tid, seq, is_sample, dir, h, 0); else mlstm_scan_task<false>(a, lds, tid, seq, is_sample, dir, h, k9);
    }
}

__device__ __forceinline__ void phase_combine_odd(const Args& a, int lane, int wave, int G) {
    const int gw = blockIdx.x * NWAVES + wave, NGW = G * NWAVES;
    const bf16_t* HF = (const bf16_t*)(a.ws + WS_HF); const bf16_t* HB = (const bf16_t*)(a.ws + WS_HB);
    const bf16_t* P = (const bf16_t*)(a.ws + WS_PROJ); bf16_t* Yo = (bf16_t*)(a.ws + WS_Y); const float* DNp = (const float*)(a.ws + WS_DEN);
    const float* ng = a.in[32];
    const int c0 = 32 * lane;
    for (int m = gw; m < NTOK; m += NGW) {
        f32x4 hf[8], hb[8]; u32x4 ov[4], zv[4], rhf[4], rhb[4];
#pragma unroll
        for (int x = 0; x < 4; ++x) { rhf[x] = *(const u32x4*)(HF + (size_t)m * 2048 + c0 + 8 * x); rhb[x] = *(const u32x4*)(HB + (size_t)m * 2048 + c0 + 8 * x); }
#pragma unroll
        for (int x = 0; x < 4; ++x) { ov[x] = *(const u32x4*)(P + (size_t)m * IN_ODD_MAIN + 6144 + c0 + 8 * x); zv[x] = *(const u32x4*)(P + (size_t)m * IN_ODD_MAIN + 8192 + c0 + 8 * x); }
#pragma unroll
        for (int q = 0; q < 8; ++q) { const int x = q >> 1, j = (q & 1) * 2;
            hf[q] = (f32x4){bflo(rhf[x][j]), bfhi(rhf[x][j]), bflo(rhf[x][j + 1]), bfhi(rhf[x][j + 1])}; hb[q] = (f32x4){bflo(rhb[x][j]), bfhi(rhb[x][j]), bflo(rhb[x][j + 1]), bfhi(rhb[x][j + 1])}; }
        const float idf = 1.f / DNp[(size_t)m * 4 + (lane >> 4)], idb = 1.f / DNp[(size_t)NTOK * 4 + (size_t)m * 4 + (lane >> 4)];
        float ss = 0.f;
#pragma unroll
        for (int q = 0; q < 8; ++q) { const unsigned o01 = ov[q >> 1][(q & 1) * 2], o23 = ov[q >> 1][(q & 1) * 2 + 1];
            f32x4 y = hf[q] * idf + hb[q] * idb;
            y.x *= sigm(bflo(o01)); y.y *= sigm(bfhi(o01)); y.z *= sigm(bflo(o23)); y.w *= sigm(bfhi(o23));
            hf[q] = y; ss += (y.x * y.x + y.y * y.y) + (y.z * y.z + y.w * y.w); }
        const float rs = rsqrtf(row16_sum(ss) * (1.f / 512.f) + EPS);
        unsigned w[16];
#pragma unroll
        for (int q = 0; q < 8; ++q) { const unsigned z01 = zv[q >> 1][(q & 1) * 2], z23 = zv[q >> 1][(q & 1) * 2 + 1]; const f32x4 g4 = *(const f32x4*)(ng + c0 + 4 * q); const f32x4 y = hf[q] * rs * g4;
            w[2 * q] = pk2(y.x * silu(bflo(z01)), y.y * silu(bfhi(z01))); w[2 * q + 1] = pk2(y.z * silu(bflo(z23)), y.w * silu(bfhi(z23))); }
        u32x4* dst = (u32x4*)(Yo + (size_t)m * 2048 + c0);
#pragma unroll
        for (int q = 0; q < 4; ++q) dst[q] = (u32x4){w[4 * q], w[4 * q + 1], w[4 * q + 2], w[4 * q + 3]};
    }
}

__device__ __forceinline__ void phase_final(const Args& a, int lane, int wave, int G) {
    const int gw = blockIdx.x * NWAVES + wave, NGW = G * NWAVES;
    const float* MOD = (const float*)(a.ws + WS_MOD); const bf16_t* PART = (const bf16_t*)(a.ws + WS_PART); const float* X1 = (const float*)(a.ws + WS_X1);
    const float* fg = a.in[12];
    for (int m = gw; m < NTOK; m += NGW) {
        int t, T, cr; tok_info(m, t, T, cr);
        const f32x4* xr = (const f32x4*)(X1 + (size_t)m * 1024) + lane;
        const u32x2* p0 = (const u32x2*)(PART + (size_t)m * 1024) + lane; const u32x2* p1 = (const u32x2*)(PART + (size_t)NTOK * 1024 + (size_t)m * 1024) + lane;
        const f32x4* gt = (const f32x4*)(MOD + (1 * 3 + cr) * 3072 + 2048) + lane;
        f32x4 v[4]; float s = 0.f;
#pragma unroll
        for (int j = 0; j < 4; ++j) { { const u32x2 a0 = p0[64 * j], a1 = p1[64 * j]; const f32x4 ps = (f32x4){bflo(a0.x) + bflo(a1.x), bfhi(a0.x) + bfhi(a1.x), bflo(a0.y) + bflo(a1.y), bfhi(a0.y) + bfhi(a1.y)}; v[j] = xr[64 * j] + gt[64 * j] * ps; } s += (v[j].x * v[j].x + v[j].y * v[j].y) + (v[j].z * v[j].z + v[j].w * v[j].w); }
        const float rstd = rsqrtf(wave_sum(s) * (1.f / 1024.f) + EPS);
#pragma unroll
        for (int j = 0; j < 4; ++j) { const f32x4 g4 = *(const f32x4*)(fg + 4 * lane + 256 * j); ((f32x4*)(a.out + OUT_Y + (size_t)m * 1024))[lane + 64 * j] = v[j] * rstd * g4; }
    }
}


#define XB_TMO      128
#define XB_XCNT(j)  (256  + 64 * (j))
#define XB_XSUB(j)  (1280 + 64 * (j))
#define XB_XGEN(j)  (2304 + 64 * (j))
#define XB_TOP      3328
#define XB_TOPGEN   3392
#define XCD_BAR_WORDS 3456
#define XB_SPIN_CAP (1u << 18)
__device__ __forceinline__ unsigned xb_ld(unsigned* p)              { return __hip_atomic_load(p, __ATOMIC_RELAXED, __HIP_MEMORY_SCOPE_AGENT); }
__device__ __forceinline__ unsigned xb_add(unsigned* p, unsigned v) { return __hip_atomic_fetch_add(p, v, __ATOMIC_RELAXED, __HIP_MEMORY_SCOPE_AGENT); }
__device__ __forceinline__ unsigned xb_xcc_id() { return (unsigned)__builtin_amdgcn_s_getreg((3 << 11) | 20) & 0xFu; }
#define XB_SPIN(cond, bar) do { unsigned _sp = 0; while (cond) { __builtin_amdgcn_s_sleep(1); \
    if ((++_sp & 255u) == 0u) { if (xb_ld(&(bar)[XB_TMO])) break; if (_sp > XB_SPIN_CAP) { atomicAdd(&(bar)[XB_TMO], 1u); break; } } } } while (0)
struct XcdBarrier { unsigned* bar; unsigned x; volatile LAS unsigned* st; };
__device__ __forceinline__ XcdBarrier xcd_barrier_post(unsigned* bar, volatile LAS unsigned* st) {
    XcdBarrier b; b.bar = bar; b.x = xb_xcc_id(); b.st = st;
    if (threadIdx.x == 0) (void)xb_add(&bar[XB_XCNT(b.x)], 1u);
    return b;
}
__device__ __forceinline__ void xcd_barrier_complete(unsigned* bar, unsigned x, unsigned& nloc, unsigned& nx) {
    const unsigned G = gridDim.x * gridDim.y * gridDim.z;
    unsigned sum, cnt, mine, sp = 0u;
    for (;;) {
        sum = 0u; cnt = 0u; mine = 0u;
#pragma unroll
        for (unsigned j = 0; j < 16; ++j) { const unsigned c = xb_ld(&bar[XB_XCNT(j)]); sum += c; cnt += (c > 0u) ? 1u : 0u; mine = (j == x) ? c : mine; }
        if (sum == G) break;
        __builtin_amdgcn_s_sleep(1);
        if ((++sp & 255u) == 0u) { if (xb_ld(&bar[XB_TMO])) break; if (sp > XB_SPIN_CAP) { atomicAdd(&bar[XB_TMO], 1u); break; } }
    }
    nloc = mine > 0u ? mine : 1u; nx = cnt > 0u ? cnt : 1u;
}
__device__ __forceinline__ void xcd_barrier(const XcdBarrier& b) {
    asm volatile("s_waitcnt vmcnt(0)" ::: "memory");
    __syncthreads();
    if (threadIdx.x == 0) {
        unsigned* bar = b.bar;
        __builtin_amdgcn_s_waitcnt(0);
        unsigned nloc = b.st[0], nx = b.st[1];
        if (nloc == 0u) { xcd_barrier_complete(bar, b.x, nloc, nx); b.st[0] = nloc; b.st[1] = nx; }
        const unsigned old = xb_add(&bar[XB_XSUB(b.x)], 1u);
        const unsigned gen = old / nloc;
        if (old + 1u == (gen + 1u) * nloc) {
            __builtin_amdgcn_fence(__ATOMIC_RELEASE, "agent");
            asm volatile("s_waitcnt vmcnt(0)" ::: "memory");
            const unsigned og = xb_add(&bar[XB_TOP], 1u);
            const unsigned tg = og / nx;
            if (og + 1u == (tg + 1u) * nx) xb_add(&bar[XB_TOPGEN], 1u);
            else XB_SPIN(xb_ld(&bar[XB_TOPGEN]) == tg, bar);
            __builtin_amdgcn_fence(__ATOMIC_ACQUIRE, "agent");
            xb_add(&bar[XB_XGEN(b.x)], 1u);
            asm volatile("s_waitcnt vmcnt(0)" ::: "memory");
        } else {
            XB_SPIN(xb_ld(&bar[XB_XGEN(b.x)]) == gen, bar);
            __builtin_amdgcn_fence(__ATOMIC_ACQUIRE, "agent");
            asm volatile("s_waitcnt vmcnt(0)" ::: "memory");
        }
    }
    __syncthreads();
}

constexpr int N_PHASES = 17;
#ifndef PROBE_MASK
#define PROBE_MASK 0u
#endif
template <int K>
__device__ __forceinline__ void run_phase(const Args& a, LAS unsigned char* lds, int tid_, int G, int rep) {
    int tid = tid_; asm volatile("" : "+v"(tid)); const int lane = tid & 63, wave = __builtin_amdgcn_readfirstlane(tid >> 6);
    if constexpr (K == 0) phase_prologue(a, lds, tid, lane, wave, G);
    else if constexpr (K == 1) phase_modnorm0(a, lane, wave, G);
    else if constexpr (K == 2) { pg8::Gemm g{(const bf16_t*)(a.ws + WS_XN), (const bf16_t*)(a.ws + WS_WINE), NTOK, IN_EVEN, 1024, 1024}; pg8::StaticOrder S; S.init(NTOK, IN_EVEN, G, (int)blockIdx.x);
        pg8::EpiBf16 E{(bf16_t*)(a.ws + WS_PROJ), IN_EVEN};
        pg8::gemm_phase<pg8::EpiBf16, pg8::StaticOrder, true, true>(lds, g, S, E); }
    else if constexpr (K == 3) phase_rwkv_lr(a, tid, G);
    else if constexpr (K == 4) { pg8::Gemm g{(const bf16_t*)(a.ws + WS_LR), (const bf16_t*)(a.ws + WS_W2B), NTOK, 4096, 128, 256}; pg8::LowRankOrder S; S.S.init(NTOK, 4096, G, (int)blockIdx.x);
        pg8::EpiBf16 E{(bf16_t*)(a.ws + WS_U4), 4096};
        pg8::gemm_phase<pg8::EpiBf16, pg8::LowRankOrder, true, true>(lds, g, S, E); }
    else if constexpr (K == 5) {
        unsigned* head = (unsigned*)(a.ws + WS_CTL) + CW_Q2 + rep * 2048; volatile LAS unsigned* slot = (volatile LAS unsigned*)(lds + MISC_OFF);
        for (;;) { const int task = queue_pop(head, slot, tid); if (task >= 768) break;
            const int grp = task / 3, sub = task - grp * 3;
            if (sub < 2) { const int job = (grp * 2 + sub) * 8 + wave; rwkv_chunk_job(a, lds + wave * RW_WL, lane, job >> 4, job & 15); }
            else hgrn_pre_bundle(a, lds, tid, grp * 16); } }
    else if constexpr (K == 6) phase_scans_even(a, lds, tid, rep * 2048);
    else if constexpr (K == 7) phase_combine_even(a, lane, wave, G);
    else if constexpr (K == 8) { pg8::Gemm g{(const bf16_t*)(a.ws + WS_Y), (const bf16_t*)(a.ws + WS_WOUTE), NTOK, 1024, 1024, 2048}; pg8::SplitKOrder S{G, (int)blockIdx.x};
        pg8::EpiBf16Part E{(bf16_t*)(a.ws + WS_PART), 1024, (size_t)NTOK * 1024};
        pg8::gemm_phase<pg8::EpiBf16Part, pg8::SplitKOrder, false, true>(lds, g, S, E); }
    else if constexpr (K == 9) phase_res_modnorm1(a, lane, wave, G);
    else if constexpr (K == 10) { pg8::Gemm g{(const bf16_t*)(a.ws + WS_XN), (const bf16_t*)(a.ws + WS_WINO), NTOK, IN_ODD_MAIN, 1024, 1024}; pg8::StaticOrder S; S.init(NTOK, IN_ODD_MAIN, G, (int)blockIdx.x);
        pg8::EpiBf16 E{(bf16_t*)(a.ws + WS_PROJ), IN_ODD_MAIN};
        pg8::gemm_phase<pg8::EpiBf16, pg8::StaticOrder, true, true>(lds, g, S, E); }
    else if constexpr (K == 11) { { const int gw = blockIdx.x * NWAVES + wave; if (gw < 144) mlstm_gate_scan(a, lane, gw); } phase_conv(a, tid, G); }
    else if constexpr (K == 12) phase_mlstm_pre(a, lds, lane, wave, G);
    else if constexpr (K == 13) phase_scans_odd(a, lds, tid, rep * 2048);
    else if constexpr (K == 14) phase_combine_odd(a, lane, wave, G);
    else if constexpr (K == 15) { pg8::Gemm g{(const bf16_t*)(a.ws + WS_Y), (const bf16_t*)(a.ws + WS_WOUTO), NTOK, 1024, 1024, 2048}; pg8::SplitKOrder S{G, (int)blockIdx.x};
        pg8::EpiBf16Part E{(bf16_t*)(a.ws + WS_PART), 1024, (size_t)NTOK * 1024};
        pg8::gemm_phase<pg8::EpiBf16Part, pg8::SplitKOrder, false, true>(lds, g, S, E); }
    else if constexpr (K == 16) phase_final(a, lane, wave, G);
}
__global__ void __launch_bounds__(NT, 2) fwd_kernel(Args a) {
    extern __shared__ __attribute__((aligned(16))) unsigned char lds_raw[];
    LAS unsigned char* lds = (LAS unsigned char*)lds_raw;
    const int tid = threadIdx.x, G = gridDim.x;
    const int lo = a.ph_lo, hi = a.ph_hi;
    if (tid < 16) ((volatile LAS unsigned*)(lds + MISC_OFF))[tid] = 0u;
    __syncthreads();
    const XcdBarrier bar = xcd_barrier_post((unsigned*)(a.ws + WS_CTL) + CW_BAR, (volatile LAS unsigned*)(lds + MISC_OFF) + 8);
#define IN(k) (lo <= (k) && (k) < hi)
#define PHASE(k) do { if (IN(k)) { run_phase<k>(a, lds, tid, G, 0); if ((PROBE_MASK >> (k)) & 1u) { xcd_barrier(bar); run_phase<k>(a, lds, tid, G, 1); } } \
        if (IN(k) && IN((k) + 1)) xcd_barrier(bar); } while (0)
    PHASE(0); PHASE(1); PHASE(2); PHASE(3); PHASE(4); PHASE(5); PHASE(6); PHASE(7); PHASE(8); PHASE(9); PHASE(10); PHASE(11); PHASE(12); PHASE(13); PHASE(14); PHASE(15); PHASE(16);
#undef IN
#undef PHASE
}

extern "C" void kernel_launch(void* const* d_in, const int* in_sizes, int n_in,
                              void* d_out, int out_size, void* d_ws, size_t ws_size,
                              hipStream_t stream) {
    static int grid_blocks = 0;
    if (!grid_blocks) {
        int dev = 0, cus = 0, per_cu = 0;
        (void)hipGetDevice(&dev);
        (void)hipDeviceGetAttribute(&cus, hipDeviceAttributeMultiprocessorCount, dev);
        (void)hipFuncSetAttribute((const void*)fwd_kernel, hipFuncAttributeMaxDynamicSharedMemorySize, LDS_BYTES);
        (void)hipOccupancyMaxActiveBlocksPerMultiprocessor(&per_cu, (const void*)fwd_kernel, NT, LDS_BYTES);
        (void)hipGetLastError();
        grid_blocks = cus > 0 ? cus : 256;
        fprintf(stderr, "kernel_launch: cus=%d per_cu=%d grid=%d ws=%zu\n", cus, per_cu, grid_blocks, ws_size);
        if (n_in != 33 || ws_size < WS_END) { fprintf(stderr, "kernel_launch: unexpected n_in %d / ws %zu\n", n_in, ws_size); }
    }
    (void)hipMemsetAsync((char*)d_ws + WS_CTL, 0, CTL_ZERO_BYTES, stream);
    Args a{};
    for (int i = 0; i < 33; ++i) a.in[i] = (const float*)d_in[i];
    a.out = (float*)d_out; a.ws = (unsigned char*)d_ws; a.ph_lo = 0; a.ph_hi = N_PHASES;
    void* args[] = {&a};
    hipError_t e = hipLaunchCooperativeKernel((const void*)fwd_kernel, dim3(grid_blocks), dim3(NT), args, LDS_BYTES, stream);
    if (e != hipSuccess) fprintf(stderr, "cooperative launch failed: %s (grid %d)\n", hipGetErrorString(e), grid_blocks);
}
```

```cpp
#define PROBE_MASK (1u << 16)
#include <hip/hip_runtime.h>
#include <cstdio>
#include <cstdint>

#define LAS __attribute__((address_space(3)))
#define GAS __attribute__((address_space(1)))
typedef unsigned short bf16_t;
typedef short bf16x8 __attribute__((ext_vector_type(8)));
typedef float f32x4 __attribute__((ext_vector_type(4)));
typedef float f32x2 __attribute__((ext_vector_type(2)));
typedef unsigned u32x4 __attribute__((ext_vector_type(4)));
typedef unsigned u32x2 __attribute__((ext_vector_type(2)));

namespace pg8 {
#define PG8_LAS __attribute__((address_space(3)))
constexpr int BM = 256, BK = 64, HALF = 128, HTB = HALF * BK * 2, STAGE_BYTES = 8 * HTB, NXCD = 8, WGM = 8;

__host__ __device__ __forceinline__ int lds_byte(int r, int c) { const int st = (r >> 4) * 2 + (c >> 5), rr = r & 15, cc = c & 31, ob = rr * 64 + cc * 2; return st * 1024 + (ob ^ (((ob >> 9) & 1) << 5)); }
__host__ __device__ __forceinline__ void stage_rc(int b, int& R, int& C) { const int st = b / 1024, sb = b % 1024, swz = sb ^ (((sb >> 9) & 1) << 5); R = (st >> 1) * 16 + swz / 64; C = (st & 1) * 32 + (swz % 64) / 2; }
__host__ __device__ __forceinline__ int perm32(int rho) { const int n = rho >> 4, i = rho & 15; return 8 * (i >> 2) + 4 * n + (i & 3); }

struct Unit { int pm, pn, ks; };
struct Gemm { const bf16_t* A; const bf16_t* Bt; int M, N, K, ld; };

struct StaticOrder {
    int nM, nN, nwg, G, c;
    __host__ __device__ void init(int M, int N, int G_, int c_) { nM = M / BM; nN = N / BM; nwg = nM * nN; G = G_; c = c_; }
    __host__ __device__ bool next(int i, Unit& u) const {
        const long L = (long)i * G + c; if (L >= nwg) return false;
        int wgid = (int)L; { const int q = nwg / NXCD, r = nwg % NXCD, xcd = wgid % NXCD, off = wgid / NXCD; wgid = (xcd < r ? xcd * (q + 1) : r * (q + 1) + (xcd - r) * q) + off; }
        const int nig = WGM * nN, gid = wgid / nig, fm = gid * WGM, gsz = (nM - fm) < WGM ? (nM - fm) : WGM;
        u.pm = fm + ((wgid % nig) % gsz); u.pn = (wgid % nig) / gsz; u.ks = 0; return true;
    }
    __device__ __forceinline__ void a_ready(const Unit&) const {}
    __device__ __forceinline__ void done(const Unit&) const {}
};
struct LowRankOrder { StaticOrder S;
    __host__ __device__ bool next(int i, Unit& u) const { if (!S.next(i, u)) return false; u.ks = u.pn >> 3; return true; }
    __device__ __forceinline__ void a_ready(const Unit&) const {}
    __device__ __forceinline__ void done(const Unit&) const {}
};
struct SplitKOrder {
    int G, c;
    __host__ __device__ bool next(int i, Unit& u) const {
        const long L = (long)i * G + c; if (L >= 256) return false;
        u.pm = (int)(L >> 3); u.pn = (int)((L >> 1) & 3); u.ks = (int)(L & 1); return true;
    }
    __device__ __forceinline__ void a_ready(const Unit&) const {}
    __device__ __forceinline__ void done(const Unit&) const {}
};

__device__ __forceinline__ unsigned cvt_pk_bf16(float lo, float hi) { unsigned r; asm volatile("v_cvt_pk_bf16_f32 %0, %1, %2" : "=v"(r) : "v"(lo), "v"(hi)); return r; }

struct EpiBf16 {
    static constexpr bool PERM = true, AFTER_DRAIN = false;
    bf16_t* O; int ldc;
    __device__ __forceinline__ void operator()(const f32x4 (&acc)[2][2][4][2], const Unit& u, int wr, int wc, int fr, int fq) const {
        const int row0 = u.pm * BM + wr * 64 + fr; const int col0 = u.pn * BM + wc * 32 + 8 * fq;
#pragma unroll
        for (int ai = 0; ai < 2; ++ai)
#pragma unroll
            for (int m = 0; m < 4; ++m) { bf16_t* rowp = O + (size_t)(row0 + ai * HALF + m * 16) * ldc + col0;
#pragma unroll
                for (int bj = 0; bj < 2; ++bj) { const f32x4 v0 = acc[ai][bj][m][0], v1 = acc[ai][bj][m][1];
                    u32x4 w; w.x = cvt_pk_bf16(v0[0], v0[1]); w.y = cvt_pk_bf16(v0[2], v0[3]); w.z = cvt_pk_bf16(v1[0], v1[1]); w.w = cvt_pk_bf16(v1[2], v1[3]);
                    *(u32x4*)(rowp + bj * HALF) = w; } }
    }
};
struct EpiBf16Part {
    static constexpr bool PERM = true, AFTER_DRAIN = false;
    bf16_t* O; int ldc; size_t part_stride;
    __device__ __forceinline__ void operator()(const f32x4 (&acc)[2][2][4][2], const Unit& u, int wr, int wc, int fr, int fq) const {
        const int row0 = u.pm * BM + wr * 64 + fr; const int col0 = u.pn * BM + wc * 32 + 8 * fq;
        bf16_t* base = O + (size_t)u.ks * part_stride;
#pragma unroll
        for (int ai = 0; ai < 2; ++ai)
#pragma unroll
            for (int m = 0; m < 4; ++m) { bf16_t* rowp = base + (size_t)(row0 + ai * HALF + m * 16) * ldc + col0;
#pragma unroll
                for (int bj = 0; bj < 2; ++bj) { const f32x4 v0 = acc[ai][bj][m][0], v1 = acc[ai][bj][m][1];
                    u32x4 w; w.x = cvt_pk_bf16(v0[0], v0[1]); w.y = cvt_pk_bf16(v0[2], v0[3]); w.z = cvt_pk_bf16(v1[0], v1[1]); w.w = cvt_pk_bf16(v1[2], v1[3]);
                    *(u32x4*)(rowp + bj * HALF) = w; } }
    }
};
struct EpiF32Part {
    static constexpr bool PERM = false, AFTER_DRAIN = false;
    float* P; int ldc; size_t part_stride;
    __device__ __forceinline__ void operator()(const f32x4 (&acc)[2][2][4][2], const Unit& u, int wr, int wc, int fr, int fq) const {
        const int row0 = u.pm * BM + wr * 64 + fr; const int col0 = u.pn * BM + wc * 32 + 4 * fq;
        float* base = P + (size_t)u.ks * part_stride;
#pragma unroll
        for (int ai = 0; ai < 2; ++ai)
#pragma unroll
            for (int m = 0; m < 4; ++m) { float* rowp = base + (size_t)(row0 + ai * HALF + m * 16) * ldc + col0;
#pragma unroll
                for (int bj = 0; bj < 2; ++bj)
#pragma unroll
                    for (int n = 0; n < 2; ++n) *(f32x4*)(rowp + bj * HALF + n * 16) = acc[ai][bj][m][n]; }
    }
};

template <class Epi, class Sched, bool ALIGN_EPI = false, bool SP2 = false>
__device__ __forceinline__ void gemm_phase(PG8_LAS unsigned char* lds, const Gemm g, const Sched& S, const Epi& E) {
    const int tid = threadIdx.x, wid = __builtin_amdgcn_readfirstlane(tid >> 6), lane = tid & 63, wr = wid >> 2, wc = wid & 3, fr = lane & 15, fq = lane >> 4;
    const int K = g.K, nt = K / BK, LD = g.ld;
    unsigned voffA[2], voffB[2];
#pragma unroll
    for (int i = 0; i < 2; ++i) { int R, C; stage_rc(tid * 16 + i * 8192, R, C); const int Rb = Epi::PERM ? ((R & ~31) + perm32(R & 31)) : R;
        voffA[i] = (unsigned)(R * LD + C) * 2u; voffB[i] = (unsigned)(Rb * LD + C) * 2u; }
    const size_t kstep = (size_t)(BK * 2);
    const size_t hstep = (size_t)HALF * LD * 2;
    const size_t tstep = 2 * hstep;
    const size_t sstep = (size_t)K * 2;
    const unsigned ldsw = (unsigned)wid * 1024u;
    const int aoff = lds_byte(wr * 64 + fr, fq * 8), boff = lds_byte(wc * 32 + fr, fq * 8);
#define PG8_SA(b, h) (((b) * 2 + (h)) * HTB)
#define PG8_SB(b, h) ((4 + (b) * 2 + (h)) * HTB)
#define PG8_STAGE(bufoff, gbase, voff) do { _Pragma("unroll") for (int _i = 0; _i < 2; ++_i) \
        __builtin_amdgcn_global_load_lds((const unsigned*)((const char*)(gbase) + (voff)[_i]), (PG8_LAS unsigned*)(lds + (bufoff) + ldsw + _i * 8192), 16, 0, 0); } while (0)
#define PG8_LDA(dst, b, h) do { _Pragma("unroll") for (int m = 0; m < 4; ++m) _Pragma("unroll") for (int k = 0; k < 2; ++k) dst[m][k] = *(const PG8_LAS bf16x8*)(lds + PG8_SA(b, h) + aoff + m * 2048 + k * 1024); } while (0)
#define PG8_LDB(dst, b, h) do { _Pragma("unroll") for (int n = 0; n < 2; ++n) _Pragma("unroll") for (int k = 0; k < 2; ++k) dst[n][k] = *(const PG8_LAS bf16x8*)(lds + PG8_SB(b, h) + boff + n * 2048 + k * 1024); } while (0)
#define PG8_MMA(ai, bj, At, Bt) do { __builtin_amdgcn_s_setprio(1); _Pragma("unroll") for (int m = 0; m < 4; ++m) _Pragma("unroll") for (int n = 0; n < 2; ++n) _Pragma("unroll") for (int k = 0; k < 2; ++k) \
        acc[ai][bj][m][n] = __builtin_amdgcn_mfma_f32_16x16x32_bf16(Bt[n][k], At[m][k], acc[ai][bj][m][n], 0, 0, 0); __builtin_amdgcn_s_setprio(0); } while (0)
#define PG8_WAIT_V(n) asm volatile("s_waitcnt vmcnt(" #n ")" ::: "memory")
#define PG8_WAIT_L(n) asm volatile("s_waitcnt lgkmcnt(" #n ")" ::: "memory")
#define PG8_BAR __builtin_amdgcn_s_barrier()
#define PG8_SCHED __builtin_amdgcn_sched_barrier(0)
    Unit cur, nxt; int ui = 0;
    if (!S.next(0, cur)) return;
    f32x4 acc[2][2][4][2];
#pragma unroll
    for (int a = 0; a < 2; ++a)
#pragma unroll
        for (int b = 0; b < 2; ++b)
#pragma unroll
            for (int m = 0; m < 4; ++m)
#pragma unroll
                for (int n = 0; n < 2; ++n) acc[a][b][m][n] = (f32x4){0.f, 0.f, 0.f, 0.f};
    bf16x8 At[4][2], B0[2][2], B1[2][2];
    const char* cA = (const char*)g.A + (size_t)cur.pm * tstep + (size_t)cur.ks * sstep; const char* cB = (const char*)g.Bt + (size_t)cur.pn * tstep + (size_t)cur.ks * sstep;
    S.a_ready(cur);
    if constexpr (SP2) {
        PG8_STAGE(PG8_SB(0, 0), cB, voffB); PG8_STAGE(PG8_SB(0, 1), cB + hstep, voffB); PG8_STAGE(PG8_SA(0, 0), cA, voffA); PG8_STAGE(PG8_SA(0, 1), cA + hstep, voffA);
        if (wr == 1) PG8_BAR;
        PG8_WAIT_V(2); PG8_BAR;
        PG8_STAGE(PG8_SB(1, 0), cB + kstep, voffB); PG8_STAGE(PG8_SA(1, 0), cA + kstep, voffA); PG8_STAGE(PG8_SB(1, 1), cB + hstep + kstep, voffB);
        PG8_WAIT_V(6); PG8_BAR;
    } else {
        PG8_STAGE(PG8_SB(0, 0), cB, voffB); PG8_STAGE(PG8_SA(0, 0), cA, voffA); PG8_STAGE(PG8_SB(0, 1), cB + hstep, voffB); PG8_STAGE(PG8_SA(0, 1), cA + hstep, voffA);
        if (wr == 1) PG8_BAR;
        PG8_WAIT_V(4); PG8_BAR;
        PG8_STAGE(PG8_SB(1, 0), cB + kstep, voffB); PG8_STAGE(PG8_SA(1, 0), cA + kstep, voffA); PG8_STAGE(PG8_SB(1, 1), cB + hstep + kstep, voffB);
        PG8_WAIT_V(6); PG8_BAR;
    }
    for (;;) {
        const bool has_next = S.next(ui + 1, nxt);
        const char* nA = has_next ? (const char*)g.A + (size_t)nxt.pm * tstep + (size_t)nxt.ks * sstep : cA; const char* nB = has_next ? (const char*)g.Bt + (size_t)nxt.pn * tstep + (size_t)nxt.ks * sstep : cB;
        for (int t = 0; t < nt; t += 2) {
            const bool last = (t == nt - 2);
            const char* a1 = cA + (size_t)(t + 1) * kstep;
            const char* a2 = last ? nA : cA + (size_t)(t + 2) * kstep; const char* b2 = last ? nB : cB + (size_t)(t + 2) * kstep;
            const char* a3 = a2 + kstep; const char* b3 = b2 + kstep;
            if (last && has_next) S.a_ready(nxt);
            if constexpr (SP2) {
            PG8_LDB(B0, 0, 0); PG8_LDB(B1, 0, 1); PG8_SCHED; PG8_LDA(At, 0, 0); PG8_STAGE(PG8_SA(1, 1), a1 + hstep, voffA);
            PG8_WAIT_V(8); PG8_WAIT_L(0); PG8_BAR; PG8_MMA(0, 0, At, B0); PG8_MMA(0, 1, At, B1); PG8_BAR; PG8_SCHED;
            PG8_LDA(At, 0, 1); PG8_STAGE(PG8_SB(0, 0), b2, voffB); PG8_STAGE(PG8_SB(0, 1), b2 + hstep, voffB); PG8_STAGE(PG8_SA(0, 0), a2, voffA);
            PG8_WAIT_V(8); PG8_WAIT_L(0); PG8_BAR; PG8_MMA(1, 0, At, B0); PG8_MMA(1, 1, At, B1); PG8_BAR; PG8_SCHED;
            PG8_LDB(B0, 1, 0); PG8_LDB(B1, 1, 1); PG8_SCHED; PG8_LDA(At, 1, 0); PG8_STAGE(PG8_SA(0, 1), a2 + hstep, voffA);
            PG8_WAIT_V(8); PG8_WAIT_L(0); PG8_BAR; PG8_MMA(0, 0, At, B0); PG8_MMA(0, 1, At, B1); PG8_BAR; PG8_SCHED;
            PG8_LDA(At, 1, 1); PG8_STAGE(PG8_SB(1, 0), b3, voffB); PG8_STAGE(PG8_SB(1, 1), b3 + hstep, voffB); PG8_STAGE(PG8_SA(1, 0), a3, voffA);
            PG8_WAIT_V(8); PG8_WAIT_L(0); PG8_BAR; PG8_MMA(1, 0, At, B0); PG8_MMA(1, 1, At, B1); PG8_BAR; PG8_SCHED;
            } else {
            PG8_LDB(B0, 0, 0); PG8_SCHED; PG8_LDA(At, 0, 0); PG8_STAGE(PG8_SA(1, 1), a1 + hstep, voffA);
            PG8_WAIT_L(8); PG8_BAR; PG8_WAIT_L(0); PG8_MMA(0, 0, At, B0); PG8_BAR; PG8_SCHED;
            PG8_LDB(B1, 0, 1); PG8_STAGE(PG8_SB(0, 0), b2, voffB);
            PG8_BAR; PG8_WAIT_L(0); PG8_MMA(0, 1, At, B1); PG8_BAR;
            PG8_LDA(At, 0, 1); PG8_STAGE(PG8_SA(0, 0), a2, voffA);
            PG8_BAR; PG8_WAIT_L(0); PG8_MMA(1, 0, At, B0); PG8_BAR; PG8_SCHED;
            PG8_STAGE(PG8_SB(0, 1), b2 + hstep, voffB);
            PG8_WAIT_V(6); PG8_BAR; PG8_MMA(1, 1, At, B1); PG8_BAR;
            PG8_LDB(B0, 1, 0); PG8_SCHED; PG8_LDA(At, 1, 0); PG8_STAGE(PG8_SA(0, 1), a2 + hstep, voffA);
            PG8_WAIT_L(8); PG8_BAR; PG8_WAIT_L(0); PG8_MMA(0, 0, At, B0); PG8_BAR; PG8_SCHED;
            PG8_LDB(B1, 1, 1); PG8_STAGE(PG8_SB(1, 0), b3, voffB);
            PG8_BAR; PG8_WAIT_L(0); PG8_MMA(0, 1, At, B1); PG8_BAR;
            PG8_LDA(At, 1, 1); PG8_STAGE(PG8_SA(1, 0), a3, voffA);
            PG8_BAR; PG8_WAIT_L(0); PG8_MMA(1, 0, At, B0); PG8_BAR; PG8_SCHED;
            PG8_STAGE(PG8_SB(1, 1), b3 + hstep, voffB);
            PG8_WAIT_V(6); PG8_BAR; PG8_MMA(1, 1, At, B1); PG8_BAR;
            }
        }
        if constexpr (ALIGN_EPI) { if (wr == 0) PG8_BAR; }
        if constexpr (!Epi::AFTER_DRAIN) { E(acc, cur, wr, wc, fr, fq); S.done(cur); }
        if (!has_next) break;
#pragma unroll
        for (int a = 0; a < 2; ++a)
#pragma unroll
            for (int b = 0; b < 2; ++b)
#pragma unroll
                for (int m = 0; m < 4; ++m)
#pragma unroll
                    for (int n = 0; n < 2; ++n) acc[a][b][m][n] = (f32x4){0.f, 0.f, 0.f, 0.f};
        cur = nxt; cA = nA; cB = nB; ++ui;
        if constexpr (ALIGN_EPI) { if (wr == 1) PG8_BAR; }
    }
    PG8_WAIT_V(0);
    if constexpr (!ALIGN_EPI) { if (wr == 0) PG8_BAR; }
    PG8_BAR;
#undef PG8_SA
#undef PG8_SB
#undef PG8_STAGE
#undef PG8_LDA
#undef PG8_LDB
#undef PG8_MMA
#undef PG8_WAIT_V
#undef PG8_WAIT_L
#undef PG8_BAR
#undef PG8_SCHED
}
}

constexpr int NT = 512, NWAVES = 8;
constexpr int LDS_BYTES = 159744;
constexpr int MISC_OFF = 155648;
constexpr int NTOK = 8192, DM = 1024;
constexpr int IN_EVEN = 9472, IN_ODD = 10256, IN_ODD_MAIN = 10240;
constexpr float EPS = 1e-6f, GN_EPS = 64e-5f;
constexpr size_t OUT_Y = 0, OUT_HGRN = 8388608, OUT_RWKV = 12582912, OUT_C = 14680064, OUT_N = 48234496, OUT_M = 48300032;
constexpr size_t MiB = 1u << 20;
constexpr size_t WS_CTL = 0, CTL_ZERO_BYTES = 64 * 1024;
constexpr size_t WS_MOD = 1 * MiB;
constexpr size_t WS_GW = 1 * MiB + 512 * 1024;
constexpr size_t WS_GATES = 1 * MiB + 768 * 1024;
constexpr size_t WS_WINE = 4 * MiB;
constexpr size_t WS_WOUTE = 24 * MiB;
constexpr size_t WS_WINO = 28 * MiB;
constexpr size_t WS_WOUTO = 48 * MiB;
constexpr size_t WS_XN = 52 * MiB;
constexpr size_t WS_X1 = 68 * MiB;
constexpr size_t WS_PROJ = 100 * MiB;
constexpr size_t WS_OF = 260 * MiB, WS_OB = 292 * MiB;
constexpr size_t WS_QKC = 260 * MiB;
constexpr size_t WS_YF = 324 * MiB, WS_YB = 356 * MiB;
constexpr size_t WS_HF = 324 * MiB, WS_HB = 388 * MiB;
constexpr size_t WS_U4 = 260 * MiB;
constexpr size_t WS_RS = 324 * MiB, WS_KS = 340 * MiB, WS_KKS = 356 * MiB;
constexpr size_t WS_RWREC = 388 * MiB;
constexpr size_t WS_Y = 564 * MiB;
constexpr size_t WS_PART = 596 * MiB;
constexpr size_t WS_BS = 660 * MiB;
constexpr size_t WS_GT = 662 * MiB;
constexpr size_t WS_DEN = 662 * MiB + 512 * 1024;
constexpr size_t WS_V = 664 * MiB;
constexpr size_t WS_LR = 680 * MiB;
constexpr size_t WS_W2B = 684 * MiB;
constexpr size_t WS_HQA0 = 52 * MiB, WS_HKT0 = 68 * MiB, WS_HQA1 = 84 * MiB, WS_HKT1 = 616 * MiB;
constexpr size_t WS_HSC = 632 * MiB;
constexpr size_t WS_MP = 686 * MiB;
constexpr size_t WS_MLREC = 596 * MiB;
constexpr size_t WS_QKF = 420 * MiB;
constexpr size_t WS_END = 687 * MiB;
constexpr int CW_Q0 = 64, CW_Q2 = 192, CW_Q1 = 1024, CW_BAR = 4096;

struct Args { const float* in[33]; float* out; unsigned char* ws; int ph_lo, ph_hi; };

__device__ __forceinline__ float bf2f(unsigned short u) { return __uint_as_float((unsigned)u << 16); }
typedef __bf16 bf16x2_t __attribute__((ext_vector_type(2)));
__device__ __forceinline__ unsigned pk2(float lo, float hi) { const f32x2 v = {lo, hi}; const bf16x2_t b = __builtin_convertvector(v, bf16x2_t); return __builtin_bit_cast(unsigned, b); }
__device__ __forceinline__ unsigned f2bf(float f) { return (unsigned)__builtin_bit_cast(unsigned short, (__bf16)f); }
__device__ __forceinline__ float sigm(float x) { return __builtin_amdgcn_rcpf(1.f + __expf(-x)); }
__device__ __forceinline__ float silu(float x) { return x * __builtin_amdgcn_rcpf(1.f + __expf(-x)); }
__device__ __forceinline__ void tok_info(int m, int& t, int& T, int& cr) {
    if (m < 4096) { t = m & 255; T = 256; cr = 0; } else { const int mm = m - 4096; t = mm & 2047; T = 2048; cr = 1 + (mm >> 11); }
}
__device__ __forceinline__ const float* x_row(const Args& a, int m) { return m < 4096 ? a.in[0] + (size_t)m * DM : a.in[1] + (size_t)(m - 4096) * DM; }
template <int CTRL> __device__ __forceinline__ float dpp_mov(float v) { return __uint_as_float((unsigned)__builtin_amdgcn_update_dpp(0, (int)__float_as_uint(v), CTRL, 0xF, 0xF, false)); }
__device__ __forceinline__ float row16_sum(float v) {
    v += dpp_mov<0xB1>(v);
    v += dpp_mov<0x4E>(v);
    v += dpp_mov<0x141>(v);
    v += dpp_mov<0x140>(v);
    return v;
}
__device__ __forceinline__ float bflo(unsigned u) { return __uint_as_float(u << 16); }
__device__ __forceinline__ float bfhi(unsigned u) { return __uint_as_float(u & 0xffff0000u); }
__device__ __forceinline__ float quad_sum(float v) { v += dpp_mov<0xB1>(v); v += dpp_mov<0x4E>(v); return v; }
__device__ __forceinline__ float oct_sum(float v) { v = quad_sum(v); v += dpp_mov<0x141>(v); return v; }
__device__ __forceinline__ float wave_sum(float v) {
    v = row16_sum(v);
    const int vi = (int)__float_as_uint(v);
    const float s0 = __uint_as_float((unsigned)__builtin_amdgcn_readlane(vi, 0)), s1 = __uint_as_float((unsigned)__builtin_amdgcn_readlane(vi, 16));
    const float s2 = __uint_as_float((unsigned)__builtin_amdgcn_readlane(vi, 32)), s3 = __uint_as_float((unsigned)__builtin_amdgcn_readlane(vi, 48));
    return (s0 + s1) + (s2 + s3);
}

__device__ __forceinline__ void p0_transpose_item(const float* W, int ldw, int K, int nblk, bf16_t* WT, LAS float* scr, int item, int lane) {
    const int kb = item / nblk, nb = item % nblk, k0 = 64 * kb, n0 = 32 * nb;
    f32x4 v[8];
#pragma unroll
    for (int i = 0; i < 8; ++i) v[i] = *(const f32x4*)(W + (size_t)(k0 + 8 * i + (lane >> 3)) * ldw + n0 + 4 * (lane & 7));
    __builtin_amdgcn_sched_barrier(0);
#pragma unroll
    for (int i = 0; i < 8; ++i) { LAS float* d = scr + (8 * i + (lane >> 3)) * 33 + 4 * (lane & 7); d[0] = v[i].x; d[1] = v[i].y; d[2] = v[i].z; d[3] = v[i].w; }
    asm volatile("s_waitcnt lgkmcnt(0)" ::: "memory");
    const int c = lane & 7;
#pragma unroll
    for (int j = 0; j < 4; ++j) { const int n = (lane >> 3) + 8 * j; const LAS float* s = scr + (8 * c) * 33 + n;
        u32x4 o; o.x = pk2(s[0 * 33], s[1 * 33]); o.y = pk2(s[2 * 33], s[3 * 33]); o.z = pk2(s[4 * 33], s[5 * 33]); o.w = pk2(s[6 * 33], s[7 * 33]);
        *(u32x4*)(WT + (size_t)(n0 + n) * K + k0 + 8 * c) = o; }
    asm volatile("s_waitcnt lgkmcnt(0)" ::: "memory");
}

__device__ __forceinline__ void phase_prologue(const Args& a, LAS unsigned char* lds, int tid, int lane, int wave, int G) {
    unsigned char* ws = a.ws;
    if ((int)blockIdx.x < 96) {
        const int item = blockIdx.x, layer = item / 48, g = item % 48, col = g * 64 + lane;
        const float* wm = a.in[9] + (size_t)layer * 1024 * 3072;
        const float* cctx = a.in[8]; const float* cc = a.in[2];
        float a0 = 0.f, a1 = 0.f, a2 = 0.f;
        const int k0 = wave * 128;
        float sv[3][2];
#pragma unroll
        for (int hh = 0; hh < 2; ++hh) { sv[0][hh] = silu(cctx[k0 + 64 * hh + lane]); sv[1][hh] = silu(cc[k0 + 64 * hh + lane]); sv[2][hh] = silu(cc[1024 + k0 + 64 * hh + lane]); }
#pragma unroll
        for (int kb = 0; kb < 128; kb += 32) { float wv[32];
#pragma unroll
            for (int i = 0; i < 32; ++i) wv[i] = wm[(size_t)(k0 + kb + i) * 3072 + col];
            __builtin_amdgcn_sched_barrier(0);
#pragma unroll
            for (int i = 0; i < 32; ++i) { const int kk = kb + i;
                a0 += __uint_as_float((unsigned)__builtin_amdgcn_readlane((int)__float_as_uint(sv[0][kk >> 6]), kk & 63)) * wv[i];
                a1 += __uint_as_float((unsigned)__builtin_amdgcn_readlane((int)__float_as_uint(sv[1][kk >> 6]), kk & 63)) * wv[i];
                a2 += __uint_as_float((unsigned)__builtin_amdgcn_readlane((int)__float_as_uint(sv[2][kk >> 6]), kk & 63)) * wv[i]; } }
        LAS float* red = (LAS float*)lds;
        red[(wave * 3 + 0) * 64 + lane] = a0; red[(wave * 3 + 1) * 64 + lane] = a1; red[(wave * 3 + 2) * 64 + lane] = a2;
        __syncthreads();
        if (tid < 192) { const int r = tid >> 6, l = tid & 63; float s = 0.f;
#pragma unroll
            for (int w = 0; w < 8; ++w) s += red[(w * 3 + r) * 64 + l];
            ((float*)(ws + WS_MOD))[(layer * 3 + r) * 3072 + g * 64 + l] = s + a.in[10][layer * 3072 + g * 64 + l]; }
        __syncthreads();
    }
    for (int idx = blockIdx.x * NT + tid; idx < 16384; idx += G * NT) { const int k = idx >> 4, j = idx & 15; ((float*)(ws + WS_GW))[j * 1024 + k] = a.in[27][(size_t)k * IN_ODD + IN_ODD_MAIN + j]; }
    for (int idx = blockIdx.x * NT + tid; idx < 4096 * 256; idx += G * NT) { const int n = idx >> 8, k = idx & 255, qn = n >> 10, c = n & 1023, qk = k >> 6, j = k & 63;
        float wv = 0.f; if (qn == qk) wv = (qn < 2 ? a.in[19] : a.in[21])[(size_t)((qn & 1) * 64 + j) * 1024 + c];
        ((bf16_t*)(ws + WS_W2B))[idx] = (bf16_t)f2bf(wv); }
    LAS float* scr = (LAS float*)(lds + wave * 16384);
    const int gw = blockIdx.x * NWAVES + wave, NGW = G * NWAVES;
    constexpr int I_E = 16 * 296, I_OE = 32 * 32, NITEMS = I_E + I_OE;
    for (int it = gw; it < NITEMS; it += NGW) {
        int r = it;
        if (r < I_E) { p0_transpose_item(a.in[13], IN_EVEN, 1024, 296, (bf16_t*)(ws + WS_WINE), scr, r, lane); continue; } r -= I_E;
        p0_transpose_item(a.in[14], 1024, 2048, 32, (bf16_t*)(ws + WS_WOUTE), scr, r, lane);
    }
}

#define ROW_CB(lane, jj) (8 * (lane) + 512 * ((jj) >> 1) + 4 * ((jj) & 1))
__device__ __forceinline__ void row_unpack(const u32x4 p, f32x4& lo, f32x4& hi) { lo = (f32x4){bflo(p.x), bfhi(p.x), bflo(p.y), bfhi(p.y)}; hi = (f32x4){bflo(p.z), bfhi(p.z), bflo(p.w), bfhi(p.w)}; }
__device__ __forceinline__ void modnorm_store(const f32x4 (&v)[4], const float* ng, const float* mod, bf16_t* orow, int lane, f32x4 (&h)[4]) {
    f32x4 g4[4], sh[4], sc[4];
#pragma unroll
    for (int j = 0; j < 4; ++j) { const int col = ROW_CB(lane, j); g4[j] = *(const f32x4*)(ng + col); sh[j] = *(const f32x4*)(mod + col); sc[j] = *(const f32x4*)(mod + 1024 + col); }
    __builtin_amdgcn_sched_barrier(0);
    float s = 0.f;
#pragma unroll
    for (int j = 0; j < 4; ++j) s += (v[j].x * v[j].x + v[j].y * v[j].y) + (v[j].z * v[j].z + v[j].w * v[j].w);
    const float rstd = rsqrtf(wave_sum(s) * (1.f / 1024.f) + EPS);
#pragma unroll
    for (int j = 0; j < 4; ++j) h[j] = v[j] * rstd * g4[j] * (sc[j] + 1.f) + sh[j];
#pragma unroll
    for (int j2 = 0; j2 < 2; ++j2) *(u32x4*)(orow + 8 * lane + 512 * j2) = (u32x4){pk2(h[2 * j2].x, h[2 * j2].y), pk2(h[2 * j2].z, h[2 * j2].w), pk2(h[2 * j2 + 1].x, h[2 * j2 + 1].y), pk2(h[2 * j2 + 1].z, h[2 * j2 + 1].w)};
}

__device__ __forceinline__ void phase_modnorm0(const Args& a, int lane, int wave, int G) {
    const int gw = blockIdx.x * NWAVES + wave, NGW = G * NWAVES;
    const float* MOD = (const float*)(a.ws + WS_MOD);
    bf16_t* XN = (bf16_t*)(a.ws + WS_XN);
    for (int m = gw; m < NTOK; m += NGW) {
        int t, T, cr; tok_info(m, t, T, cr);
        const float* xr = x_row(a, m);
        f32x4 v[4], h[4];
#pragma unroll
        for (int j = 0; j < 4; ++j) v[j] = *(const f32x4*)(xr + ROW_CB(lane, j));
        modnorm_store(v, a.in[11], MOD + (0 * 3 + cr) * 3072, XN + (size_t)m * DM, lane, h);
    }
}

__device__ __forceinline__ float shiftv(const bf16_t* P, const float* mu, int m, int t, int T, int cc) {
    const bf16_t* p = P + (size_t)m * IN_EVEN + 5120 + cc;
    const float cur = bf2f(p[0]);
    const float prev = t > 0 ? bf2f(p[-IN_EVEN]) : 0.f;
    const float nxt = t < T - 1 ? bf2f(p[IN_EVEN]) : 0.f;
    return cur + mu[cc] * (prev - cur) + mu[3328 + cc] * (nxt - cur);
}
__device__ __forceinline__ void shift8(const u32x4 p, const u32x4 c, const u32x4 n, float pm, float nm, const float* mu0, const float* mu1, float (&x)[8]) {
    const unsigned pp[4] = {p.x, p.y, p.z, p.w}, cc[4] = {c.x, c.y, c.z, c.w}, nn[4] = {n.x, n.y, n.z, n.w};
    const f32x4 a0 = *(const f32x4*)mu0, a1 = *(const f32x4*)(mu0 + 4), b0 = *(const f32x4*)mu1, b1 = *(const f32x4*)(mu1 + 4);
    const float m0[8] = {a0.x, a0.y, a0.z, a0.w, a1.x, a1.y, a1.z, a1.w}, m1[8] = {b0.x, b0.y, b0.z, b0.w, b1.x, b1.y, b1.z, b1.w};
#pragma unroll
    for (int d = 0; d < 4; ++d) { const float c0 = bflo(cc[d]), c1 = bfhi(cc[d]);
        x[2 * d] = c0 + m0[2 * d] * (bflo(pp[d]) * pm - c0) + m1[2 * d] * (bflo(nn[d]) * nm - c0);
        x[2 * d + 1] = c1 + m0[2 * d + 1] * (bfhi(pp[d]) * pm - c1) + m1[2 * d + 1] * (bfhi(nn[d]) * nm - c1); }
}
__device__ __forceinline__ u32x4 pack8(const float (&x)[8]) { return (u32x4){pk2(x[0], x[1]), pk2(x[2], x[3]), pk2(x[4], x[5]), pk2(x[6], x[7])}; }
__device__ __forceinline__ void phase_rwkv_lr(const Args& a, int tid, int G) {
    const bf16_t* P = (const bf16_t*)(a.ws + WS_PROJ); bf16_t* LR = (bf16_t*)(a.ws + WS_LR); const float* mu = a.in[17];
    bf16_t* RS = (bf16_t*)(a.ws + WS_RS); bf16_t* KS = (bf16_t*)(a.ws + WS_KS); bf16_t* KKS = (bf16_t*)(a.ws + WS_KKS); bf16_t* oV = (bf16_t*)(a.ws + WS_V);
    const int lane = tid & 63, gw = blockIdx.x * NWAVES + (tid >> 6), NGW = G * NWAVES;
    for (int item = gw; item < 2048; item += NGW) {
        const int m0 = (item >> 1) * 8, half = item & 1, hc8 = half * 512 + 8 * lane, lc8 = 3072 + half * 128 + 8 * (lane & 15);
        int t0, T, cr; tok_info(m0, t0, T, cr);
        const bool hp = t0 > 0, hn = t0 + 8 < T;
        u32x4 rr[10], rk[10], rv[10];
#define LR_ROW(r) (P + (size_t)(((r) == 0 && !hp) ? m0 : (((r) == 9 && !hn) ? m0 + 7 : m0 - 1 + (r))) * IN_EVEN + 5120)
#pragma unroll
        for (int r = 0; r < 10; ++r) { const bf16_t* row = LR_ROW(r); rr[r] = *(const u32x4*)(row + hc8); rk[r] = *(const u32x4*)(row + 1024 + hc8); rv[r] = *(const u32x4*)(row + 2048 + hc8); }
        __builtin_amdgcn_sched_barrier(0);
#define LR_PM(i) (((i) == 0 && !hp) ? 0.f : 1.f)
#define LR_NM(i) (((i) == 7 && !hn) ? 0.f : 1.f)
#pragma unroll
        for (int i = 0; i < 8; ++i) { float x[8]; shift8(rr[i], rr[i + 1], rr[i + 2], LR_PM(i), LR_NM(i), mu + hc8, mu + 3328 + hc8, x); *(u32x4*)(RS + (size_t)(m0 + i) * 1024 + hc8) = pack8(x); }
        __builtin_amdgcn_sched_barrier(0);
#pragma unroll
        for (int r = 0; r < 10; ++r) rr[r] = *(const u32x4*)(LR_ROW(r) + lc8);
        __builtin_amdgcn_sched_barrier(0);
        { const f32x4 kw0 = *(const f32x4*)(a.in[22] + hc8), kw1 = *(const f32x4*)(a.in[22] + hc8 + 4);
          const float kkw[8] = {kw0.x, kw0.y, kw0.z, kw0.w, kw1.x, kw1.y, kw1.z, kw1.w};
#pragma unroll
          for (int i = 0; i < 8; ++i) { float x[8]; const size_t o = (size_t)(m0 + i) * 1024 + hc8;
              shift8(rk[i], rk[i + 1], rk[i + 2], LR_PM(i), LR_NM(i), mu + 1024 + hc8, mu + 3328 + 1024 + hc8, x); *(u32x4*)(KS + o) = pack8(x);
              float kk[8], ss = 0.f;
#pragma unroll
              for (int e = 0; e < 8; ++e) { kk[e] = x[e] * kkw[e]; ss += kk[e] * kk[e]; }
              const float inv = 1.f / fmaxf(sqrtf(oct_sum(ss)), 1e-12f);
#pragma unroll
              for (int e = 0; e < 8; ++e) kk[e] *= inv;
              *(u32x4*)(KKS + o) = pack8(kk); } }
#pragma unroll
        for (int i = 0; i < 8; ++i) { float x[8]; shift8(rv[i], rv[i + 1], rv[i + 2], LR_PM(i), LR_NM(i), mu + 2048 + hc8, mu + 3328 + 2048 + hc8, x); *(u32x4*)(oV + (size_t)(m0 + i) * 1024 + hc8) = pack8(x); }
#pragma unroll
        for (int i = 0; i < 8; ++i) { float x[8]; shift8(rr[i], rr[i + 1], rr[i + 2], LR_PM(i), LR_NM(i), mu + lc8, mu + 3328 + lc8, x);
            if (half == 0) {
#pragma unroll
                for (int e = 0; e < 8; ++e) x[e] = 1.f - 2.f * __builtin_amdgcn_rcpf(1.f + __expf(2.f * x[e])); }
            if (lane < 16) *(u32x4*)(LR + (size_t)(m0 + i) * 256 + half * 128 + 8 * lane) = pack8(x); }
#undef LR_ROW
#undef LR_PM
#undef LR_NM
    }
}

typedef short s16x4g __attribute__((ext_vector_type(4)));
template <int PITCH>
__device__ __forceinline__ bf16x8 tr_frag_p(const LAS unsigned char* img, int rowb, int col0, int r16) {
    const LAS unsigned char* p = img + (rowb + (r16 >> 2)) * PITCH + (col0 + 4 * (r16 & 3)) * 2;
    const s16x4g t0 = __builtin_amdgcn_ds_read_tr16_b64_v4i16((LAS s16x4g*)p), t1 = __builtin_amdgcn_ds_read_tr16_b64_v4i16((LAS s16x4g*)(p + 4 * PITCH));
    return (bf16x8){t0[0], t0[1], t0[2], t0[3], t1[0], t1[1], t1[2], t1[3]};
}
constexpr int RW_RECSZ = 29184, RW_WL = 18432;
__device__ __forceinline__ void rwkv_chunk_job(const Args& a, LAS unsigned char* wl, int lane, int gtb, int h) {
    const bf16_t* U4 = (const bf16_t*)(a.ws + WS_U4);
    const bf16_t* RS = (const bf16_t*)(a.ws + WS_RS); const bf16_t* KS = (const bf16_t*)(a.ws + WS_KS); const bf16_t* KKS = (const bf16_t*)(a.ws + WS_KKS); const bf16_t* Vs = (const bf16_t*)(a.ws + WS_V);
    float* oBS = (float*)(a.ws + WS_BS);
    const int m0 = gtb * 32;
    const int hc = h * 64 + lane, q = lane >> 4, r16 = lane & 15;
    LAS unsigned char* X0 = wl; LAS unsigned char* X1 = wl + 4608; LAS unsigned char* X2 = wl + 9216; LAS unsigned char* X3 = wl + 13824;
    const float ka = a.in[23][hc], rk = a.in[24][hc];
    unsigned nlw[8], nav[8], nr[8], nk[8], nkk[8];
#define RW_JLOAD(DIRV, jo_) do { _Pragma("unroll") for (int ji = 0; ji < 8; ++ji) { const int j = 8 * (jo_) + ji; const int t = (DIRV) ? 31 - j : j; \
            const bf16_t* up = U4 + (size_t)(m0 + t) * 4096 + (DIRV) * 1024 + hc; const size_t o = (size_t)(m0 + t) * 1024 + hc; \
            nlw[ji] = up[0]; nav[ji] = up[2048]; nr[ji] = RS[o]; nk[ji] = KS[o]; nkk[ji] = KKS[o]; } } while (0)
    RW_JLOAD(0, 0);
    const float w0cs[2] = {a.in[18][hc], a.in[18][1024 + hc]}, a0cs[2] = {a.in[20][hc], a.in[20][1024 + hc]};
    { u32x4 vp[4];
#pragma unroll
      for (int i = 0; i < 4; ++i) { const int p = lane + 64 * i; vp[i] = *(const u32x4*)(Vs + (size_t)(m0 + (p >> 3)) * 1024 + h * 64 + (p & 7) * 8); }
#pragma unroll
      for (int i = 0; i < 4; ++i) { const int p = lane + 64 * i; *(LAS u32x4*)(X0 + (p >> 3) * 144 + (p & 7) * 16) = vp[i]; }
#pragma unroll
      for (int vt = 0; vt < 4; ++vt) { const bf16x8 ff = tr_frag_p<144>(X0, 8 * q, 16 * vt, r16), fr = tr_frag_p<144>(X0, 24 - 8 * q, 16 * vt, r16);
          *(bf16x8*)(a.ws + WS_RWREC + (size_t)((gtb * 16 + h) * 2 + 0) * RW_RECSZ + (24 + vt) * 1024 + lane * 16) = ff;
          *(bf16x8*)(a.ws + WS_RWREC + (size_t)((gtb * 16 + h) * 2 + 1) * RW_RECSZ + (24 + vt) * 1024 + lane * 16) = (bf16x8){fr[7], fr[6], fr[5], fr[4], fr[3], fr[2], fr[1], fr[0]}; } }
#pragma unroll
    for (int dir = 0; dir < 2; ++dir) {
        unsigned char* rec = a.ws + WS_RWREC + (size_t)((gtb * 16 + h) * 2 + dir) * RW_RECSZ;
        const float w0c = w0cs[dir], a0c = a0cs[dir];
        float cum = 0.f, ecp = 1.f;
#pragma unroll 1
        for (int jo = 0; jo < 4; ++jo) {
            float lw8[8], av8[8], r8[8], k8[8], kk8[8], bs8[8];
#pragma unroll
            for (int ji = 0; ji < 8; ++ji) { lw8[ji] = __uint_as_float(nlw[ji] << 16); av8[ji] = __uint_as_float(nav[ji] << 16); r8[ji] = __uint_as_float(nr[ji] << 16); k8[ji] = __uint_as_float(nk[ji] << 16); kk8[ji] = __uint_as_float(nkk[ji] << 16); }
            if (jo < 3) RW_JLOAD(dir, jo + 1);
            __builtin_amdgcn_sched_barrier(0);
#pragma unroll
            for (int ji = 0; ji < 8; ++ji) { const int j = 8 * jo + ji;
                const float lw = -0.60653066f * sigm(w0c + lw8[ji]), av = sigm(a0c + av8[ji]);
                cum += lw;
                const float kka = kk8[ji] * av, kd = k8[ji] * (1.f + (av - 1.f) * ka);
                bs8[ji] = r8[ji] * kd * rk;
                const float ec = __expf(cum), ei = __builtin_amdgcn_rcpf(ec);
                *(LAS unsigned short*)(X0 + j * 144 + lane * 2) = (unsigned short)f2bf(ecp * kk8[ji]);
                *(LAS unsigned short*)(X3 + j * 144 + lane * 2) = (unsigned short)f2bf(ec * r8[ji]);
                *(LAS unsigned short*)(X1 + j * 144 + lane * 2) = (unsigned short)f2bf(-kka * ei);
                *(LAS unsigned short*)(X2 + j * 144 + lane * 2) = (unsigned short)f2bf(kd * ei);
                ecp = ec; }
            { float w4[4], x2[2];
#pragma unroll
              for (int i = 0; i < 4; ++i) { const auto r_ = __builtin_amdgcn_permlane32_swap(__float_as_uint(bs8[i]), __float_as_uint(bs8[i + 4]), false, false); w4[i] = __uint_as_float(r_[0]) + __uint_as_float(r_[1]); }
#pragma unroll
              for (int i = 0; i < 2; ++i) { const auto r_ = __builtin_amdgcn_permlane16_swap(__float_as_uint(w4[i]), __float_as_uint(w4[i + 2]), false, false); x2[i] = row16_sum(__uint_as_float(r_[0]) + __uint_as_float(r_[1])); }
              if (r16 == 0) { const int ji0 = 4 * (lane >> 5) + 2 * ((lane >> 4) & 1);
#pragma unroll
                  for (int i = 0; i < 2; ++i) { const int j = 8 * jo + ji0 + i; const int t = dir ? 31 - j : j; oBS[(size_t)dir * NTOK * 16 + (size_t)(m0 + t) * 16 + h] = x2[i]; } } }
        }
        if (dir == 0) RW_JLOAD(1, 0);
        const float wend = __expf(cum);
        *(float*)(rec + 28672 + lane * 4) = wend;
#define RWF(X, rt, ks) (*(const LAS bf16x8*)((X) + (16 * (rt) + r16) * 144 + (32 * (ks) + 8 * q) * 2))
        f32x4 A1[3], A2T[3], B1[3], B2[3];
#pragma unroll
        for (int tl = 0; tl < 3; ++tl) { const int jt = tl > 0 ? 1 : 0, it = tl == 2 ? 1 : 0;
            f32x4 c1 = (f32x4){0.f, 0.f, 0.f, 0.f}, c2 = c1, c3 = c1, c4 = c1;
#pragma unroll
            for (int ks = 0; ks < 2; ++ks) { const bf16x8 kbj = RWF(X0, jt, ks), rbj = RWF(X3, jt, ks), aci = RWF(X1, it, ks), bci = RWF(X2, it, ks);
                c1 = __builtin_amdgcn_mfma_f32_16x16x32_bf16(kbj, aci, c1, 0, 0, 0);
                c2 = __builtin_amdgcn_mfma_f32_16x16x32_bf16(bci, kbj, c2, 0, 0, 0);
                c3 = __builtin_amdgcn_mfma_f32_16x16x32_bf16(rbj, aci, c3, 0, 0, 0);
                c4 = __builtin_amdgcn_mfma_f32_16x16x32_bf16(rbj, bci, c4, 0, 0, 0); }
#pragma unroll
            for (int rr = 0; rr < 4; ++rr) { const int jrow = 16 * jt + 4 * q + rr, icol = 16 * it + r16;
                c1[rr] = (icol < jrow) ? c1[rr] : 0.f; c3[rr] = (icol <= jrow) ? c3[rr] : 0.f; c4[rr] = (icol <= jrow) ? c4[rr] : 0.f;
                const int irow = 16 * it + 4 * q + rr, jcol = 16 * jt + r16;
                c2[rr] = (irow < jcol) ? c2[rr] : 0.f; }
            A1[tl] = c1; A2T[tl] = c2; B1[tl] = c3; B2[tl] = c4; }
#pragma unroll
        for (int jt = 0; jt < 2; ++jt)
#pragma unroll
            for (int ks = 0; ks < 2; ++ks) { *(bf16x8*)(rec + (jt * 2 + ks) * 1024 + lane * 16) = RWF(X0, jt, ks); *(bf16x8*)(rec + (4 + jt * 2 + ks) * 1024 + lane * 16) = RWF(X3, jt, ks); }
#pragma unroll
        for (int kt = 0; kt < 4; ++kt) { const float we = __shfl(wend, 16 * kt + r16);
            const u32x4 ra = __builtin_bit_cast(u32x4, tr_frag_p<144>(X1, 8 * q, 16 * kt, r16)), rb = __builtin_bit_cast(u32x4, tr_frag_p<144>(X2, 8 * q, 16 * kt, r16));
            u32x4 wa, wb;
#pragma unroll
            for (int x = 0; x < 4; ++x) { wa[x] = pk2(bflo(ra[x]) * we, bfhi(ra[x]) * we); wb[x] = pk2(bflo(rb[x]) * we, bfhi(rb[x]) * we); }
            *(u32x4*)(rec + (16 + kt) * 1024 + lane * 16) = wa;
            *(u32x4*)(rec + (20 + kt) * 1024 + lane * 16) = wb; }
#undef RWF
        LAS float* AS = (LAS float*)X0;
#pragma unroll
        for (int tl = 0; tl < 3; ++tl) { const int jt = tl > 0 ? 1 : 0, it = tl == 2 ? 1 : 0;
#pragma unroll
            for (int rr = 0; rr < 4; ++rr) AS[(16 * jt + 4 * q + rr) * 33 + 16 * it + r16] = A1[tl][rr]; }
#pragma unroll
        for (int rr = 0; rr < 4; ++rr) AS[(4 * q + rr) * 33 + 16 + r16] = 0.f;
        { const int col = lane & 31; float Tr[32];
#pragma unroll
          for (int j = 0; j < 32; ++j) { const float rowv = AS[j * 33 + col]; float acc = (col == j) ? 1.f : 0.f;
#pragma unroll
              for (int i = 0; i < j; ++i) acc += __uint_as_float((unsigned)__builtin_amdgcn_readlane((int)__float_as_uint(rowv), i)) * Tr[i];
              Tr[j] = acc;
              if (lane < 32) *(LAS unsigned short*)(X1 + j * 80 + col * 2) = (unsigned short)f2bf(acc); } }
#pragma unroll
        for (int tl = 0; tl < 3; ++tl) { const int it = tl == 2 ? 1 : 0, jt = tl > 0 ? 1 : 0;
#pragma unroll
            for (int rr = 0; rr < 4; ++rr) *(LAS unsigned short*)(X2 + (16 * it + 4 * q + rr) * 80 + (16 * jt + r16) * 2) = (unsigned short)f2bf(A2T[tl][rr]); }
#pragma unroll
        for (int rr = 0; rr < 4; ++rr) *(LAS unsigned short*)(X2 + (16 + 4 * q + rr) * 80 + r16 * 2) = (unsigned short)0;
        { bf16x8 tf[2], af[2];
#pragma unroll
          for (int x = 0; x < 2; ++x) { tf[x] = *(const LAS bf16x8*)(X1 + (16 * x + r16) * 80 + 8 * q * 2); af[x] = *(const LAS bf16x8*)(X2 + (16 * x + r16) * 80 + 8 * q * 2);
              *(bf16x8*)(rec + (8 + x) * 1024 + lane * 16) = tf[x]; }
#pragma unroll
          for (int jt = 0; jt < 2; ++jt)
#pragma unroll
              for (int it = 0; it < 2; ++it) { f32x4 c = (f32x4){0.f, 0.f, 0.f, 0.f}; c = __builtin_amdgcn_mfma_f32_16x16x32_bf16(tf[jt], af[it], c, 0, 0, 0);
#pragma unroll
                  for (int rr = 0; rr < 4; ++rr) *(LAS unsigned short*)(X3 + (16 * jt + 4 * q + rr) * 80 + (16 * it + r16) * 2) = (unsigned short)f2bf(c[rr]); } }
#pragma unroll
        for (int x = 0; x < 2; ++x) *(bf16x8*)(rec + (10 + x) * 1024 + lane * 16) = *(const LAS bf16x8*)(X3 + (16 * x + r16) * 80 + 8 * q * 2);
#pragma unroll
        for (int which = 0; which < 2; ++which) {
#pragma unroll
            for (int tl = 0; tl < 3; ++tl) { const int jt = tl > 0 ? 1 : 0, it = tl == 2 ? 1 : 0;
#pragma unroll
                for (int rr = 0; rr < 4; ++rr) *(LAS unsigned short*)(X3 + (16 * jt + 4 * q + rr) * 80 + (16 * it + r16) * 2) = (unsigned short)f2bf(which ? B2[tl][rr] : B1[tl][rr]); }
#pragma unroll
            for (int rr = 0; rr < 4; ++rr) *(LAS unsigned short*)(X3 + (4 * q + rr) * 80 + (16 + r16) * 2) = (unsigned short)0;
#pragma unroll
            for (int x = 0; x < 2; ++x) *(bf16x8*)(rec + (12 + 2 * which + x) * 1024 + lane * 16) = *(const LAS bf16x8*)(X3 + (16 * x + r16) * 80 + 8 * q * 2);
        }
    }
}
#undef RW_JLOAD
__device__ __forceinline__ void phase_rwkv_chunks(const Args& a, LAS unsigned char* lds, int lane, int wave, int G) {
    const int gw = blockIdx.x * NWAVES + wave, NGW = G * NWAVES;
    for (int job = gw; job < 256 * 16; job += NGW) rwkv_chunk_job(a, lds + wave * RW_WL, lane, job >> 4, job & 15);
}

constexpr int HP_QA = 0, HP_KT = 8704, HP_TOT = 17408;
__device__ __forceinline__ void hgrn_pre_load(const Args& a, int tid, int gtb, int h, int dir, unsigned (&pq)[8], unsigned (&pf)[8], float (&ll)[2]) {
    const bf16_t* P = (const bf16_t*)(a.ws + WS_PROJ);
    const int m0 = gtb * 32, ch = tid & 127, tq = tid >> 7; const int fcol = (dir ? 3072 : 2048) + h * 128 + ch;
#pragma unroll
    for (int i = 0; i < 8; ++i) { const int ii = 8 * tq + i; const int t = dir ? 31 - ii : ii; const bf16_t* row = P + (size_t)(m0 + t) * IN_EVEN; pq[i] = row[h * 128 + ch]; pf[i] = row[fcol];
        ll[0] = a.in[15][h * 128 + ch]; ll[1] = a.in[15][1024 + h * 128 + ch]; }
}
__device__ __forceinline__ void hgrn_pre_job(const Args& a, LAS unsigned char* lds, int tid, int gtb, int h, int dir, const unsigned (&pq)[8], const unsigned (&pf)[8], const float (&ll)[2]) {
    bf16_t* QA = (bf16_t*)(a.ws + (dir ? WS_HQA1 : WS_HQA0)); bf16_t* KT = (bf16_t*)(a.ws + (dir ? WS_HKT1 : WS_HKT0));
    float* SC = (float*)(a.ws + WS_HSC) + (size_t)(dir * 256 + gtb) * 3072;
    const int m0 = gtb * 32, ch = tid & 127, tq = tid >> 7;
    LAS unsigned char* Qi = lds + HP_QA; LAS unsigned char* Ki = lds + HP_KT; LAS float* tot = (LAS float*)(lds + HP_TOT);
    const float l0 = ll[0], l1 = ll[1];
    const float lb = 1.f / (1.f + __expf(l1 - l0));
    float bl[8], kv[8]; float run = 0.f;
#pragma unroll
    for (int i = 0; i < 8; ++i) { const float f = lb + (1.f - lb) * sigm(bflo(pf[i])); run += __logf(f); bl[i] = run; kv[i] = 1.f - f; }
    tot[tq * 128 + ch] = run;
    __syncthreads();
    { const float t0 = tot[ch], t1 = tot[128 + ch], t2 = tot[256 + ch], t3 = tot[384 + ch];
      const float off = tq == 0 ? 0.f : (tq == 1 ? t0 : (tq == 2 ? t0 + t1 : t0 + t1 + t2));
      const float bmid = t0 + t1, bend = (t0 + t1) + (t2 + t3);
#pragma unroll
      for (int i = 0; i < 8; ++i) { const float b = off + bl[i]; const int s = 8 * tq + i;
          const float ek = __expf(bmid - b), ea = __builtin_amdgcn_rcpf(ek);
          *(LAS unsigned short*)(Qi + s * 272 + ch * 2) = (unsigned short)f2bf(bflo(pq[i]) * ea);
          *(LAS unsigned short*)(Ki + s * 272 + ch * 2) = (unsigned short)f2bf(kv[i] * ek); }
      if (tq == 0) { SC[h * 128 + ch] = __expf(bmid); SC[1024 + h * 128 + ch] = __expf(bend); SC[2048 + h * 128 + ch] = __expf(bend - bmid); } }
    __syncthreads();
    { const int s = tid >> 4, dc = tid & 15; const size_t o = (size_t)(m0 + s) * 1024 + h * 128 + dc * 8;
      *(u32x4*)(QA + o) = *(const LAS u32x4*)(Qi + s * 272 + dc * 16); *(u32x4*)(KT + o) = *(const LAS u32x4*)(Ki + s * 272 + dc * 16); }
    __syncthreads();
}
__device__ __forceinline__ void hgrn_pre_bundle(const Args& a, LAS unsigned char* lds, int tid, int job0) {
    unsigned qA[8], fA[8], qB[8], fB[8]; float lA[2], lB[2];
#define HP_DEC(j) ((j) >> 4), (((j) >> 1) & 7), ((j) & 1)
    hgrn_pre_load(a, tid, HP_DEC(job0), qA, fA, lA);
#pragma unroll 1
    for (int i = 0; i < 16; i += 2) {
        hgrn_pre_load(a, tid, HP_DEC(job0 + i + 1), qB, fB, lB);
        hgrn_pre_job(a, lds, tid, HP_DEC(job0 + i), qA, fA, lA);
        if (i + 2 < 16) hgrn_pre_load(a, tid, HP_DEC(job0 + i + 2), qA, fA, lA);
        hgrn_pre_job(a, lds, tid, HP_DEC(job0 + i + 1), qB, fB, lB);
    }
#undef HP_DEC
}

constexpr int HG_IMG = 0  , HG_ST = 52224, HG_PM = 87040;
typedef short s16x4h __attribute__((ext_vector_type(4)));
__device__ __forceinline__ bf16x8 tr_frag(const LAS unsigned char* img, int row0, int col0, int q, int r16) {
    const LAS unsigned char* p = img + (row0 + 8 * q + (r16 >> 2)) * 272 + (col0 + 4 * (r16 & 3)) * 2;
    const s16x4h t0 = __builtin_amdgcn_ds_read_tr16_b64_v4i16((LAS s16x4h*)p), t1 = __builtin_amdgcn_ds_read_tr16_b64_v4i16((LAS s16x4h*)(p + 4 * 272));
    return (bf16x8){t0[0], t0[1], t0[2], t0[3], t1[0], t1[1], t1[2], t1[3]};
}
__device__ __forceinline__ void hgrn_task(const Args& a, LAS unsigned char* lds, int tid, int seq, int is_sample, int dir, int h, int half) {
    const bf16_t* P = (const bf16_t*)(a.ws + WS_PROJ);
    const bf16_t* QA = (const bf16_t*)(a.ws + (dir ? WS_HQA1 : WS_HQA0)); const bf16_t* KT = (const bf16_t*)(a.ws + (dir ? WS_HKT1 : WS_HKT0));
    const float* SCb = (const float*)(a.ws + WS_HSC) + (size_t)dir * 256 * 3072;
    bf16_t* O = (bf16_t*)(a.ws + (dir ? WS_OB : WS_OF));
    const int T = is_sample ? 2048 : 256, base = is_sample ? 4096 + seq * 2048 : seq * 256, nch = T / 32, gtb0 = base / 32;
    const int cbeg = is_sample ? half * 32 : 0, cend = is_sample ? cbeg + 32 : nch;
    const int lane = tid & 63, w = __builtin_amdgcn_readfirstlane(tid >> 6), q = lane >> 4, r16 = lane & 15;
    LAS unsigned char* St = lds + HG_ST; LAS unsigned char* Pm = lds + HG_PM;
    f32x4 Sacc[8];
    if (is_sample) { const float* s0 = a.in[3] + ((size_t)((seq * 2 + dir) * 8 + h) * 128) * 128;
#pragma unroll
        for (int j = 0; j < 8; ++j)
#pragma unroll
            for (int r = 0; r < 4; ++r) Sacc[j][r] = s0[(size_t)(16 * w + 4 * q + r) * 128 + 16 * j + r16];
    } else {
#pragma unroll
        for (int j = 0; j < 8; ++j) Sacc[j] = (f32x4){0.f, 0.f, 0.f, 0.f};
    }
#define HG_GTB(c) (gtb0 + (dir ? nch - 1 - (c) : (c)))
#define HG_SCAL(dst, c, which) do { const float* sp = SCb + (size_t)HG_GTB(c) * 3072 + (which) * 1024 + h * 128 + 16 * w + 4 * q; const f32x4 v4 = *(const f32x4*)sp; dst[0] = v4.x; dst[1] = v4.y; dst[2] = v4.z; dst[3] = v4.w; } while (0)
#define HG_STORE_ST(scl) do { _Pragma("unroll") for (int j = 0; j < 8; ++j) { u32x2 pk; pk.x = pk2(Sacc[j][0] * scl[0], Sacc[j][1] * scl[1]); pk.y = pk2(Sacc[j][2] * scl[2], Sacc[j][3] * scl[3]); \
        *(LAS u32x2*)(St + (16 * j + r16) * 272 + (16 * w + 4 * q) * 2) = pk; } } while (0)
    const int ps = tid >> 4, pdc = tid & 15;
#define HG_LOADIMG(rq, rk, rv, c) do { const int gb = HG_GTB(c); const size_t o = (size_t)(gb * 32 + ps) * 1024 + h * 128 + pdc * 8; rq = *(const u32x4*)(QA + o); rk = *(const u32x4*)(KT + o); \
        rv = *(const u32x4*)(P + (size_t)(gb * 32 + (dir ? 31 - ps : ps)) * IN_EVEN + 1024 + h * 128 + pdc * 8); } while (0)
#define HG_WRITE(rq, rk, rv, buf) do { LAS unsigned char* ib = lds + HG_IMG + (buf) * 26112 + ps * 272 + pdc * 16; *(LAS u32x4*)ib = rq; *(LAS u32x4*)(ib + 8704) = rk; *(LAS u32x4*)(ib + 17408) = rv; } while (0)
#define HG_BUNDLE(X, c) do { if ((c) < cend) { HG_SCAL(ebe##X, c, 1); HG_SCAL(ecc##X, c, 2); if ((c) + 1 < cend) { HG_SCAL(ebm##X, (c) + 1, 0); HG_LOADIMG(rq##X, rk##X, rv##X, (c) + 1); } } } while (0)
    u32x4 rqA, rkA, rvA, rqB, rkB, rvB; float ebeA[4], eccA[4], ebmA[4], ebeB[4], eccB[4], ebmB[4];
    rqA = rkA = rvA = rqB = rkB = rvB = (u32x4){0u, 0u, 0u, 0u};
#pragma unroll
    for (int r = 0; r < 4; ++r) { ebeA[r] = eccA[r] = ebmA[r] = ebeB[r] = eccB[r] = ebmB[r] = 0.f; }
    if (cbeg > 0) {
#define HG_LOADKV(rk, rv, c) do { const int gb = HG_GTB(c); rk = *(const u32x4*)(KT + (size_t)(gb * 32 + ps) * 1024 + h * 128 + pdc * 8); \
        rv = *(const u32x4*)(P + (size_t)(gb * 32 + (dir ? 31 - ps : ps)) * IN_EVEN + 1024 + h * 128 + pdc * 8); } while (0)
#define HG_WRITEKV(rk, rv, buf) do { LAS unsigned char* ib = lds + HG_IMG + (buf) * 26112 + ps * 272 + pdc * 16; *(LAS u32x4*)(ib + 8704) = rk; *(LAS u32x4*)(ib + 17408) = rv; } while (0)
#define HG_LBUNDLE(X, c) do { if ((c) < cbeg) { HG_SCAL(ebe##X, c, 1); HG_SCAL(ecc##X, c, 2); if ((c) + 1 < cbeg) HG_LOADKV(rk##X, rv##X, (c) + 1); } } while (0)
#define HG_LIGHT(X, c) do { const LAS unsigned char* Ki = lds + HG_IMG + ((c) & 1) * 26112 + 8704; const LAS unsigned char* Vi = Ki + 8704; \
        __syncthreads(); \
        const bf16x8 kta = tr_frag(Ki, 0, 16 * w, q, r16); \
        _Pragma("unroll") for (int j = 0; j < 8; ++j) { const bf16x8 vfj = tr_frag(Vi, 0, 16 * j, q, r16); f32x4 t4 = (f32x4){0.f, 0.f, 0.f, 0.f}; t4 = __builtin_amdgcn_mfma_f32_16x16x32_bf16(kta, vfj, t4, 0, 0, 0); \
            _Pragma("unroll") for (int r = 0; r < 4; ++r) Sacc[j][r] = ebe##X[r] * Sacc[j][r] + ecc##X[r] * t4[r]; } \
        if ((c) + 1 < cbeg) HG_WRITEKV(rk##X, rv##X, ((c) + 1) & 1); \
        HG_LBUNDLE(X, (c) + 2); } while (0)
        { u32x4 k0, v0; HG_LOADKV(k0, v0, 0); HG_WRITEKV(k0, v0, 0); }
        HG_LBUNDLE(A, 0); HG_LBUNDLE(B, 1);
#pragma unroll 1
        for (int c = 0; c < cbeg; c += 2) { HG_LIGHT(A, c); HG_LIGHT(B, c + 1); }
#undef HG_LIGHT
#undef HG_LBUNDLE
#undef HG_WRITEKV
#undef HG_LOADKV
    }
    { float e0[4]; HG_SCAL(e0, cbeg, 0); u32x4 q0, k0, v0; HG_LOADIMG(q0, k0, v0, cbeg); HG_STORE_ST(e0); HG_WRITE(q0, k0, v0, 0); }
    HG_BUNDLE(A, cbeg); HG_BUNDLE(B, cbeg + 1);
#define HG_CHUNK(X, c) do { \
        const LAS unsigned char* Qi = lds + HG_IMG + ((c) & 1) * 26112; const LAS unsigned char* Ki = Qi + 8704; const LAS unsigned char* Vi = Qi + 17408; \
        __syncthreads();                                             \
        if (w < 3) { const int tt = w > 0 ? 1 : 0, ss = w == 2 ? 1 : 0; \
            f32x4 s4 = (f32x4){0.f, 0.f, 0.f, 0.f}; \
            _Pragma("unroll") for (int ks = 0; ks < 4; ++ks) { const bf16x8 af = *(const LAS bf16x8*)(Qi + (16 * tt + r16) * 272 + (32 * ks + 8 * q) * 2); const bf16x8 bf = *(const LAS bf16x8*)(Ki + (16 * ss + r16) * 272 + (32 * ks + 8 * q) * 2); \
                s4 = __builtin_amdgcn_mfma_f32_16x16x32_bf16(af, bf, s4, 0, 0, 0); } \
            _Pragma("unroll") for (int r = 0; r < 4; ++r) { const int trow = 16 * tt + 4 * q + r, scol = 16 * ss + r16; \
                *(LAS unsigned short*)(Pm + trow * 80 + scol * 2) = (unsigned short)((scol <= trow) ? f2bf(s4[r]) : 0u); } \
        } else if (w == 3) { \
            _Pragma("unroll") for (int r = 0; r < 4; ++r) *(LAS unsigned short*)(Pm + (4 * q + r) * 80 + (16 + r16) * 2) = (unsigned short)0; \
        } \
        f32x4 oacc[2]; \
        _Pragma("unroll") for (int tt = 0; tt < 2; ++tt) { oacc[tt] = (f32x4){0.f, 0.f, 0.f, 0.f}; \
            _Pragma("unroll") for (int ks = 0; ks < 4; ++ks) { const bf16x8 af = *(const LAS bf16x8*)(Qi + (16 * tt + r16) * 272 + (32 * ks + 8 * q) * 2); const bf16x8 bf = *(const LAS bf16x8*)(St + (16 * w + r16) * 272 + (32 * ks + 8 * q) * 2); \
                oacc[tt] = __builtin_amdgcn_mfma_f32_16x16x32_bf16(bf, af, oacc[tt], 0, 0, 0); } }        \
        bf16x8 vf[8]; \
        _Pragma("unroll") for (int j = 0; j < 8; ++j) vf[j] = tr_frag(Vi, 0, 16 * j, q, r16); \
        const bf16x8 kta = tr_frag(Ki, 0, 16 * w, q, r16); \
        __syncthreads();                                             \
        { const bf16x8 vown = tr_frag(Vi, 0, 16 * w, q, r16);        \
          _Pragma("unroll") for (int tt = 0; tt < 2; ++tt) { const bf16x8 pf_ = *(const LAS bf16x8*)(Pm + (16 * tt + r16) * 80 + q * 16); \
              oacc[tt] = __builtin_amdgcn_mfma_f32_16x16x32_bf16(vown, pf_, oacc[tt], 0, 0, 0); } \
            \
          { const auto rx = __builtin_amdgcn_permlane16_swap(pk2(oacc[0][0], oacc[0][1]), pk2(oacc[1][0], oacc[1][1]), false, false); \
            const auto ry = __builtin_amdgcn_permlane16_swap(pk2(oacc[0][2], oacc[0][3]), pk2(oacc[1][2], oacc[1][3]), false, false); \
            const int ii = (c) * 32 + 16 * (q & 1) + r16; const int t = dir ? (T - 1 - ii) : ii; \
            *(u32x4*)(O + (size_t)(base + t) * 1024 + h * 128 + 16 * w + 4 * (q & 2)) = (u32x4){rx[0], ry[0], rx[1], ry[1]}; } } \
        _Pragma("unroll") for (int j = 0; j < 8; ++j) { f32x4 t4 = (f32x4){0.f, 0.f, 0.f, 0.f}; t4 = __builtin_amdgcn_mfma_f32_16x16x32_bf16(kta, vf[j], t4, 0, 0, 0); \
            _Pragma("unroll") for (int r = 0; r < 4; ++r) Sacc[j][r] = ebe##X[r] * Sacc[j][r] + ecc##X[r] * t4[r]; } \
        if ((c) + 1 < cend) { HG_STORE_ST(ebm##X); HG_WRITE(rq##X, rk##X, rv##X, ((c) + 1) & 1); } \
        HG_BUNDLE(X, (c) + 2); \
    } while (0)
    for (int c = cbeg; c < cend; c += 2) { HG_CHUNK(A, c); HG_CHUNK(B, c + 1); }
#undef HG_CHUNK
#undef HG_BUNDLE
#undef HG_LOADIMG
#undef HG_WRITE
#undef HG_SCAL
#undef HG_GTB
#undef HG_STORE_ST
    if (!is_sample) { float* so = a.out + OUT_HGRN + ((size_t)((seq * 2 + dir) * 8 + h) * 128) * 128;
#pragma unroll
        for (int j = 0; j < 8; ++j)
#pragma unroll
            for (int r = 0; r < 4; ++r) so[(size_t)(16 * w + 4 * q + r) * 128 + 16 * j + r16] = Sacc[j][r]; }
    __syncthreads();
}

constexpr int RWS_STAGE = 32768;
template <int nrec>
__device__ __forceinline__ void rwkv_scan_block(const Args& a, LAS unsigned char* lds, int tid, int rid0, int is_sample) {
    const int lane = tid & 63, wave = __builtin_amdgcn_readfirstlane(tid >> 6);
    constexpr int nf = 3 * nrec; const int rsel = nrec == 2 ? wave >> 2 : 0, vt = wave & 3;
    const bool comp = nrec == 2 || wave < 4;
    const int lf0 = nrec == 2 ? vt * 6 : wave * 3;
    const int rid = rid0 + rsel, h = rid & 15, dir = (rid >> 4) & 1, seq = rid >> 5;
    const int T = is_sample ? 2048 : 256, base = is_sample ? 4096 + seq * 2048 : seq * 256;
    const int nblk = T / 32, gtb0 = base / 32;
    const int q = lane >> 4, r16 = lane & 15;
    LAS unsigned char* SA = lds + wave * 4096; LAS unsigned char* UA = SA + 2304;
    LAS unsigned char* stg = lds + RWS_STAGE + rsel * 24576 + lane * 16;
    bf16_t* Y = (bf16_t*)(a.ws + (dir ? WS_YB : WS_YF));
    f32x4 S[4];
    if (is_sample) { const float* sp = a.in[4] + (size_t)((seq * 2 + dir) * 16 + h) * 4096;
#pragma unroll
        for (int kt = 0; kt < 4; ++kt)
#pragma unroll
            for (int r = 0; r < 4; ++r) S[kt][r] = sp[(size_t)(16 * vt + 4 * q + r) * 64 + 16 * kt + r16];
    } else {
#pragma unroll
        for (int kt = 0; kt < 4; ++kt) S[kt] = (f32x4){0.f, 0.f, 0.f, 0.f};
    }
#define RW_REC(c) (a.ws + WS_RWREC + (size_t)(((gtb0 + (dir ? nblk - 1 - (c) : (c))) * 16 + h) * 2 + dir) * RW_RECSZ)
#define RW_FR(rec, f) (*(const bf16x8*)((rec) + (f) * 1024 + lane * 16))
#define RW_LF(buf, f) (*(const LAS bf16x8*)(stg + (buf) * 49152 + (f) * 1024))
#define RW_GLOAD(g, rec) do { _Pragma("unroll") for (int i_ = 0; i_ < 6; ++i_) if (i_ < nf) g[i_] = *(const u32x4*)((rec) + (lf0 + i_) * 1024 + lane * 16); } while (0)
#define RW_GWRITE(g, buf) do { _Pragma("unroll") for (int i_ = 0; i_ < 6; ++i_) if (i_ < nf) *(LAS u32x4*)(stg + (buf) * 49152 + (lf0 + i_) * 1024) = g[i_]; } while (0)
    u32x4 gA[6], gB[6]; bf16x8 VA; float we[4];
#pragma unroll
    for (int i = 0; i < 6; ++i) { gA[i] = (u32x4){0u, 0u, 0u, 0u}; gB[i] = gA[i]; }
    { const unsigned char* rec0 = RW_REC(0); const unsigned char* rec1 = RW_REC(1);
      RW_GLOAD(gB, rec0); RW_GLOAD(gA, rec1);
      VA = RW_FR(rec0, 24 + vt);
#pragma unroll
      for (int x = 0; x < 4; ++x) we[x] = *(const float*)(rec0 + 28672 + (16 * x + r16) * 4);
      RW_GWRITE(gB, 0); }
    __syncthreads();
#define RW_STEP(GX, GY, c) do { \
        const unsigned char* nrec1 = RW_REC((c) + 1 < nblk ? (c) + 1 : nblk - 1); const unsigned char* nrec2 = RW_REC((c) + 2 < nblk ? (c) + 2 : nblk - 1); \
        const bf16x8 VAn = RW_FR(nrec1, 24 + vt); float wen[4]; \
        _Pragma("unroll") for (int x = 0; x < 4; ++x) wen[x] = *(const float*)(nrec1 + 28672 + (16 * x + r16) * 4); \
        RW_GLOAD(GY, nrec2); \
        if (comp) { const int bf_ = (c) & 1; \
            _Pragma("unroll") for (int kt = 0; kt < 4; ++kt) _Pragma("unroll") for (int r = 0; r < 4; ++r) *(LAS unsigned short*)(SA + (4 * q + r) * 144 + (16 * kt + r16) * 2) = (unsigned short)f2bf(S[kt][r]); \
            const bf16x8 sa0 = *(const LAS bf16x8*)(SA + r16 * 144 + (8 * q) * 2), sa1 = *(const LAS bf16x8*)(SA + r16 * 144 + (32 + 8 * q) * 2); \
            f32x4 ut[2], yt[2]; \
            _Pragma("unroll") for (int jt = 0; jt < 2; ++jt) { ut[jt] = (f32x4){0.f, 0.f, 0.f, 0.f}; yt[jt] = ut[jt]; \
                ut[jt] = __builtin_amdgcn_mfma_f32_16x16x32_bf16(sa0, RW_LF(bf_, jt * 2), ut[jt], 0, 0, 0); ut[jt] = __builtin_amdgcn_mfma_f32_16x16x32_bf16(sa1, RW_LF(bf_, jt * 2 + 1), ut[jt], 0, 0, 0); \
                yt[jt] = __builtin_amdgcn_mfma_f32_16x16x32_bf16(sa0, RW_LF(bf_, 4 + jt * 2), yt[jt], 0, 0, 0); yt[jt] = __builtin_amdgcn_mfma_f32_16x16x32_bf16(sa1, RW_LF(bf_, 4 + jt * 2 + 1), yt[jt], 0, 0, 0); } \
            _Pragma("unroll") for (int jt = 0; jt < 2; ++jt) _Pragma("unroll") for (int r = 0; r < 4; ++r) *(LAS unsigned short*)(UA + (4 * q + r) * 80 + (16 * jt + r16) * 2) = (unsigned short)f2bf(ut[jt][r]); \
            const bf16x8 ua0 = *(const LAS bf16x8*)(UA + r16 * 80 + 8 * q * 2); \
            f32x4 u2[2]; \
            _Pragma("unroll") for (int jt = 0; jt < 2; ++jt) { u2[jt] = (f32x4){0.f, 0.f, 0.f, 0.f}; \
                u2[jt] = __builtin_amdgcn_mfma_f32_16x16x32_bf16(ua0, RW_LF(bf_, 8 + jt), u2[jt], 0, 0, 0); u2[jt] = __builtin_amdgcn_mfma_f32_16x16x32_bf16(VA, RW_LF(bf_, 10 + jt), u2[jt], 0, 0, 0); } \
            _Pragma("unroll") for (int jt = 0; jt < 2; ++jt) _Pragma("unroll") for (int r = 0; r < 4; ++r) *(LAS unsigned short*)(UA + (4 * q + r) * 80 + (16 * jt + r16) * 2) = (unsigned short)f2bf(u2[jt][r]); \
            const bf16x8 ua1 = *(const LAS bf16x8*)(UA + r16 * 80 + 8 * q * 2); \
            _Pragma("unroll") for (int jt = 0; jt < 2; ++jt) { yt[jt] = __builtin_amdgcn_mfma_f32_16x16x32_bf16(ua1, RW_LF(bf_, 12 + jt), yt[jt], 0, 0, 0); yt[jt] = __builtin_amdgcn_mfma_f32_16x16x32_bf16(VA, RW_LF(bf_, 14 + jt), yt[jt], 0, 0, 0); } \
            { const int tb = dir ? nblk - 1 - (c) : (c); \
                \
              const auto rx_ = __builtin_amdgcn_permlane16_swap(pk2(yt[0][0], yt[0][1]), pk2(yt[1][0], yt[1][1]), false, false); \
              const auto ry_ = __builtin_amdgcn_permlane16_swap(pk2(yt[0][2], yt[0][3]), pk2(yt[1][2], yt[1][3]), false, false); \
              const int j = 16 * (q & 1) + r16; const int tl = dir ? 31 - j : j; \
              *(u32x4*)(Y + (size_t)(base + tb * 32 + tl) * 1024 + h * 64 + 16 * vt + 4 * (q & 2)) = (u32x4){rx_[0], ry_[0], rx_[1], ry_[1]}; } \
            _Pragma("unroll") for (int kt = 0; kt < 4; ++kt) { S[kt] *= we[kt]; \
                S[kt] = __builtin_amdgcn_mfma_f32_16x16x32_bf16(ua1, RW_LF(bf_, 16 + kt), S[kt], 0, 0, 0); S[kt] = __builtin_amdgcn_mfma_f32_16x16x32_bf16(VA, RW_LF(bf_, 20 + kt), S[kt], 0, 0, 0); } \
        } \
        RW_GWRITE(GX, ((c) + 1) & 1); \
        __syncthreads(); \
        VA = VAn; \
        _Pragma("unroll") for (int x = 0; x < 4; ++x) we[x] = wen[x]; \
    } while (0)
    for (int c = 0; c < nblk; c += 2) { RW_STEP(gA, gB, c); RW_STEP(gB, gA, c + 1); }
#undef RW_STEP
#undef RW_GLOAD
#undef RW_GWRITE
#undef RW_LF
#undef RW_REC
#undef RW_FR
    if (!is_sample) { float* so = a.out + OUT_RWKV + (size_t)((seq * 2 + dir) * 16 + h) * 4096;
#pragma unroll
        for (int kt = 0; kt < 4; ++kt)
#pragma unroll
            for (int r = 0; r < 4; ++r) so[(size_t)(16 * vt + 4 * q + r) * 64 + 16 * kt + r16] = S[kt][r]; }
}

__device__ __forceinline__ int queue_pop(unsigned* head, volatile LAS unsigned* slot, int tid) {
    __syncthreads();
    if (tid == 0) slot[0] = __hip_atomic_fetch_add(head, 1u, __ATOMIC_RELAXED, __HIP_MEMORY_SCOPE_AGENT);
    __syncthreads();
    return (int)slot[0];
}

__device__ __forceinline__ void phase_scans_even(const Args& a, LAS unsigned char* lds, int tid, int qoff) {
    unsigned* head = (unsigned*)(a.ws + WS_CTL) + CW_Q0 + qoff;
    volatile LAS unsigned* slot = (volatile LAS unsigned*)(lds + MISC_OFF);
    const int lane = tid & 63, wave = __builtin_amdgcn_readfirstlane(tid >> 6);
    for (;;) {
        int task = queue_pop(head, slot, tid);
        if (task >= 1408) break;
        if (task >= 128 && task < 896) { LAS float* scr = (LAS float*)(lds + wave * 16384); const int r = (task - 128) * 8 + wave;
            if (r < 5120) p0_transpose_item(a.in[27], IN_ODD, 1024, 320, (bf16_t*)(a.ws + WS_WINO), scr, r, lane);
            else p0_transpose_item(a.in[28], 1024, 2048, 32, (bf16_t*)(a.ws + WS_WOUTO), scr, r - 5120, lane);
            continue; }
        const bool is_h = task < 64 || (task >= 896 && task < 1152);
        if (is_h) { const int is_sample = task < 64; const int k = is_sample ? task & 31 : task - 896; hgrn_task(a, lds, tid, k >> 4, is_sample, (k >> 3) & 1, k & 7, 1 - (task >> 5)); }
        else if (task < 128) rwkv_scan_block<1>(a, lds, tid, task - 64, 1);
        else rwkv_scan_block<2>(a, lds, tid, 2 * (task - 1152), 0);
    }
}

__device__ __forceinline__ void phase_combine_even(const Args& a, int lane, int wave, int G) {
    const int gw = blockIdx.x * NWAVES + wave, NGW = G * NWAVES;
    const bf16_t* OF = (const bf16_t*)(a.ws + WS_OF); const bf16_t* OB = (const bf16_t*)(a.ws + WS_OB);
    const bf16_t* YF = (const bf16_t*)(a.ws + WS_YF); const bf16_t* YB = (const bf16_t*)(a.ws + WS_YB);
    const bf16_t* P = (const bf16_t*)(a.ws + WS_PROJ); const bf16_t* V = (const bf16_t*)(a.ws + WS_V); const float* BS = (const float*)(a.ws + WS_BS);
    bf16_t* Yo = (bf16_t*)(a.ws + WS_Y);
    const int c0 = 16 * lane, hh = lane >> 2;
    f32x4 hg4[4], gg4[4], gb4[4];
#pragma unroll
    for (int q = 0; q < 4; ++q) { hg4[q] = *(const f32x4*)(a.in[16] + c0 + 4 * q); gg4[q] = *(const f32x4*)(a.in[25] + c0 + 4 * q); gb4[q] = *(const f32x4*)(a.in[26] + c0 + 4 * q); }
    for (int m = gw; m < NTOK; m += NGW) {
        f32x4 of[4], ob[4], yf[4], yb[4]; u32x4 za[2], zb[2], vv[2], rof[2], rob[2], ryf[2], ryb[2];
#pragma unroll
        for (int x = 0; x < 2; ++x) { rof[x] = *(const u32x4*)(OF + (size_t)m * 1024 + c0 + 8 * x); rob[x] = *(const u32x4*)(OB + (size_t)m * 1024 + c0 + 8 * x);
            ryf[x] = *(const u32x4*)(YF + (size_t)m * 1024 + c0 + 8 * x); ryb[x] = *(const u32x4*)(YB + (size_t)m * 1024 + c0 + 8 * x); }
#pragma unroll
        for (int x = 0; x < 2; ++x) { za[x] = *(const u32x4*)(P + (size_t)m * IN_EVEN + 4096 + c0 + 8 * x); zb[x] = *(const u32x4*)(P + (size_t)m * IN_EVEN + 8448 + c0 + 8 * x); vv[x] = *(const u32x4*)(V + (size_t)m * 1024 + c0 + 8 * x); }
#pragma unroll
        for (int q = 0; q < 4; ++q) { const int x = q >> 1, j = (q & 1) * 2;
            of[q] = (f32x4){bflo(rof[x][j]), bfhi(rof[x][j]), bflo(rof[x][j + 1]), bfhi(rof[x][j + 1])}; ob[q] = (f32x4){bflo(rob[x][j]), bfhi(rob[x][j]), bflo(rob[x][j + 1]), bfhi(rob[x][j + 1])};
            yf[q] = (f32x4){bflo(ryf[x][j]), bfhi(ryf[x][j]), bflo(ryf[x][j + 1]), bfhi(ryf[x][j + 1])}; yb[q] = (f32x4){bflo(ryb[x][j]), bfhi(ryb[x][j]), bflo(ryb[x][j + 1]), bfhi(ryb[x][j + 1])}; }
        const float bon = BS[(size_t)m * 16 + hh] + BS[(size_t)NTOK * 16 + (size_t)m * 16 + hh];
        float ss = 0.f;
#pragma unroll
        for (int q = 0; q < 4; ++q) { of[q] = of[q] + ob[q]; ss += (of[q].x * of[q].x + of[q].y * of[q].y) + (of[q].z * of[q].z + of[q].w * of[q].w); }
        const float rs = rsqrtf(oct_sum(ss) * (1.f / 128.f) + EPS);
        { unsigned w[8];
#pragma unroll
          for (int q = 0; q < 4; ++q) { const unsigned z01 = za[q >> 1][(q & 1) * 2], z23 = za[q >> 1][(q & 1) * 2 + 1]; const f32x4 o = of[q] * rs * hg4[q];
              w[2 * q] = pk2(o.x * silu(bflo(z01)), o.y * silu(bfhi(z01))); w[2 * q + 1] = pk2(o.z * silu(bflo(z23)), o.w * silu(bfhi(z23))); }
          u32x4* dst = (u32x4*)(Yo + (size_t)m * 2048 + c0);
          dst[0] = (u32x4){w[0], w[1], w[2], w[3]}; dst[1] = (u32x4){w[4], w[5], w[6], w[7]}; }
        float sm = 0.f;
#pragma unroll
        for (int q = 0; q < 4; ++q) { yf[q] = yf[q] + yb[q]; sm += (yf[q].x + yf[q].y) + (yf[q].z + yf[q].w); }
        const float mean = quad_sum(sm) * (1.f / 64.f); float sq = 0.f;
#pragma unroll
        for (int q = 0; q < 4; ++q) { yf[q] = yf[q] - mean; sq += (yf[q].x * yf[q].x + yf[q].y * yf[q].y) + (yf[q].z * yf[q].z + yf[q].w * yf[q].w); }
        const float rg = rsqrtf(quad_sum(sq) * (1.f / 64.f) + GN_EPS);
        { unsigned w[8];
#pragma unroll
          for (int q = 0; q < 4; ++q) { const unsigned z01 = zb[q >> 1][(q & 1) * 2], z23 = zb[q >> 1][(q & 1) * 2 + 1], v01 = vv[q >> 1][(q & 1) * 2], v23 = vv[q >> 1][(q & 1) * 2 + 1];
              const f32x4 g = yf[q] * rg * gg4[q] + gb4[q];
              w[2 * q] = pk2((g.x + bon * bflo(v01)) * silu(bflo(z01)), (g.y + bon * bfhi(v01)) * silu(bfhi(z01)));
              w[2 * q + 1] = pk2((g.z + bon * bflo(v23)) * silu(bflo(z23)), (g.w + bon * bfhi(v23)) * silu(bfhi(z23))); }
          u32x4* dst = (u32x4*)(Yo + (size_t)m * 2048 + 1024 + c0);
          dst[0] = (u32x4){w[0], w[1], w[2], w[3]}; dst[1] = (u32x4){w[4], w[5], w[6], w[7]}; }
    }
}

__device__ __forceinline__ void phase_res_modnorm1(const Args& a, int lane, int wave, int G) {
    const int gw = blockIdx.x * NWAVES + wave, NGW = G * NWAVES;
    const float* MOD = (const float*)(a.ws + WS_MOD); const bf16_t* PART = (const bf16_t*)(a.ws + WS_PART); const float* GW = (const float*)(a.ws + WS_GW);
    float* X1 = (float*)(a.ws + WS_X1); bf16_t* XN = (bf16_t*)(a.ws + WS_XN); float* GT = (float*)(a.ws + WS_GT);
    for (int m0 = gw; m0 < NTOK; m0 += 4 * NGW) {
        f32x4 h[4][4];
        { f32x4 xv[4][4]; u32x4 pa[4][2], pb[4][2];
#pragma unroll
          for (int k = 0; k < 4; ++k) { const int m = m0 + k * NGW; const float* xr = x_row(a, m);
              const bf16_t* p0 = PART + (size_t)m * 1024 + 8 * lane; const bf16_t* p1 = p0 + (size_t)NTOK * 1024;
#pragma unroll
              for (int j = 0; j < 4; ++j) xv[k][j] = *(const f32x4*)(xr + ROW_CB(lane, j));
#pragma unroll
              for (int j2 = 0; j2 < 2; ++j2) { pa[k][j2] = *(const u32x4*)(p0 + 512 * j2); pb[k][j2] = *(const u32x4*)(p1 + 512 * j2); } }
          __builtin_amdgcn_sched_barrier(0);
#pragma unroll
          for (int k = 0; k < 4; ++k) { const int m = m0 + k * NGW; int t, T, cr; tok_info(m, t, T, cr);
              const float* gt = MOD + (0 * 3 + cr) * 3072 + 2048;
              f32x4 v[4];
#pragma unroll
              for (int j2 = 0; j2 < 2; ++j2) { f32x4 a0, a1, b0, b1; row_unpack(pa[k][j2], a0, a1); row_unpack(pb[k][j2], b0, b1);
                  v[2 * j2] = xv[k][2 * j2] + *(const f32x4*)(gt + ROW_CB(lane, 2 * j2)) * (a0 + b0); v[2 * j2 + 1] = xv[k][2 * j2 + 1] + *(const f32x4*)(gt + ROW_CB(lane, 2 * j2 + 1)) * (a1 + b1); }
#pragma unroll
              for (int j = 0; j < 4; ++j) *(f32x4*)(X1 + (size_t)m * 1024 + ROW_CB(lane, j)) = v[j];
              modnorm_store(v, a.in[11] + 1024, MOD + (1 * 3 + cr) * 3072, XN + (size_t)m * DM, lane, h[k]); } }
        float myg[4] = {0.f, 0.f, 0.f, 0.f};
#pragma unroll 4
        for (int jg = 0; jg < 16; ++jg) { f32x4 w4[4]; float d[4];
#pragma unroll
            for (int j = 0; j < 4; ++j) w4[j] = *(const f32x4*)(GW + jg * 1024 + ROW_CB(lane, j));
#pragma unroll
            for (int k = 0; k < 4; ++k) { d[k] = 0.f;
#pragma unroll
                for (int j = 0; j < 4; ++j) d[k] += (h[k][j].x * w4[j].x + h[k][j].y * w4[j].y) + (h[k][j].z * w4[j].z + h[k][j].w * w4[j].w);
                d[k] = wave_sum(d[k]);
                if (lane == jg) myg[k] = d[k]; } }
        if (lane < 16) {
#pragma unroll
            for (int k = 0; k < 4; ++k) GT[(size_t)(m0 + k * NGW) * 16 + lane] = myg[k] + a.in[31][lane]; }
    }
}

__device__ __forceinline__ void conv_fma8(float (&acc)[8], const u32x4 x, const f32x4 w0, const f32x4 w1) {
    acc[0] += bflo(x.x) * w0.x; acc[1] += bfhi(x.x) * w0.y; acc[2] += bflo(x.y) * w0.z; acc[3] += bfhi(x.y) * w0.w;
    acc[4] += bflo(x.z) * w1.x; acc[5] += bfhi(x.z) * w1.y; acc[6] += bflo(x.w) * w1.z; acc[7] += bfhi(x.w) * w1.w;
}
__device__ __forceinline__ u32x4 conv_out8(const float (&acc)[8], float sc) {
    u32x4 o; o.x = pk2(silu(acc[0]) * sc, silu(acc[1]) * sc); o.y = pk2(silu(acc[2]) * sc, silu(acc[3]) * sc); o.z = pk2(silu(acc[4]) * sc, silu(acc[5]) * sc); o.w = pk2(silu(acc[6]) * sc, silu(acc[7]) * sc); return o;
}
__device__ __forceinline__ void phase_conv(const Args& a, int tid, int G) {
    const bf16_t* P = (const bf16_t*)(a.ws + WS_PROJ); bf16_t* QKC = (bf16_t*)(a.ws + WS_QKC);
    const float* cw = a.in[29]; const float* cb = a.in[30];
    const int c0 = tid * 8;
    const float sc = c0 >= 2048 ? 0.044194173824159216f : 1.f;
    const f32x4 b0 = *(const f32x4*)(cb + c0), b1 = *(const f32x4*)(cb + c0 + 4);
    const u32x4 zero4 = (u32x4){0u, 0u, 0u, 0u};
    for (int gtb = blockIdx.x; gtb < 256; gtb += G) {
        const int m0 = gtb * 32;
        if (m0 < 4096) {
            f32x4 w0[3], w1[3];
#pragma unroll
            for (int j = 0; j < 3; ++j) { w0[j] = *(const f32x4*)(cw + (size_t)(3 + j) * 4096 + c0); w1[j] = *(const f32x4*)(cw + (size_t)(3 + j) * 4096 + c0 + 4); }
            const int t0 = m0 & 255;
#pragma unroll 1
            for (int s8 = 0; s8 < 4; ++s8) { u32x4 x[10];
#pragma unroll
                for (int i = 0; i < 10; ++i) { const int t = t0 + 8 * s8 + i - 1; x[i] = (t >= 0 && t < 256) ? *(const u32x4*)(P + (size_t)(m0 + 8 * s8 + i - 1) * IN_ODD_MAIN + c0) : zero4; }
                __builtin_amdgcn_sched_barrier(0);
#pragma unroll
                for (int i = 0; i < 8; ++i) { float acc[8] = {b0.x, b0.y, b0.z, b0.w, b1.x, b1.y, b1.z, b1.w};
#pragma unroll
                    for (int j = 0; j < 3; ++j) conv_fma8(acc, x[i + j], w0[j], w1[j]);
                    *(u32x4*)(QKC + (size_t)(m0 + 8 * s8 + i) * 4096 + c0) = conv_out8(acc, sc); } }
        } else {
            f32x4 w0[9], w1[9];
#pragma unroll
            for (int j = 0; j < 9; ++j) { w0[j] = *(const f32x4*)(cw + (size_t)j * 4096 + c0); w1[j] = *(const f32x4*)(cw + (size_t)j * 4096 + c0 + 4); }
            const int tl = (m0 - 4096) & 2047, r = tl >> 6, cw0 = tl & 63;
#pragma unroll 1
            for (int s4 = 0; s4 < 8; ++s4) { u32x4 x[3][6];
#pragma unroll
                for (int i3 = 0; i3 < 3; ++i3)
#pragma unroll
                    for (int i = 0; i < 6; ++i) { const int rr = r + i3 - 1, cc = cw0 + 4 * s4 + i - 1;
                        x[i3][i] = (rr >= 0 && rr < 32 && cc >= 0 && cc < 64) ? *(const u32x4*)(P + (size_t)(m0 + (i3 - 1) * 64 + 4 * s4 + i - 1) * IN_ODD_MAIN + c0) : zero4; }
                __builtin_amdgcn_sched_barrier(0);
#pragma unroll
                for (int i = 0; i < 4; ++i) { float acc[8] = {b0.x, b0.y, b0.z, b0.w, b1.x, b1.y, b1.z, b1.w};
#pragma unroll
                    for (int i3 = 0; i3 < 3; ++i3)
#pragma unroll
                        for (int j = 0; j < 3; ++j) conv_fma8(acc, x[i3][i + j], w0[i3 * 3 + j], w1[i3 * 3 + j]);
                    *(u32x4*)(QKC + (size_t)(m0 + 4 * s4 + i) * 4096 + c0) = conv_out8(acc, sc); } }
        }
    }
}

constexpr int ML_RECSZ = 2560, ML_IMG_OFF = 3072;
__device__ __forceinline__ float logsig(float x) { return fminf(x, 0.f) - log1pf(__expf(-fabsf(x))); }
__device__ __forceinline__ void mlstm_gate_scan(const Args& a, int lane, int rid) {
    const float* GT = (const float*)(a.ws + WS_GT); float* MP = (float*)(a.ws + WS_MP);
    const int is_sample = rid < 16, k = is_sample ? rid : rid - 16, h = k & 3, dir = (k >> 2) & 1, seq = k >> 3;
    const int T = is_sample ? 2048 : 256, base = is_sample ? 4096 + seq * 2048 : seq * 256, nch = T / 32;
    float B = 0.f, Gm = -3.0e38f;
    if (lane < nch) { float gi[32], gf[32];
#pragma unroll
        for (int i = 0; i < 32; ++i) { const int ii = lane * 32 + i; const int t = dir ? (T - 1 - ii) : ii; gi[i] = GT[(size_t)(base + t) * 16 + dir * 4 + h]; gf[i] = GT[(size_t)(base + t) * 16 + (2 + dir) * 4 + h]; }
#pragma unroll
        for (int i = 0; i < 32; ++i) { B += logsig(gf[i]); Gm = fmaxf(Gm, gi[i] - B); } }
    float m = is_sample ? a.in[7][(seq * 2 + dir) * 4 + h] : 0.f;
    for (int c = 0; c < nch; ++c) { const float Bc = __shfl(B, c), Gc = __shfl(Gm, c);
        if (lane == 0) MP[rid * 64 + c] = m;
        m = Bc + fmaxf(m, Gc); }
    if (!is_sample && lane == 0) a.out[OUT_M + (seq * 2 + dir) * 4 + h] = m;
}
__device__ __forceinline__ void mlstm_sp_job(const Args& a, LAS unsigned char* wl, int lane, int gtb, int h, int part) {
    const bf16_t* QKC = (const bf16_t*)(a.ws + WS_QKC); const float* GT = (const float*)(a.ws + WS_GT); const float* MP = (const float*)(a.ws + WS_MP);
    const int m0 = gtb * 32, is_sample = m0 >= 4096;
    const int seq = is_sample ? (m0 - 4096) >> 11 : m0 >> 8, T = is_sample ? 2048 : 256, base = is_sample ? 4096 + seq * 2048 : seq * 256;
    const int tb = (m0 - base) >> 5, nblk = T / 32, q = lane >> 4, r16 = lane & 15;
    LAS unsigned char* PL = wl; LAS float* sc = (LAS float*)(wl + 2560);
    f32x4 S[2][2];
#pragma unroll
    for (int x = 0; x < 2; ++x)
#pragma unroll
        for (int y = 0; y < 2; ++y) S[x][y] = (f32x4){0.f, 0.f, 0.f, 0.f};
    float mpv[2] = {0.f, 0.f}, liv[2] = {0.f, 0.f}, gfv[2] = {0.f, 0.f};
    if (part == 0) {
#pragma unroll
        for (int dir = 0; dir < 2; ++dir) { const int rid = is_sample ? (seq * 2 + dir) * 4 + h : 16 + (seq * 2 + dir) * 4 + h, c = dir ? nblk - 1 - tb : tb; const int i = lane & 31, t = dir ? 31 - i : i;
            mpv[dir] = MP[rid * 64 + c]; liv[dir] = GT[(size_t)(m0 + t) * 16 + dir * 4 + h]; gfv[dir] = GT[(size_t)(m0 + t) * 16 + (2 + dir) * 4 + h]; }
        bf16x8 qA[2][4], kA[2][4], qB[2][4], kB[2][4];
#define SP_LD(X, kg) do { _Pragma("unroll") for (int x = 0; x < 2; ++x) _Pragma("unroll") for (int k4 = 0; k4 < 4; ++k4) { \
            const bf16_t* row = QKC + (size_t)(m0 + 16 * x + r16) * 4096 + h * 512 + 32 * (4 * (kg) + k4) + 8 * q; q##X[x][k4] = *(const bf16x8*)row; k##X[x][k4] = *(const bf16x8*)(row + 2048); } } while (0)
#define SP_MM(X) do { _Pragma("unroll") for (int k4 = 0; k4 < 4; ++k4) _Pragma("unroll") for (int x = 0; x < 2; ++x) _Pragma("unroll") for (int y = 0; y < 2; ++y) \
            S[x][y] = __builtin_amdgcn_mfma_f32_16x16x32_bf16(q##X[x][k4], k##X[y][k4], S[x][y], 0, 0, 0); } while (0)
        SP_LD(A, 0); SP_LD(B, 1); __builtin_amdgcn_sched_barrier(0);
        SP_MM(A); SP_LD(A, 2); __builtin_amdgcn_sched_barrier(0);
        SP_MM(B); SP_LD(B, 3); __builtin_amdgcn_sched_barrier(0);
        SP_MM(A); SP_MM(B);
#undef SP_LD
#undef SP_MM
    }
    if (part == 1) { unsigned char* fb = a.ws + WS_QKF + (size_t)((gtb * 4 + h) * 64) * 1024 + lane * 16;
      LAS unsigned char* img = wl + ML_IMG_OFF; const int lr = lane >> 3, lp = lane & 7;
      u32x4 rq[4], rk[4], nq[4], nk[4];
#pragma unroll
      for (int i = 0; i < 4; ++i) { const bf16_t* p = QKC + (size_t)(m0 + lr + 8 * i) * 4096 + h * 512 + 8 * lp; rq[i] = *(const u32x4*)p; rk[i] = *(const u32x4*)(p + 2048); }
#pragma unroll 1
      for (int w8 = 0; w8 < 8; ++w8) { const int wn = w8 < 7 ? w8 + 1 : 7;
#pragma unroll
          for (int i = 0; i < 4; ++i) { const bf16_t* p = QKC + (size_t)(m0 + lr + 8 * i) * 4096 + h * 512 + 64 * wn + 8 * lp; nq[i] = *(const u32x4*)p; nk[i] = *(const u32x4*)(p + 2048); }
#pragma unroll
          for (int i = 0; i < 4; ++i) *(LAS u32x4*)(img + (lr + 8 * i) * 272 + lp * 16) = rq[i];
#pragma unroll
          for (int xs = 0; xs < 4; ++xs) { const LAS unsigned char* qp = img + (16 * (xs >> 1) + r16) * 272 + (32 * (xs & 1) + 4 * q) * 2; const u32x2 lo = *(const LAS u32x2*)qp, hi = *(const LAS u32x2*)(qp + 32);
              *(u32x4*)(fb + (w8 * 4 + xs) * 1024) = (u32x4){lo.x, lo.y, hi.x, hi.y}; }
#pragma unroll
          for (int i = 0; i < 4; ++i) *(LAS u32x4*)(img + (lr + 8 * i) * 272 + lp * 16) = rk[i];
#pragma unroll
          for (int dt = 0; dt < 4; ++dt) *(bf16x8*)(fb + (32 + w8 * 4 + dt) * 1024) = tr_frag(img, 0, 16 * dt, q, r16);
#pragma unroll
          for (int i = 0; i < 4; ++i) { rq[i] = nq[i]; rk[i] = nk[i]; } }
      return; }
#pragma unroll
    for (int dir = 0; dir < 2; ++dir) {
        const int rid = is_sample ? (seq * 2 + dir) * 4 + h : 16 + (seq * 2 + dir) * 4 + h, c = dir ? nblk - 1 - tb : tb;
        const float m_prev = mpv[dir];
        unsigned char* rec = a.ws + WS_MLREC + (size_t)(rid * 64 + c) * ML_RECSZ;
        { const int i = lane & 31, t = dir ? 31 - i : i;
          const float li = liv[dir], lf = logsig(gfv[dir]);
          float b = lf;
#pragma unroll
          for (int o = 1; o < 32; o <<= 1) { const float x = __shfl_up(b, o, 32); if (i >= o) b += x; }
          const float g = li - b; float G = g;
#pragma unroll
          for (int o = 1; o < 32; o <<= 1) { const float x = __shfl_up(G, o, 32); if (i >= o) G = fmaxf(G, x); }
          const float M = fmaxf(m_prev, G), Mend = __shfl(M, 31);
          if (lane < 32) { sc[i] = g; sc[32 + i] = M;
              *(float*)(rec + 2048 + i * 4) = __expf(m_prev - M); *(float*)(rec + 2176 + i * 4) = __expf(g - Mend); *(float*)(rec + 2304 + i * 4) = __expf(-(b + M));
              if (lane == 0) *(float*)(rec + 2432) = __expf(m_prev - Mend); } }
#pragma unroll
        for (int x = 0; x < 2; ++x)
#pragma unroll
            for (int y = 0; y < 2; ++y)
#pragma unroll
                for (int r = 0; r < 4; ++r) { const int t = 16 * x + 4 * q + r, s = 16 * y + r16; const int i = dir ? 31 - t : t, j = dir ? 31 - s : s;
                    const float v = (j <= i) ? S[x][y][r] * __expf(sc[j] - sc[32 + i]) : 0.f;
                    *(LAS unsigned short*)(PL + i * 80 + j * 2) = (unsigned short)f2bf(v); }
#pragma unroll
        for (int x = 0; x < 2; ++x) *(bf16x8*)(rec + x * 1024 + lane * 16) = *(const LAS bf16x8*)(PL + (16 * x + r16) * 80 + 8 * q * 2);
    }
}
__device__ __forceinline__ void phase_mlstm_pre(const Args& a, LAS unsigned char* lds, int lane, int wave, int G) {
    const int gw = blockIdx.x * NWAVES + wave, NGW = G * NWAVES;
    for (int it = gw; it < 256 * 4 * 2; it += NGW) { const int job = it >> 1; mlstm_sp_job(a, lds + wave * 12288, lane, job >> 2, job & 3, it & 1); }
}

constexpr int ML_PITCH = 1040;
#ifndef ML_TR
#define ML_TR 1
#endif
typedef short s16x4 __attribute__((ext_vector_type(4)));
constexpr int M2_QS = 0, M2_KS = 33280, M2_PS = 66560, M2_VT = 132096;
template <bool DEN>
__device__ __forceinline__ void mlstm_scan_task(const Args& a, LAS unsigned char* lds, int tid, int seq, int is_sample, int dir, int h, int sl) {
    constexpr int ne = DEN ? 1 : 4;
    const bf16_t* QKC = (const bf16_t*)(a.ws + WS_QKC); const bf16_t* P = (const bf16_t*)(a.ws + WS_PROJ);
    bf16_t* H = (bf16_t*)(a.ws + (dir ? WS_HB : WS_HF)); float* DN = (float*)(a.ws + WS_DEN) + (size_t)dir * NTOK * 4;
    const int T = is_sample ? 2048 : 256, base = is_sample ? 4096 + seq * 2048 : seq * 256, nch = T / 32;
    const int rid = is_sample ? (seq * 2 + dir) * 4 + h : 16 + (seq * 2 + dir) * 4 + h;
    const unsigned char* rec0 = a.ws + WS_MLREC + (size_t)rid * 64 * ML_RECSZ;
    asm volatile("" : "+v"(tid));
    const int lane = tid & 63, w = __builtin_amdgcn_readfirstlane(tid >> 6), tt = w & 1, et = w >> 1, q = lane >> 4, r16 = lane & 15;
    LAS unsigned char* Qs = lds + M2_QS; LAS unsigned char* Ks = lds + M2_KS; LAS unsigned char* PS = lds + M2_PS; LAS unsigned char* VT = lds + M2_VT;
    const size_t sb = (size_t)((seq * 2 + dir) * 4 + h);
    f32x4 Cacc[4][4];
    if (is_sample && !DEN) { const float* src = a.in[5] + (sb * 512) * 512 + sl * 64;
        for (int i = tid; i < 512 * 16; i += NT) { const int d = i >> 4, c4 = i & 15; *(LAS f32x4*)(lds + d * 272 + c4 * 16) = *(const f32x4*)(src + (size_t)d * 512 + 4 * c4); }
        __syncthreads(); }
#pragma unroll
    for (int dt = 0; dt < 4; ++dt)
#pragma unroll
        for (int e = 0; e < 4; ++e)
#pragma unroll
            for (int r = 0; r < 4; ++r) { float v = 0.f;
                if (is_sample) { if (DEN) { if (e == 0) v = (r16 == 0) ? a.in[6][sb * 512 + 64 * w + 16 * dt + 4 * q + r] : 0.f; }
                                 else v = *(const LAS float*)(lds + (64 * w + 16 * dt + 4 * q + r) * 272 + (16 * e + r16) * 4); }
                Cacc[dt][e][r] = v; }
    __syncthreads();
    if (DEN) { for (int i = tid; i < 5120; i += NT) ((LAS unsigned*)VT)[i] = 0u;
        __syncthreads();
        if (tid < 80) *(LAS unsigned short*)(VT + (tid >= 40 ? 10240 : 0) + (tid % 40) * 2) = (unsigned short)0x3F80; }
    u32x4 Qf[4], Kf[4]; u32x4 pv = (u32x4){0u, 0u, 0u, 0u}; float pws = 0.f;
    const unsigned char* fbase = a.ws + WS_QKF + (size_t)h * 65536;
    const int gtb0 = base >> 5;
    const int qlane = dir ? (q * 16 + 15 - r16) : lane, klane = dir ? ((3 - q) * 16 + r16) : lane;
#define M2_FB(c) (fbase + (size_t)(gtb0 + (dir ? nch - 1 - (c) : (c))) * 262144)
#define M2_LOADQ(c) do { const unsigned char* fb_ = M2_FB(c) + (w * 4) * 1024 + qlane * 16; \
        _Pragma("unroll") for (int xs = 0; xs < 4; ++xs) Qf[xs] = *(const u32x4*)(fb_ + (dir ? (xs ^ 2) : xs) * 1024); } while (0)
#define M2_LOADK(c) do { const unsigned char* fb_ = M2_FB(c) + (32 + w * 4) * 1024 + klane * 16; \
        _Pragma("unroll") for (int dt = 0; dt < 4; ++dt) Kf[dt] = *(const u32x4*)(fb_ + dt * 1024); } while (0)
#define M2_LOADV(c) do { const unsigned char* rc_ = rec0 + (size_t)(c) * ML_RECSZ; \
        if (!DEN && tid < 256) { const int j = tid & 31, c16 = tid >> 5; const int ii = (c) * 32 + j; const int t = dir ? (T - 1 - ii) : ii; \
            pv = *(const u32x4*)(P + (size_t)(base + t) * IN_ODD_MAIN + 4096 + h * 512 + sl * 64 + c16 * 8); pws = *(const float*)(rc_ + 2176 + j * 4); } \
        if (DEN && tid < 32) pws = *(const float*)(rc_ + 2176 + tid * 4); } while (0)
#define M2_STOREV(buf) do { LAS unsigned char* vb = VT + (buf) * 10240; \
        if (!DEN && tid < 256) { const int j = tid & 31, c16 = tid >> 5; const unsigned vv[4] = {pv.x, pv.y, pv.z, pv.w}; \
            _Pragma("unroll") for (int i = 0; i < 4; ++i) { const int e0 = c16 * 8 + 2 * i; \
                *(LAS unsigned short*)(vb + e0 * 80 + j * 2) = (unsigned short)(vv[i] & 0xffffu); *(LAS unsigned short*)(vb + (e0 + 1) * 80 + j * 2) = (unsigned short)(vv[i] >> 16); \
                *(LAS unsigned short*)(vb + 5120 + e0 * 80 + j * 2) = (unsigned short)f2bf(bflo(vv[i]) * pws); *(LAS unsigned short*)(vb + 5120 + (e0 + 1) * 80 + j * 2) = (unsigned short)f2bf(bfhi(vv[i]) * pws); } } \
        if (DEN && tid < 32) *(LAS unsigned short*)(vb + 5120 + tid * 2) = (unsigned short)f2bf(pws); } while (0)
    LAS float* wold_s = (LAS float*)(lds + 152576);
    if (tid < nch) wold_s[tid] = *(const float*)(rec0 + (size_t)tid * ML_RECSZ + 2432);
    M2_LOADV(0);
    M2_LOADQ(0); M2_LOADK(0);
    M2_STOREV(0);
    M2_LOADV(1);
    __syncthreads();
    bf16x8 pfragP = (bf16x8){0, 0, 0, 0, 0, 0, 0, 0}, vfP = pfragP; float wpP[4] = {0.f, 0.f, 0.f, 0.f}, clP[4] = {0.f, 0.f, 0.f, 0.f};
#define M2_PHASE2_READ(cp) do { LAS unsigned char* PSp_ = PS + ((cp) & 1) * 32768; \
        _Pragma("unroll") for (int ww = 0; ww < 8; ++ww) pp[ww] = *(const LAS u32x2*)(PSp_ + ((ww * 2 + tt) * 4 + et) * 512 + lane * 8); } while (0)
#define M2_PHASE2_FIN(cp) do { f32x4 n4 = (f32x4){0.f, 0.f, 0.f, 0.f}; \
        _Pragma("unroll") for (int ww = 0; ww < 8; ++ww) n4 += (f32x4){bflo(pp[ww].x), bfhi(pp[ww].x), bflo(pp[ww].y), bfhi(pp[ww].y)}; \
        _Pragma("unroll") for (int r = 0; r < 4; ++r) n4[r] *= wpP[r]; \
        n4 = __builtin_amdgcn_mfma_f32_16x16x32_bf16(pfragP, vfP, n4, 0, 0, 0); \
        _Pragma("unroll") for (int r = 0; r < 4; ++r) { const int ii = (cp) * 32 + 16 * tt + 4 * q + r; const int t = dir ? (T - 1 - ii) : ii; \
            if (DEN) { if (r16 == 0) DN[(size_t)(base + t) * 4 + h] = fmaxf(fabsf(n4[r]), clP[r]); } \
            else H[(size_t)(base + t) * 2048 + h * 512 + sl * 64 + 16 * et + r16] = (bf16_t)f2bf(n4[r]); } } while (0)
    for (int c = 0; c < nch; ++c) {
        const unsigned char* rc = rec0 + (size_t)c * ML_RECSZ;
        const int buf = c & 1, cn = c + 1 < nch ? c + 1 : c;
        LAS unsigned char* PSc = PS + buf * 32768;
        const float w_old = wold_s[c];
        u32x2 pp[8];
        if ((!DEN || et < ne) && c > 0) M2_PHASE2_READ(c - 1);
#pragma unroll
        for (int x = 0; x < 2; ++x) { f32x4 part[4];
#pragma unroll
          for (int e = 0; e < 4; ++e) part[e] = (f32x4){0.f, 0.f, 0.f, 0.f};
#pragma unroll
          for (int s = 0; s < 2; ++s) {
              const u32x4 af = Qf[x * 2 + s];
#pragma unroll
              for (int e = 0; e < 4; ++e) if (e < ne) { u32x4 bfr; bfr.x = pk2(Cacc[2 * s][e][0], Cacc[2 * s][e][1]); bfr.y = pk2(Cacc[2 * s][e][2], Cacc[2 * s][e][3]);
                  bfr.z = pk2(Cacc[2 * s + 1][e][0], Cacc[2 * s + 1][e][1]); bfr.w = pk2(Cacc[2 * s + 1][e][2], Cacc[2 * s + 1][e][3]);
                  part[e] = __builtin_amdgcn_mfma_f32_16x16x32_bf16(__builtin_bit_cast(bf16x8, af), __builtin_bit_cast(bf16x8, bfr), part[e], 0, 0, 0); } }
#pragma unroll
          for (int e = 0; e < 4; ++e) if (e < ne) *(LAS u32x2*)(PSc + ((w * 2 + x) * 4 + e) * 512 + lane * 8) = (u32x2){pk2(part[e][0], part[e][1]), pk2(part[e][2], part[e][3])};
          __builtin_amdgcn_sched_barrier(0); }
        M2_LOADQ(cn);
        if ((!DEN || et < ne) && c > 0) M2_PHASE2_FIN(c - 1);
        if (!DEN || et < ne) { pfragP = *(const bf16x8*)(rc + tt * 1024 + lane * 16);
#pragma unroll
            for (int r = 0; r < 4; ++r) { wpP[r] = *(const float*)(rc + 2048 + (16 * tt + 4 * q + r) * 4); if constexpr (DEN) clP[r] = *(const float*)(rc + 2304 + (16 * tt + 4 * q + r) * 4); } }
#pragma unroll
        for (int dt = 0; dt < 4; ++dt)
#pragma unroll
            for (int e = 0; e < 4; ++e) Cacc[dt][e] *= w_old;
        if (!DEN || et < ne) vfP = *(const LAS bf16x8*)(VT + buf * 10240 + (16 * et + r16) * 80 + q * 16);
        { bf16x8 bfr[4];
#pragma unroll
          for (int e = 0; e < 4; ++e) if (e < ne) bfr[e] = *(const LAS bf16x8*)(VT + buf * 10240 + 5120 + (16 * e + r16) * 80 + q * 16);
#pragma unroll
          for (int dt = 0; dt < 4; ++dt) {
              u32x4 af = Kf[dt];
              if (dir) af = (u32x4){__builtin_amdgcn_alignbit(af.w, af.w, 16), __builtin_amdgcn_alignbit(af.z, af.z, 16), __builtin_amdgcn_alignbit(af.y, af.y, 16), __builtin_amdgcn_alignbit(af.x, af.x, 16)};
#pragma unroll
              for (int e = 0; e < 4; ++e) if (e < ne) Cacc[dt][e] = __builtin_amdgcn_mfma_f32_16x16x32_bf16(__builtin_bit_cast(bf16x8, af), bfr[e], Cacc[dt][e], 0, 0, 0);
              __builtin_amdgcn_sched_barrier(0); } }
        M2_LOADK(cn);
        if (c + 1 < nch) M2_STOREV(buf ^ 1);
        __syncthreads();
        if (c + 2 < nch) M2_LOADV(c + 2);
    }
    if (!DEN || et < ne) { u32x2 pp[8]; M2_PHASE2_READ(nch - 1); M2_PHASE2_FIN(nch - 1); }
#undef M2_PHASE2_READ
#undef M2_PHASE2_FIN
    __syncthreads();
#undef M2_FB
#undef M2_LOADQ
#undef M2_LOADK
#undef M2_LOADV
#undef M2_STOREV
    if (!is_sample) {
        if (DEN) {
#pragma unroll
            for (int dt = 0; dt < 4; ++dt)
#pragma unroll
                for (int r = 0; r < 4; ++r) if (r16 == 0) a.out[OUT_N + sb * 512 + 64 * w + 16 * dt + 4 * q + r] = Cacc[dt][0][r];
        } else {
#pragma unroll
            for (int dt = 0; dt < 4; ++dt)
#pragma unroll
                for (int e = 0; e < 4; ++e)
#pragma unroll
                    for (int r = 0; r < 4; ++r) *(LAS float*)(lds + (64 * w + 16 * dt + 4 * q + r) * 272 + (16 * e + r16) * 4) = Cacc[dt][e][r];
            __syncthreads();
            float* dst = a.out + OUT_C + (sb * 512) * 512 + sl * 64;
            for (int i = tid; i < 512 * 16; i += NT) { const int d = i >> 4, c4 = i & 15; *(f32x4*)(dst + (size_t)d * 512 + 4 * c4) = *(const LAS f32x4*)(lds + d * 272 + c4 * 16); }
        }
    }
    __syncthreads();
}

__device__ __forceinline__ void phase_scans_odd(const Args& a, LAS unsigned char* lds, int tid, int qoff) {
    const int xg = blockIdx.x & 7;
    unsigned* head = (unsigned*)(a.ws + WS_CTL) + CW_Q1 + qoff + 64 * xg;
    volatile LAS unsigned* slot = (volatile LAS unsigned*)(lds + MISC_OFF);
    for (;;) {
        const int task = queue_pop(head, slot, tid);
        if (task >= 162) break;
        const int rl = task / 9, k9 = task - rl * 9;
        const int is_sample = rl < 2; const int rec = is_sample ? xg * 2 + rl : xg * 16 + (rl - 2);
        const int h = rec & 3, dir = (rec >> 2) & 1, seq = rec >> 3;
        if (k9 == 8) mlstm_scan_task<true>(a, lds, tid, seq, is_sample, dir, h, 0); else mlstm_scan_task<false>(a, lds, tid, seq, is_sample, dir, h, k9);
    }
}

__device__ __forceinline__ void phase_combine_odd(const Args& a, int lane, int wave, int G) {
    const int gw = blockIdx.x * NWAVES + wave, NGW = G * NWAVES;
    const bf16_t* HF = (const bf16_t*)(a.ws + WS_HF); const bf16_t* HB = (const bf16_t*)(a.ws + WS_HB);
    const bf16_t* P = (const bf16_t*)(a.ws + WS_PROJ); bf16_t* Yo = (bf16_t*)(a.ws + WS_Y); const float* DNp = (const float*)(a.ws + WS_DEN);
    const float* ng = a.in[32];
    const int c0 = 32 * lane;
    f32x4 ngv[8];
#pragma unroll
    for (int q = 0; q < 8; ++q) ngv[q] = *(const f32x4*)(ng + c0 + 4 * q);
    for (int mb = gw; mb < NTOK; mb += 2 * NGW) {
      u32x4 ov2[2][4], zv2[2][4], rhf2[2][4], rhb2[2][4]; float dnf[2], dnb[2];
#pragma unroll
      for (int k = 0; k < 2; ++k) { const int m = mb + k * NGW;
#pragma unroll
        for (int x = 0; x < 4; ++x) { rhf2[k][x] = *(const u32x4*)(HF + (size_t)m * 2048 + c0 + 8 * x); rhb2[k][x] = *(const u32x4*)(HB + (size_t)m * 2048 + c0 + 8 * x);
            ov2[k][x] = *(const u32x4*)(P + (size_t)m * IN_ODD_MAIN + 6144 + c0 + 8 * x); zv2[k][x] = *(const u32x4*)(P + (size_t)m * IN_ODD_MAIN + 8192 + c0 + 8 * x); }
        dnf[k] = DNp[(size_t)m * 4 + (lane >> 4)]; dnb[k] = DNp[(size_t)NTOK * 4 + (size_t)m * 4 + (lane >> 4)]; }
      __builtin_amdgcn_sched_barrier(0);
#pragma unroll
      for (int k = 0; k < 2; ++k) { const int m = mb + k * NGW;
        f32x4 hf[8], hb[8]; const u32x4 (&ov)[4] = ov2[k]; const u32x4 (&zv)[4] = zv2[k]; const u32x4 (&rhf)[4] = rhf2[k]; const u32x4 (&rhb)[4] = rhb2[k];
#pragma unroll
        for (int q = 0; q < 8; ++q) { const int x = q >> 1, j = (q & 1) * 2;
            hf[q] = (f32x4){bflo(rhf[x][j]), bfhi(rhf[x][j]), bflo(rhf[x][j + 1]), bfhi(rhf[x][j + 1])}; hb[q] = (f32x4){bflo(rhb[x][j]), bfhi(rhb[x][j]), bflo(rhb[x][j + 1]), bfhi(rhb[x][j + 1])}; }
        const float idf = 1.f / dnf[k], idb = 1.f / dnb[k];
        float ss = 0.f;
#pragma unroll
        for (int q = 0; q < 8; ++q) { const unsigned o01 = ov[q >> 1][(q & 1) * 2], o23 = ov[q >> 1][(q & 1) * 2 + 1];
            f32x4 y = hf[q] * idf + hb[q] * idb;
            y.x *= sigm(bflo(o01)); y.y *= sigm(bfhi(o01)); y.z *= sigm(bflo(o23)); y.w *= sigm(bfhi(o23));
            hf[q] = y; ss += (y.x * y.x + y.y * y.y) + (y.z * y.z + y.w * y.w); }
        const float rs = rsqrtf(row16_sum(ss) * (1.f / 512.f) + EPS);
        unsigned w[16];
#pragma unroll
        for (int q = 0; q < 8; ++q) { const unsigned z01 = zv[q >> 1][(q & 1) * 2], z23 = zv[q >> 1][(q & 1) * 2 + 1]; const f32x4 g4 = ngv[q]; const f32x4 y = hf[q] * rs * g4;
            w[2 * q] = pk2(y.x * silu(bflo(z01)), y.y * silu(bfhi(z01))); w[2 * q + 1] = pk2(y.z * silu(bflo(z23)), y.w * silu(bfhi(z23))); }
        u32x4* dst = (u32x4*)(Yo + (size_t)m * 2048 + c0);
#pragma unroll
        for (int q = 0; q < 4; ++q) dst[q] = (u32x4){w[4 * q], w[4 * q + 1], w[4 * q + 2], w[4 * q + 3]};
      }
    }
}

__device__ __forceinline__ void phase_final(const Args& a, int lane, int wave, int G) {
    const int gw = blockIdx.x * NWAVES + wave, NGW = G * NWAVES;
    const float* MOD = (const float*)(a.ws + WS_MOD); const bf16_t* PART = (const bf16_t*)(a.ws + WS_PART); const float* X1 = (const float*)(a.ws + WS_X1);
    const float* fg = a.in[12];
    f32x4 fgv[4];
#pragma unroll
    for (int j = 0; j < 4; ++j) fgv[j] = *(const f32x4*)(fg + ROW_CB(lane, j));
    for (int m = gw; m < NTOK; m += NGW) {
        int t, T, cr; tok_info(m, t, T, cr);
        const float* xr = X1 + (size_t)m * 1024;
        const bf16_t* p0 = PART + (size_t)m * 1024 + 8 * lane; const bf16_t* p1 = p0 + (size_t)NTOK * 1024;
        const float* gt = MOD + (1 * 3 + cr) * 3072 + 2048;
        f32x4 v[4]; float s = 0.f;
#pragma unroll
        for (int j2 = 0; j2 < 2; ++j2) { f32x4 a0, a1, b0, b1; row_unpack(*(const u32x4*)(p0 + 512 * j2), a0, a1); row_unpack(*(const u32x4*)(p1 + 512 * j2), b0, b1);
            v[2 * j2] = *(const f32x4*)(xr + ROW_CB(lane, 2 * j2)) + *(const f32x4*)(gt + ROW_CB(lane, 2 * j2)) * (a0 + b0);
            v[2 * j2 + 1] = *(const f32x4*)(xr + ROW_CB(lane, 2 * j2 + 1)) + *(const f32x4*)(gt + ROW_CB(lane, 2 * j2 + 1)) * (a1 + b1); }
#pragma unroll
        for (int j = 0; j < 4; ++j) s += (v[j].x * v[j].x + v[j].y * v[j].y) + (v[j].z * v[j].z + v[j].w * v[j].w);
        const float rstd = rsqrtf(wave_sum(s) * (1.f / 1024.f) + EPS);
#pragma unroll
        for (int j = 0; j < 4; ++j) *(f32x4*)(a.out + OUT_Y + (size_t)m * 1024 + ROW_CB(lane, j)) = v[j] * rstd * fgv[j];
    }
}


#define XB_TMO      128
#define XB_XCNT(j)  (256  + 64 * (j))
#define XB_XSUB(j)  (1280 + 64 * (j))
#define XB_XGEN(j)  (2304 + 64 * (j))
#define XB_TOP      3328
#define XB_TOPGEN   3392
#define XCD_BAR_WORDS 3456
#define XB_SPIN_CAP (1u << 18)
__device__ __forceinline__ unsigned xb_ld(unsigned* p)              { return __hip_atomic_load(p, __ATOMIC_RELAXED, __HIP_MEMORY_SCOPE_AGENT); }
__device__ __forceinline__ unsigned xb_add(unsigned* p, unsigned v) { return __hip_atomic_fetch_add(p, v, __ATOMIC_RELAXED, __HIP_MEMORY_SCOPE_AGENT); }
__device__ __forceinline__ unsigned xb_xcc_id() { return (unsigned)__builtin_amdgcn_s_getreg((3 << 11) | 20) & 0xFu; }
#define XB_SPIN(cond, bar) do { unsigned _sp = 0; while (cond) { __builtin_amdgcn_s_sleep(1); \
    if ((++_sp & 255u) == 0u) { if (xb_ld(&(bar)[XB_TMO])) break; if (_sp > XB_SPIN_CAP) { atomicAdd(&(bar)[XB_TMO], 1u); break; } } } } while (0)
struct XcdBarrier { unsigned* bar; unsigned x; volatile LAS unsigned* st; };
__device__ __forceinline__ XcdBarrier xcd_barrier_post(unsigned* bar, volatile LAS unsigned* st) {
    XcdBarrier b; b.bar = bar; b.x = xb_xcc_id(); b.st = st;
    if (threadIdx.x == 0) (void)xb_add(&bar[XB_XCNT(b.x)], 1u);
    return b;
}
__device__ __forceinline__ void xcd_barrier_complete(unsigned* bar, unsigned x, unsigned& nloc, unsigned& nx) {
    const unsigned G = gridDim.x * gridDim.y * gridDim.z;
    unsigned sum, cnt, mine, sp = 0u;
    for (;;) {
        sum = 0u; cnt = 0u; mine = 0u;
#pragma unroll
        for (unsigned j = 0; j < 16; ++j) { const unsigned c = xb_ld(&bar[XB_XCNT(j)]); sum += c; cnt += (c > 0u) ? 1u : 0u; mine = (j == x) ? c : mine; }
        if (sum == G) break;
        __builtin_amdgcn_s_sleep(1);
        if ((++sp & 255u) == 0u) { if (xb_ld(&bar[XB_TMO])) break; if (sp > XB_SPIN_CAP) { atomicAdd(&bar[XB_TMO], 1u); break; } }
    }
    nloc = mine > 0u ? mine : 1u; nx = cnt > 0u ? cnt : 1u;
}
__device__ __forceinline__ void xcd_barrier(const XcdBarrier& b) {
    asm volatile("s_waitcnt vmcnt(0)" ::: "memory");
    __syncthreads();
    if (threadIdx.x == 0) {
        unsigned* bar = b.bar;
        __builtin_amdgcn_s_waitcnt(0);
        unsigned nloc = b.st[0], nx = b.st[1];
        if (nloc == 0u) { xcd_barrier_complete(bar, b.x, nloc, nx); b.st[0] = nloc; b.st[1] = nx; }
        const unsigned old = xb_add(&bar[XB_XSUB(b.x)], 1u);
        const unsigned gen = old / nloc;
        if (old + 1u == (gen + 1u) * nloc) {
            __builtin_amdgcn_fence(__ATOMIC_RELEASE, "agent");
            asm volatile("s_waitcnt vmcnt(0)" ::: "memory");
            const unsigned og = xb_add(&bar[XB_TOP], 1u);
            const unsigned tg = og / nx;
            if (og + 1u == (tg + 1u) * nx) xb_add(&bar[XB_TOPGEN], 1u);
            else XB_SPIN(xb_ld(&bar[XB_TOPGEN]) == tg, bar);
            __builtin_amdgcn_fence(__ATOMIC_ACQUIRE, "agent");
            xb_add(&bar[XB_XGEN(b.x)], 1u);
            asm volatile("s_waitcnt vmcnt(0)" ::: "memory");
        } else {
            XB_SPIN(xb_ld(&bar[XB_XGEN(b.x)]) == gen, bar);
            __builtin_amdgcn_fence(__ATOMIC_ACQUIRE, "agent");
            asm volatile("s_waitcnt vmcnt(0)" ::: "memory");
        }
    }
    __syncthreads();
}

constexpr int N_PHASES = 17;
#ifndef PROBE_MASK
#define PROBE_MASK 0u
#endif
template <int K>
__device__ __forceinline__ void run_phase(const Args& a, LAS unsigned char* lds, int tid_, int G, int rep) {
    int tid = tid_; asm volatile("" : "+v"(tid)); const int lane = tid & 63, wave = __builtin_amdgcn_readfirstlane(tid >> 6);
    if constexpr (K == 0) phase_prologue(a, lds, tid, lane, wave, G);
    else if constexpr (K == 1) phase_modnorm0(a, lane, wave, G);
    else if constexpr (K == 2) { pg8::Gemm g{(const bf16_t*)(a.ws + WS_XN), (const bf16_t*)(a.ws + WS_WINE), NTOK, IN_EVEN, 1024, 1024}; pg8::StaticOrder S; S.init(NTOK, IN_EVEN, G, (int)blockIdx.x);
        pg8::EpiBf16 E{(bf16_t*)(a.ws + WS_PROJ), IN_EVEN};
        pg8::gemm_phase<pg8::EpiBf16, pg8::StaticOrder, true, true>(lds, g, S, E); }
    else if constexpr (K == 3) phase_rwkv_lr(a, tid, G);
    else if constexpr (K == 4) { pg8::Gemm g{(const bf16_t*)(a.ws + WS_LR), (const bf16_t*)(a.ws + WS_W2B), NTOK, 4096, 128, 256}; pg8::LowRankOrder S; S.S.init(NTOK, 4096, G, (int)blockIdx.x);
        pg8::EpiBf16 E{(bf16_t*)(a.ws + WS_U4), 4096};
        pg8::gemm_phase<pg8::EpiBf16, pg8::LowRankOrder, true, true>(lds, g, S, E); }
    else if constexpr (K == 5) {
        unsigned* head = (unsigned*)(a.ws + WS_CTL) + CW_Q2 + rep * 2048; volatile LAS unsigned* slot = (volatile LAS unsigned*)(lds + MISC_OFF);
        for (;;) { const int task = queue_pop(head, slot, tid); if (task >= 768) break;
            const int grp = task / 3, sub = task - grp * 3;
            if (sub < 2) { const int job = (grp * 2 + sub) * 8 + wave; rwkv_chunk_job(a, lds + wave * RW_WL, lane, job >> 4, job & 15); }
            else hgrn_pre_bundle(a, lds, tid, grp * 16); } }
    else if constexpr (K == 6) phase_scans_even(a, lds, tid, rep * 2048);
    else if constexpr (K == 7) phase_combine_even(a, lane, wave, G);
    else if constexpr (K == 8) { pg8::Gemm g{(const bf16_t*)(a.ws + WS_Y), (const bf16_t*)(a.ws + WS_WOUTE), NTOK, 1024, 1024, 2048}; pg8::SplitKOrder S{G, (int)blockIdx.x};
        pg8::EpiBf16Part E{(bf16_t*)(a.ws + WS_PART), 1024, (size_t)NTOK * 1024};
        pg8::gemm_phase<pg8::EpiBf16Part, pg8::SplitKOrder, false, true>(lds, g, S, E); }
    else if constexpr (K == 9) phase_res_modnorm1(a, lane, wave, G);
    else if constexpr (K == 10) { pg8::Gemm g{(const bf16_t*)(a.ws + WS_XN), (const bf16_t*)(a.ws + WS_WINO), NTOK, IN_ODD_MAIN, 1024, 1024}; pg8::StaticOrder S; S.init(NTOK, IN_ODD_MAIN, G, (int)blockIdx.x);
        pg8::EpiBf16 E{(bf16_t*)(a.ws + WS_PROJ), IN_ODD_MAIN};
        pg8::gemm_phase<pg8::EpiBf16, pg8::StaticOrder, true, true>(lds, g, S, E); }
    else if constexpr (K == 11) { { const int gw = blockIdx.x * NWAVES + wave; if (gw < 144) mlstm_gate_scan(a, lane, gw); } phase_conv(a, tid, G); }
    else if constexpr (K == 12) phase_mlstm_pre(a, lds, lane, wave, G);
    else if constexpr (K == 13) phase_scans_odd(a, lds, tid, rep * 2048);
    else if constexpr (K == 14) phase_combine_odd(a, lane, wave, G);
    else if constexpr (K == 15) { pg8::Gemm g{(const bf16_t*)(a.ws + WS_Y), (const bf16_t*)(a.ws + WS_WOUTO), NTOK, 1024, 1024, 2048}; pg8::SplitKOrder S{G, (int)blockIdx.x};
        pg8::EpiBf16Part E{(bf16_t*)(a.ws + WS_PART), 1024, (size_t)NTOK * 1024};
        pg8::gemm_phase<pg8::EpiBf16Part, pg8::SplitKOrder, false, true>(lds, g, S, E); }
    else if constexpr (K == 16) phase_final(a, lane, wave, G);
}
__global__ void __launch_bounds__(NT, 2) fwd_kernel(Args a) {
    extern __shared__ __attribute__((aligned(16))) unsigned char lds_raw[];
    LAS unsigned char* lds = (LAS unsigned char*)lds_raw;
    const int tid = threadIdx.x, G = gridDim.x;
    const int lo = a.ph_lo, hi = a.ph_hi;
    if (tid < 16) ((volatile LAS unsigned*)(lds + MISC_OFF))[tid] = 0u;
    __syncthreads();
    const XcdBarrier bar = xcd_barrier_post((unsigned*)(a.ws + WS_CTL) + CW_BAR, (volatile LAS unsigned*)(lds + MISC_OFF) + 8);
#define IN(k) (lo <= (k) && (k) < hi)
#define PHASE(k) do { if (IN(k)) { run_phase<k>(a, lds, tid, G, 0); if ((PROBE_MASK >> (k)) & 1u) { xcd_barrier(bar); run_phase<k>(a, lds, tid, G, 1); } } \
        if (IN(k) && IN((k) + 1)) xcd_barrier(bar); } while (0)
    PHASE(0); PHASE(1); PHASE(2); PHASE(3); PHASE(4); PHASE(5); PHASE(6); PHASE(7); PHASE(8); PHASE(9); PHASE(10); PHASE(11); PHASE(12); PHASE(13); PHASE(14); PHASE(15); PHASE(16);
#undef IN
#undef PHASE
}

extern "C" void kernel_launch(void* const* d_in, const int* in_sizes, int n_in,
                              void* d_out, int out_size, void* d_ws, size_t ws_size,
                              hipStream_t stream) {
    static int grid_blocks = 0;
    if (!grid_blocks) {
        int dev = 0, cus = 0, per_cu = 0;
        (void)hipGetDevice(&dev);
        (void)hipDeviceGetAttribute(&cus, hipDeviceAttributeMultiprocessorCount, dev);
        (void)hipFuncSetAttribute((const void*)fwd_kernel, hipFuncAttributeMaxDynamicSharedMemorySize, LDS_BYTES);
        (void)hipOccupancyMaxActiveBlocksPerMultiprocessor(&per_cu, (const void*)fwd_kernel, NT, LDS_BYTES);
        (void)hipGetLastError();
        grid_blocks = cus > 0 ? cus : 256;
        fprintf(stderr, "kernel_launch: cus=%d per_cu=%d grid=%d ws=%zu\n", cus, per_cu, grid_blocks, ws_size);
        if (n_in != 33 || ws_size < WS_END) { fprintf(stderr, "kernel_launch: unexpected n_in %d / ws %zu\n", n_in, ws_size); }
    }
    (void)hipMemsetAsync((char*)d_ws + WS_CTL, 0, CTL_ZERO_BYTES, stream);
    Args a{};
    for (int i = 0; i < 33; ++i) a.in[i] = (const float*)d_in[i];
    a.out = (float*)d_out; a.ws = (unsigned char*)d_ws; a.ph_lo = 0; a.ph_hi = N_PHASES;
    void* args[] = {&a};
    hipError_t e = hipLaunchCooperativeKernel((const void*)fwd_kernel, dim3(grid_blocks), dim3(NT), args, LDS_BYTES, stream);
    if (e != hipSuccess) fprintf(stderr, "cooperative launch failed: %s (grid %d)\n", hipGetErrorString(e), grid_blocks);
}
```
